# Optimizing an MI355X kernel written in HIP

```python
import jax, jax.numpy as jnp
from jax import lax
import numpy as np

D_MODEL = 1024
BATCH = 8
SEQ = 4096
DEPTH = 1
DEC_BATCH = 16
DEC_SEQ = 4096
PAST_LEN = 128

A_HEADS = 8
A_KV_HEADS = 2
A_HEAD_DIM = 64
WINDOW = 128
BLOCK = 128
B_HEADS = 8
Q_LORA = 256
KV_LORA = 128
QK_NOPE = 64
QK_ROPE = 32
V_HEAD = 64
D_FF = 2816
CONV_W = 3
ROPE_THETA = 10000.0
EPS = 1e-6
NEG_INF = -1e30

A_Q = A_HEADS * A_HEAD_DIM
A_KV = A_KV_HEADS * A_HEAD_DIM
B_QK = QK_NOPE + QK_ROPE
IN_SPLITS = (A_Q, A_Q + A_KV, A_Q + 2 * A_KV, A_Q + 2 * A_KV + Q_LORA, A_Q + 2 * A_KV + Q_LORA + KV_LORA, A_Q + 2 * A_KV + Q_LORA + KV_LORA + QK_ROPE, A_Q + 2 * A_KV + Q_LORA + KV_LORA + QK_ROPE + D_MODEL)
IN_TOTAL = A_Q + 2 * A_KV + Q_LORA + KV_LORA + QK_ROPE + 2 * D_MODEL

kernel_name = 'hybrid_swa_mla_convffn_adaln_encoder'


def _rmsnorm(x, g):
    xf = x.astype(jnp.float32)
    y = xf * lax.rsqrt(jnp.mean(xf * xf, axis=-1, keepdims=True) + EPS)
    return y.astype(x.dtype) * g


def _rope_tables(seq, dim, dtype):
    inv = 1.0 / (ROPE_THETA ** (jnp.arange(0, dim, 2, dtype=jnp.float32) / dim))
    ang = jnp.arange(seq, dtype=jnp.float32)[:, None] * inv[None, :]
    return jnp.cos(ang).astype(dtype), jnp.sin(ang).astype(dtype)


def _apply_rope(x, cos, sin):
    c = cos[:, None, :]
    s = sin[:, None, :]
    x1, x2 = jnp.split(x, 2, axis=-1)
    return jnp.concatenate([x1 * c - x2 * s, x1 * s + x2 * c], axis=-1)


def _band(t):
    b, s, hk, d = t.shape
    nb = s // BLOCK
    tp = jnp.pad(t, ((0, 0), (BLOCK, BLOCK), (0, 0), (0, 0))).reshape(b, nb + 2, BLOCK, hk, d)
    return jnp.concatenate([tp[:, :-2], tp[:, 1:-1], tp[:, 2:]], axis=2)


def _window_attention(q, k, v, sink):
    b, s, h, dh = q.shape
    hkv = k.shape[2]
    grp = h // hkv
    nb = s // BLOCK
    qb = q.reshape(b, nb, BLOCK, hkv, grp, dh)
    kb = _band(k)
    vb = _band(v)
    sc = jnp.einsum('bnqhgd,bnkhd->bnhgqk', qb, kb).astype(jnp.float32) * (dh ** -0.5)
    qpos = jnp.arange(nb)[:, None] * BLOCK + jnp.arange(BLOCK)[None, :]
    kpos = (jnp.arange(nb)[:, None] - 1) * BLOCK + jnp.arange(3 * BLOCK)[None, :]
    valid = ((jnp.abs(qpos[:, :, None] - kpos[:, None, :]) <= WINDOW)
             & (kpos[:, None, :] >= 0) & (kpos[:, None, :] < s))
    sc = jnp.where(valid[None, :, None, None], sc, NEG_INF)
    sk = sink.astype(jnp.float32).reshape(1, 1, hkv, grp, 1, 1)
    m = jnp.maximum(jnp.max(sc, axis=-1, keepdims=True), sk)
    p = jnp.exp(sc - m)
    p = p / (jnp.sum(p, axis=-1, keepdims=True) + jnp.exp(sk - m))
    o = jnp.einsum('bnhgqk,bnkhd->bnqhgd', p.astype(v.dtype), vb)
    return o.reshape(b, s, h * dh)


def _dense_attention_blocks(q, k, v):
    b, s, h, dq = q.shape
    dv = v.shape[-1]
    nb = s // BLOCK
    qb = jnp.moveaxis(q.reshape(b, nb, BLOCK, h, dq), 1, 0)
    scale = dq ** -0.5

    def one_block(qi):
        sc = jnp.einsum('bqhd,bkhd->bhqk', qi, k).astype(jnp.float32) * scale
        p = jax.nn.softmax(sc, axis=-1)
        return jnp.einsum('bhqk,bkhd->bqhd', p.astype(v.dtype), v)

    o = lax.map(one_block, qb)
    return jnp.moveaxis(o, 0, 1).reshape(b, s, h * dv)


def _dwconv(u, w, bias):
    s = u.shape[1]
    half = CONV_W // 2
    up = jnp.pad(u, ((0, 0), (half, half), (0, 0)))
    out = bias
    for j in range(CONV_W):
        out = out + up[:, j:j + s] * w[j]
    return out


def _layer(x, c, w_ada, b_ada, g_attn, w_in, gq_a, gk_a, sink_a, g_cq, w_uq, g_ckv, w_ukv,
           gq_b, gk_b, w_o_a, w_o_b, w_out, g_ffn, w_up, conv_w, conv_b, w_down):
    b, s, _ = x.shape
    mod = jax.nn.silu(c) @ w_ada + b_ada
    sh1, sc1, gt1, sh2, sc2, gt2 = [t[:, None, :] for t in jnp.split(mod, 6, axis=-1)]

    h = _rmsnorm(x, g_attn) * (1 + sc1) + sh1
    z = h @ w_in
    qa, ka, va, cq, ckv, kr, gla, glb = jnp.split(z, IN_SPLITS, axis=-1)

    cos_a, sin_a = _rope_tables(s, A_HEAD_DIM, x.dtype)
    qa = _apply_rope(_rmsnorm(qa.reshape(b, s, A_HEADS, A_HEAD_DIM), gq_a), cos_a, sin_a)
    ka = _apply_rope(_rmsnorm(ka.reshape(b, s, A_KV_HEADS, A_HEAD_DIM), gk_a), cos_a, sin_a)
    va = va.reshape(b, s, A_KV_HEADS, A_HEAD_DIM)
    oa = _window_attention(qa, ka, va, sink_a)

    qb = (_rmsnorm(cq, g_cq) @ w_uq).reshape(b, s, B_HEADS, B_QK)
    kv = (_rmsnorm(ckv, g_ckv) @ w_ukv).reshape(b, s, B_HEADS, QK_NOPE + V_HEAD)
    k_nope = kv[..., :QK_NOPE]
    vb = kv[..., QK_NOPE:]
    kb = jnp.concatenate([k_nope, jnp.broadcast_to(kr[:, :, None, :], (b, s, B_HEADS, QK_ROPE))], axis=-1)
    qb = _rmsnorm(qb, gq_b)
    kb = _rmsnorm(kb, gk_b)
    cos_b, sin_b = _rope_tables(s, QK_ROPE, x.dtype)
    qb = jnp.concatenate([qb[..., :QK_NOPE], _apply_rope(qb[..., QK_NOPE:], cos_b, sin_b)], axis=-1)
    kb = jnp.concatenate([kb[..., :QK_NOPE], _apply_rope(kb[..., QK_NOPE:], cos_b, sin_b)], axis=-1)
    ob = _dense_attention_blocks(qb, kb, vb)

    mix = jax.nn.sigmoid(gla) * (oa @ w_o_a) + jax.nn.sigmoid(glb) * (ob @ w_o_b)
    x = x + gt1 * (mix @ w_out)

    h2 = _rmsnorm(x, g_ffn) * (1 + sc2) + sh2
    u = _dwconv(h2 @ w_up, conv_w, conv_b)
    ua, ug = jnp.split(u, 2, axis=-1)
    x = x + gt2 * ((jax.nn.silu(ug) * ua) @ w_down)
    return x


def setup_inputs(seed: int = 0) -> dict:
    key = jax.random.key(seed)
    ks = jax.random.split(key, 32)
    f32 = jnp.float32

    def nrm(k, shape, fan_in):
        return jax.random.normal(k, shape, f32) * (fan_in ** -0.5)

    def gain(k, shape):
        return 1.0 + 0.1 * jax.random.normal(k, shape, f32)

    def small(k, shape, scale):
        return scale * jax.random.normal(k, shape, f32)

    L = DEPTH
    return {
        'x_prompt': jax.random.normal(ks[0], (BATCH, SEQ, D_MODEL), f32),
        'x_sample': jax.random.normal(ks[1], (DEC_BATCH, DEC_SEQ, D_MODEL), f32),
        'c_prompt': jax.random.normal(ks[2], (BATCH, D_MODEL), f32),
        'c_sample': jax.random.normal(ks[3], (DEC_BATCH, D_MODEL), f32),
        'w_ada': nrm(ks[4], (L, D_MODEL, 6 * D_MODEL), D_MODEL),
        'b_ada': small(ks[5], (L, 6 * D_MODEL), 0.02),
        'g_attn': gain(ks[6], (L, D_MODEL)),
        'w_in': nrm(ks[7], (L, D_MODEL, IN_TOTAL), D_MODEL),
        'gq_a': gain(ks[8], (L, A_HEAD_DIM)),
        'gk_a': gain(ks[9], (L, A_HEAD_DIM)),
        'sink_a': small(ks[10], (L, A_HEADS), 0.5),
        'g_cq': gain(ks[11], (L, Q_LORA)),
        'w_uq': nrm(ks[12], (L, Q_LORA, B_HEADS * B_QK), Q_LORA),
        'g_ckv': gain(ks[13], (L, KV_LORA)),
        'w_ukv': nrm(ks[14], (L, KV_LORA, B_HEADS * (QK_NOPE + V_HEAD)), KV_LORA),
        'gq_b': gain(ks[15], (L, B_QK)),
        'gk_b': gain(ks[16], (L, B_QK)),
        'w_o_a': nrm(ks[17], (L, A_Q, D_MODEL), A_Q),
        'w_o_b': nrm(ks[18], (L, B_HEADS * V_HEAD, D_MODEL), B_HEADS * V_HEAD),
        'w_out': nrm(ks[19], (L, D_MODEL, D_MODEL), D_MODEL),
        'g_ffn': gain(ks[20], (L, D_MODEL)),
        'w_up': nrm(ks[21], (L, D_MODEL, 2 * D_FF), D_MODEL),
        'conv_w': nrm(ks[22], (L, CONV_W, 2 * D_FF), CONV_W),
        'conv_b': small(ks[23], (L, 2 * D_FF), 0.02),
        'w_down': nrm(ks[24], (L, D_FF, D_MODEL), D_FF),
    }


def reference(x_prompt, x_sample, c_prompt, c_sample, w_ada, b_ada, g_attn, w_in, gq_a, gk_a,
              sink_a, g_cq, w_uq, g_ckv, w_ukv, gq_b, gk_b, w_o_a, w_o_b, w_out, g_ffn, w_up,
              conv_w, conv_b, w_down):
    y_prompt = x_prompt
    y_sample = x_sample
    for l in range(DEPTH):
        p = (w_ada[l], b_ada[l], g_attn[l], w_in[l], gq_a[l], gk_a[l], sink_a[l], g_cq[l], w_uq[l],
             g_ckv[l], w_ukv[l], gq_b[l], gk_b[l], w_o_a[l], w_o_b[l], w_out[l], g_ffn[l], w_up[l],
             conv_w[l], conv_b[l], w_down[l])
        y_prompt = _layer(y_prompt, c_prompt, *p)
        y_sample = _layer(y_sample, c_sample, *p)
    return (y_prompt, y_sample)
```

```cpp
#include <hip/hip_runtime.h>
#include <hip/hip_cooperative_groups.h>
#include <cstdio>
#include <cstdint>
namespace cg = cooperative_groups;
#ifndef PM
#define PM 4095
#endif

typedef unsigned short bf16_t;
typedef short bf16x8 __attribute__((ext_vector_type(8)));
typedef float f32x4 __attribute__((ext_vector_type(4)));
typedef unsigned u32x4 __attribute__((ext_vector_type(4)));
typedef unsigned u32x2 __attribute__((ext_vector_type(2)));
#define DI __device__ __forceinline__

constexpr int D = 1024, S = 4096, NBATCH = 24, T = NBATCH * S;
constexpr int T_PROMPT = 8 * S;
constexpr int IN_TOTAL = 3232, NZ = 1280  , NIN = NZ + 2048;
constexpr int DFF = 2816, NUP = 2 * DFF;
constexpr float EPS = 1e-6f;
constexpr float LOG2E = 1.4426950408889634f;
constexpr int NCHUNK = 4, TCH = T / NCHUNK;

constexpr size_t MiB = 1024ull * 1024ull;
constexpr size_t O_WIN = 0;
constexpr size_t O_WUQ = O_WIN + (size_t)NIN * 1024 * 2;
constexpr size_t O_WUKV = O_WUQ + 768ull * 256 * 2;
constexpr size_t O_WOA = O_WUKV + 1024ull * 128 * 2;
constexpr size_t O_WOB = O_WOA + 1024ull * 512 * 2;
constexpr size_t O_WOUT = O_WOB + 1024ull * 512 * 2;
constexpr size_t O_WUP = O_WOUT + 1024ull * 1024 * 2;
constexpr size_t O_WDN = O_WUP + (size_t)NUP * 1024 * 2;
constexpr size_t O_MODP = O_WDN + 1024ull * DFF * 2;
constexpr size_t O_MOD = O_MODP + 16ull * 24 * 6144 * 4;
constexpr size_t O_ROPEA = O_MOD + 24ull * 6144 * 4;
constexpr size_t O_ROPEB = O_ROPEA + 4096ull * 32 * 8;
constexpr size_t O_WB_END = O_ROPEB + 4096ull * 16 * 8;
static_assert(O_WB_END <= 48 * MiB, "weights region");
constexpr size_t O_ZS = 48 * MiB;
constexpr size_t O_QA = 288 * MiB;
constexpr size_t O_KA = O_QA + 96 * MiB;
constexpr size_t O_VTA = O_KA + 24 * MiB;
constexpr size_t O_QB = O_VTA + 24 * MiB;
constexpr size_t O_KB = O_QB + 144 * MiB;
constexpr size_t O_VTB = O_KB + 144 * MiB;
constexpr size_t O_H = 816 * MiB;
constexpr size_t O_UP = 288 * MiB;
constexpr size_t O_ACT = 552 * MiB;
constexpr size_t WS_NEED = 1008 * MiB;
static_assert(O_VTB + 96 * MiB <= O_H, "qkv region");
constexpr size_t OO_G = 0, O_OA = O_H, O_OB = O_H + 96 * MiB;

struct Params {
    const float* in[25];
    float* out;
    unsigned char* ws;
};

typedef __bf16 bf16x2_t __attribute__((ext_vector_type(2)));
typedef float f32x2_t __attribute__((ext_vector_type(2)));
DI unsigned pk2(float lo, float hi) { const f32x2_t v = {lo, hi}; return __builtin_bit_cast(unsigned, __builtin_convertvector(v, bf16x2_t)); }
DI float bflo(unsigned u) { return __uint_as_float(u << 16); }
DI float bfhi(unsigned u) { return __uint_as_float(u & 0xffff0000u); }
DI float bf2f(bf16_t v) { return __uint_as_float(((unsigned)v) << 16); }
DI bf16_t f2bf(float v) { return (bf16_t)(pk2(v, v) & 0xffffu); }
DI float fast_rcp(float x) { return __builtin_amdgcn_rcpf(x); }
DI float fast_exp2(float x) { return __builtin_amdgcn_exp2f(x); }
DI float sigmoidf_(float v) { return fast_rcp(1.f + fast_exp2(-v * LOG2E)); }
DI float xor_reduce_g(float v) { v += __shfl_xor(v, 16); v += __shfl_xor(v, 32); return v; }
DI float wave_sum(float v) {
#pragma unroll
    for (int o = 1; o < 64; o <<= 1) v += __shfl_xor(v, o);
    return v;
}
DI int perm32(int s) { const int lo = s & 31; return (s & ~31) | (((lo >> 2) & 3) << 3) | ((lo >> 4) << 2) | (lo & 3); }
DI const float* xrow_ptr(const Params& p, int t) { return t < T_PROMPT ? p.in[0] + (size_t)t * D : p.in[1] + (size_t)(t - T_PROMPT) * D; }

DI void tile_map(int L, int nN, int ntiles, int& pm, int& pn) {
    const int xcd = L & 7, q = L >> 3;
    const int Lp = xcd * (ntiles >> 3) + q;
    const int grp = Lp / (8 * nN), rem = Lp % (8 * nN);
    pm = grp * 8 + (rem & 7); pn = rem >> 3;
}

template <int BM, int BN, int NWM, int NWN>
DI void gemm_mainloop(f32x4 (&acc)[BM / NWM / 16][BN / NWN / 16], const bf16_t* __restrict__ A, int lda,
                      const bf16_t* __restrict__ B, int ldb, int K, char* lds) {
    constexpr int MT = BM / NWM / 16, NT = BN / NWN / 16, NA = BM / 32, NB = BN / 32, STAGE = (BM + BN) * 128;
    const int tid = threadIdx.x, lane = tid & 63, wave = tid >> 6;
    const int wm = wave / NWN, wn = wave % NWN;
    const int r = lane & 15, g = lane >> 4;
    const int lr = tid >> 3, lc = tid & 7;
    const int lsw = (lc ^ ((lr >> 1) & 7)) * 16;
    u32x4 ra[NA], rb[NB];
    const bf16_t* Ap = A + (size_t)lr * lda + lc * 8;
    const bf16_t* Bp = B + (size_t)lr * ldb + lc * 8;
    const int nk = K >> 6;
#pragma unroll
    for (int i = 0; i < NA; ++i) ra[i] = *(const u32x4*)(Ap + (size_t)(32 * i) * lda);
#pragma unroll
    for (int i = 0; i < NB; ++i) rb[i] = *(const u32x4*)(Bp + (size_t)(32 * i) * ldb);
#pragma unroll
    for (int i = 0; i < NA; ++i) *(u32x4*)(lds + (lr + 32 * i) * 128 + lsw) = ra[i];
#pragma unroll
    for (int i = 0; i < NB; ++i) *(u32x4*)(lds + BM * 128 + (lr + 32 * i) * 128 + lsw) = rb[i];
    __syncthreads();
    const int rsw = (r >> 1) & 7;
    for (int kt = 0; kt < nk; ++kt) {
        const int cur = kt & 1;
        const bool more = (kt + 1 < nk);
        if (more) {
#pragma unroll
            for (int i = 0; i < NA; ++i) ra[i] = *(const u32x4*)(Ap + (size_t)(32 * i) * lda + (kt + 1) * 64);
#pragma unroll
            for (int i = 0; i < NB; ++i) rb[i] = *(const u32x4*)(Bp + (size_t)(32 * i) * ldb + (kt + 1) * 64);
        }
        const char* sA = lds + cur * STAGE;
        const char* sB = sA + BM * 128;
#pragma unroll
        for (int ks = 0; ks < 2; ++ks) {
            bf16x8 wf[NT], xf[MT];
            const int co = ((ks * 4 + g) ^ rsw) * 16;
#pragma unroll
            for (int nt = 0; nt < NT; ++nt) wf[nt] = *(const bf16x8*)(sB + (wn * (NT * 16) + nt * 16 + r) * 128 + co);
#pragma unroll
            for (int mt = 0; mt < MT; ++mt) xf[mt] = *(const bf16x8*)(sA + (wm * (MT * 16) + mt * 16 + r) * 128 + co);
#pragma unroll
            for (int mt = 0; mt < MT; ++mt)
#pragma unroll
                for (int nt = 0; nt < NT; ++nt) acc[mt][nt] = __builtin_amdgcn_mfma_f32_16x16x32_bf16(wf[nt], xf[mt], acc[mt][nt], 0, 0, 0);
        }
        if (more) {
            char* dA = lds + (cur ^ 1) * STAGE;
#pragma unroll
            for (int i = 0; i < NA; ++i) *(u32x4*)(dA + (lr + 32 * i) * 128 + lsw) = ra[i];
#pragma unroll
            for (int i = 0; i < NB; ++i) *(u32x4*)(dA + BM * 128 + (lr + 32 * i) * 128 + lsw) = rb[i];
        }
        __syncthreads();
    }
}

template <int MT, int NT>
DI void zero_acc(f32x4 (&acc)[MT][NT]) {
#pragma unroll
    for (int i = 0; i < MT; ++i)
#pragma unroll
        for (int j = 0; j < NT; ++j) acc[i][j] = (f32x4){0.f, 0.f, 0.f, 0.f};
}

DI void transpose_item(const float* __restrict__ W, int K, int N, bf16_t* __restrict__ WT, int mode, const float* __restrict__ scale,
                       float* scr, int item, int lane) {
    const int nblk = N >> 5, kb = item / nblk, nb = item % nblk, k0 = kb * 64, n0 = nb * 32;
#pragma unroll 8
    for (int i = 0; i < 32; ++i) {
        const int kk = 2 * i + (lane >> 5);
        float v = W[(size_t)(k0 + kk) * N + n0 + (lane & 31)];
        if (scale) v *= scale[k0 + kk];
        scr[kk * 33 + (lane & 31)] = v;
    }
    asm volatile("s_waitcnt lgkmcnt(0)" ::: "memory");
    const int c = lane & 7;
#pragma unroll
    for (int j = 0; j < 4; ++j) {
        const int nl = (lane >> 3) + 8 * j;
        const float* s = scr + (8 * c) * 33 + nl;
        u32x4 o;
        o.x = pk2(s[0 * 33], s[1 * 33]); o.y = pk2(s[2 * 33], s[3 * 33]); o.z = pk2(s[4 * 33], s[5 * 33]); o.w = pk2(s[6 * 33], s[7 * 33]);
        const int n = n0 + nl;
        int row;
        if (mode == 1) row = n < 1184 ? n : n + 96;
        else if (mode == 2) { const int h = n >> 7, jj = n & 127; row = jj < 64 ? h * 64 + jj : 512 + h * 64 + (jj - 64); }
        else row = n;
        *(u32x4*)(WT + (size_t)row * K + k0 + 8 * c) = o;
    }
    asm volatile("s_waitcnt lgkmcnt(0)" ::: "memory");
}

DI void phase0(const Params& p, char* lds) {
    const int tid = threadIdx.x, bid = blockIdx.x, G = gridDim.x, lane = tid & 63, wave = tid >> 6;
    unsigned char* ws = p.ws;
    float* sc = (float*)lds;
    for (int it = bid; it < 384; it += G) {
        const int cb = it % 24, ks = it / 24;
        __syncthreads();
        for (int i = tid; i < 24 * 64; i += 256) {
            const int b = i >> 6, k = i & 63;
            const float* c = b < 8 ? p.in[2] + b * 1024 : p.in[3] + (b - 8) * 1024;
            const float v = c[ks * 64 + k];
            sc[i] = v * sigmoidf_(v);
        }
        __syncthreads();
        float a[24];
#pragma unroll
        for (int b = 0; b < 24; ++b) a[b] = 0.f;
        const int n = cb * 256 + tid;
        const float* w = p.in[4] + (size_t)(ks * 64) * 6144 + n;
        for (int k = 0; k < 64; ++k) {
            const float wv = w[(size_t)k * 6144];
#pragma unroll
            for (int b = 0; b < 24; ++b) a[b] += sc[b * 64 + k] * wv;
        }
        float* mp = (float*)(ws + O_MODP) + (size_t)(ks * 24) * 6144 + n;
#pragma unroll
        for (int b = 0; b < 24; ++b) mp[(size_t)b * 6144] = a[b];
    }
    __syncthreads();
    {
        float* scr = (float*)(lds + wave * 8448);
        const int gw = bid * 4 + wave, NGW = G * 4;
        constexpr int I0 = 16 * 101, I1 = 4 * 24, I2 = 2 * 32, I3 = 8 * 32, I4 = 8 * 32, I5 = 16 * 32, I6 = 16 * 176, I7 = 44 * 32;
        constexpr int NI = I0 + I1 + I2 + I3 + I4 + I5 + I6 + I7;
        for (int it = gw; it < NI; it += NGW) {
            int q = it;
            if (q < I0) { transpose_item(p.in[7], 1024, IN_TOTAL, (bf16_t*)(ws + O_WIN), 1, nullptr, scr, q, lane); continue; } q -= I0;
            if (q < I1) { transpose_item(p.in[12], 256, 768, (bf16_t*)(ws + O_WUQ), 0, p.in[11], scr, q, lane); continue; } q -= I1;
            if (q < I2) { transpose_item(p.in[14], 128, 1024, (bf16_t*)(ws + O_WUKV), 2, p.in[13], scr, q, lane); continue; } q -= I2;
            if (q < I3) { transpose_item(p.in[17], 512, 1024, (bf16_t*)(ws + O_WOA), 0, nullptr, scr, q, lane); continue; } q -= I3;
            if (q < I4) { transpose_item(p.in[18], 512, 1024, (bf16_t*)(ws + O_WOB), 0, nullptr, scr, q, lane); continue; } q -= I4;
            if (q < I5) { transpose_item(p.in[19], 1024, 1024, (bf16_t*)(ws + O_WOUT), 0, nullptr, scr, q, lane); continue; } q -= I5;
            if (q < I6) { transpose_item(p.in[21], 1024, NUP, (bf16_t*)(ws + O_WUP), 0, nullptr, scr, q, lane); continue; } q -= I6;
            transpose_item(p.in[24], DFF, 1024, (bf16_t*)(ws + O_WDN), 0, nullptr, scr, q, lane);
        }
    }
    const int gt = bid * 256 + tid, NGT = G * 256;
    for (int i = gt; i < 4096 * 48; i += NGT) {
        const int pos = i / 48, j = i % 48;
        float inv;
        if (j < 32) inv = exp2f(-(float)(2 * j) * (1.f / 64.f) * 13.287712379549449f);
        else inv = exp2f(-(float)(2 * (j - 32)) * (1.f / 32.f) * 13.287712379549449f);
        const float ang = (float)pos * inv;
        float rev = ang * 0.15915494309189535f;
        rev -= floorf(rev);
        const float sn = __builtin_amdgcn_sinf(rev), cs = __builtin_amdgcn_cosf(rev);
        float2* dst = j < 32 ? (float2*)(ws + O_ROPEA) + pos * 32 + j : (float2*)(ws + O_ROPEB) + pos * 16 + (j - 32);
        *dst = make_float2(cs, sn);
    }
    for (int i = gt; i < 96 * 1024 / 8; i += NGT) *(u32x4*)((bf16_t*)(ws + O_WIN) + 1184 * 1024 + (size_t)i * 8) = (u32x4){0u, 0u, 0u, 0u};
}

DI void phase0m(const Params& p) {
    const int gt = blockIdx.x * 256 + threadIdx.x, NGT = gridDim.x * 256;
    const float* mp = (const float*)(p.ws + O_MODP);
    float* mod = (float*)(p.ws + O_MOD);
    for (int i = gt; i < 24 * 6144; i += NGT) {
        float s = p.in[5][i % 6144];
#pragma unroll
        for (int ks = 0; ks < 16; ++ks) s += mp[(size_t)ks * 24 * 6144 + i];
        mod[i] = s;
    }
}

DI void norm_pass(const Params& p, bool second, bf16_t* dst) {
    const int lane = threadIdx.x & 63, gw = blockIdx.x * 4 + (threadIdx.x >> 6), NGW = gridDim.x * 4;
    const float* gwt = second ? p.in[20] : p.in[6];
    const float* mod = (const float*)(p.ws + O_MOD);
    f32x4 gv[4];
#pragma unroll
    for (int j = 0; j < 4; ++j) gv[j] = *((const f32x4*)gwt + 64 * j + lane);
    for (int t = gw; t < T; t += NGW) {
        const float* xr = second ? p.out + (size_t)t * D : xrow_ptr(p, t);
        const int b = t >> 12;
        const float* sh = mod + (size_t)b * 6144 + (second ? 3072 : 0);
        const float* sc = sh + 1024;
        f32x4 v[4]; float s = 0.f;
#pragma unroll
        for (int j = 0; j < 4; ++j) { v[j] = *((const f32x4*)xr + 64 * j + lane); s += (v[j].x * v[j].x + v[j].y * v[j].y) + (v[j].z * v[j].z + v[j].w * v[j].w); }
        const float rstd = rsqrtf(wave_sum(s) * (1.f / D) + EPS);
        u32x2* o = (u32x2*)(dst + (size_t)t * D) + lane;
#pragma unroll
        for (int j = 0; j < 4; ++j) {
            const f32x4 scv = *((const f32x4*)sc + 64 * j + lane), shv = *((const f32x4*)sh + 64 * j + lane);
            f32x4 y;
            y.x = v[j].x * rstd * gv[j].x * (1.f + scv.x) + shv.x; y.y = v[j].y * rstd * gv[j].y * (1.f + scv.y) + shv.y;
            y.z = v[j].z * rstd * gv[j].z * (1.f + scv.z) + shv.z; y.w = v[j].w * rstd * gv[j].w * (1.f + scv.w) + shv.w;
            o[64 * j] = (u32x2){pk2(y.x, y.y), pk2(y.z, y.w)};
        }
    }
}

DI void phase1(const Params& p, char* lds) {
    const bf16_t* H = (const bf16_t*)(p.ws + O_H);
    const bf16_t* W = (const bf16_t*)(p.ws + O_WIN);
    bf16_t* ZS = (bf16_t*)(p.ws + O_ZS);
    bf16_t* Gt = (bf16_t*)((unsigned char*)p.out + OO_G);
    constexpr int nM = T / 128, nN = NIN / 128, NTILES = nM * nN;
    const int lane = threadIdx.x & 63, wave = threadIdx.x >> 6, wm = wave >> 1, wn = wave & 1, r = lane & 15, g = lane >> 4;
    for (int L = blockIdx.x; L < NTILES; L += gridDim.x) {
        int pm, pn; tile_map(L, nN, NTILES, pm, pn);
        f32x4 acc[4][4]; zero_acc(acc);
        gemm_mainloop<128, 128, 2, 2>(acc, H + (size_t)pm * 128 * 1024, 1024, W + (size_t)pn * 128 * 1024, 1024, 1024, lds);
        const int col0 = pn * 128 + wn * 64 + g * 4;
#pragma unroll
        for (int mt = 0; mt < 4; ++mt) {
            const int m = pm * 128 + wm * 64 + mt * 16 + r;
#pragma unroll
            for (int nt = 0; nt < 4; ++nt) {
                const int n = col0 + nt * 16;
                const f32x4 a = acc[mt][nt];
                if (pn < NZ / 128) *(u32x2*)(ZS + (size_t)m * NZ + n) = (u32x2){pk2(a.x, a.y), pk2(a.z, a.w)};
                else *(u32x2*)(Gt + (size_t)m * 2048 + (n - NZ)) = (u32x2){pk2(sigmoidf_(a.x), sigmoidf_(a.y)), pk2(sigmoidf_(a.z), sigmoidf_(a.w))};
            }
        }
    }
}

template <int NCH>
DI float row_sumsq(const bf16_t* rowp, int g) {
    float s = 0.f;
#pragma unroll
    for (int c = 0; c < NCH; ++c) {
        const u32x4 v = *(const u32x4*)(rowp + (g * NCH + c) * 8);
#pragma unroll
        for (int e = 0; e < 4; ++e) { const float a = bflo(v[e]), b = bfhi(v[e]); s += a * a + b * b; }
    }
    return xor_reduce_g(s);
}

DI void phase2(const Params& p, char* lds) {
    unsigned char* ws = p.ws;
    const bf16_t* ZS = (const bf16_t*)(ws + O_ZS);
    const int tid = threadIdx.x, lane = tid & 63, wave = tid >> 6, r = lane & 15, g = lane >> 4;
    const float2* ropeA = (const float2*)(ws + O_ROPEA);
    const float2* ropeB = (const float2*)(ws + O_ROPEB);
    constexpr int NTL = T / 128;
    for (int it = blockIdx.x; it < NTL * 8; it += gridDim.x) {
        const int tile = it >> 3, sub = it & 7, t0 = tile * 128, b = t0 >> 12, s0 = t0 & (S - 1);
        {
            const int h = sub;
            f32x4 acc[2][6]; zero_acc(acc);
            gemm_mainloop<128, 96, 4, 1>(acc, ZS + (size_t)t0 * NZ + 768, NZ, (const bf16_t*)(ws + O_WUQ) + (size_t)h * 96 * 256, 256, 256, lds);
            const float* gq = p.in[15];
            const float qs = 0.10206207261596577f * LOG2E;
            bf16_t* QB = (bf16_t*)(ws + O_QB) + ((size_t)(b * 8 + h) * S) * 96;
#pragma unroll
            for (int mt = 0; mt < 2; ++mt) {
                const int ml = wave * 32 + mt * 16 + r, sp = s0 + ml;
                const float rstd = rsqrtf(row_sumsq<8>(ZS + (size_t)(t0 + ml) * NZ + 768, g) * (1.f / 256.f) + EPS);
                float ss = 0.f;
#pragma unroll
                for (int nt = 0; nt < 6; ++nt) { acc[mt][nt] = acc[mt][nt] * rstd; const f32x4 a = acc[mt][nt]; ss += (a.x * a.x + a.y * a.y) + (a.z * a.z + a.w * a.w); }
                const float r2 = rsqrtf(xor_reduce_g(ss) * (1.f / 96.f) + EPS);
#pragma unroll
                for (int nt = 0; nt < 6; ++nt) {
                    const f32x4 gg = *(const f32x4*)(gq + nt * 16 + g * 4);
                    acc[mt][nt] = acc[mt][nt] * r2 * gg;
                }
#pragma unroll
                for (int j = 0; j < 4; ++j) {
                    const float2 cs = ropeB[sp * 16 + g * 4 + j];
                    const float x1 = acc[mt][4][j], x2 = acc[mt][5][j];
                    acc[mt][4][j] = x1 * cs.x - x2 * cs.y;
                    acc[mt][5][j] = x1 * cs.y + x2 * cs.x;
                }
                bf16_t* qrow = QB + (size_t)sp * 96 + g * 4;
#pragma unroll
                for (int nt = 0; nt < 6; ++nt) { const f32x4 a = acc[mt][nt] * qs; *(u32x2*)(qrow + nt * 16) = (u32x2){pk2(a.x, a.y), pk2(a.z, a.w)}; }
                __builtin_amdgcn_sched_barrier(0);
            }
        }
    }
    for (int it = blockIdx.x; it < NTL * 4; it += gridDim.x) {
        const int tile = it >> 2, hp = it & 3, t0 = tile * 128, b = t0 >> 12, s0 = t0 & (S - 1);
        {
            f32x4 acc[4][4]; zero_acc(acc);
            gemm_mainloop<128, 128, 2, 2>(acc, ZS + (size_t)t0 * NZ + 1024, NZ,
                                          (const bf16_t*)(ws + O_WUKV) + (size_t)(hp * 128) * 128, 128, 128, lds);
            const int wm = wave >> 1, wn = wave & 1, h = hp * 2 + wn;
            {
                const float* gk = p.in[16];
                bf16_t* KB = (bf16_t*)(ws + O_KB) + ((size_t)(b * 8 + h) * S) * 96;
#pragma unroll
                for (int mt = 0; mt < 4; ++mt) {
                    const int ml = wm * 64 + mt * 16 + r, sp = s0 + ml;
                    const bf16_t* zrow = ZS + (size_t)(t0 + ml) * NZ;
                    const float rstd = rsqrtf(row_sumsq<4>(zrow + 1024, g) * (1.f / 128.f) + EPS);
                    const u32x2 k1 = *(const u32x2*)(zrow + 1152 + g * 4), k2 = *(const u32x2*)(zrow + 1168 + g * 4);
                    float x1[4] = {bflo(k1.x), bfhi(k1.x), bflo(k1.y), bfhi(k1.y)};
                    float x2[4] = {bflo(k2.x), bfhi(k2.x), bflo(k2.y), bfhi(k2.y)};
                    float ss = 0.f;
#pragma unroll
                    for (int j = 0; j < 4; ++j) ss += x1[j] * x1[j] + x2[j] * x2[j];
#pragma unroll
                    for (int nt = 0; nt < 4; ++nt) { acc[mt][nt] = acc[mt][nt] * rstd; const f32x4 a = acc[mt][nt]; ss += (a.x * a.x + a.y * a.y) + (a.z * a.z + a.w * a.w); }
                    const float r2 = rsqrtf(xor_reduce_g(ss) * (1.f / 96.f) + EPS);
                    bf16_t* krow = KB + (size_t)sp * 96 + g * 4;
#pragma unroll
                    for (int nt = 0; nt < 4; ++nt) {
                        const f32x4 gg = *(const f32x4*)(gk + nt * 16 + g * 4);
                        const f32x4 a = acc[mt][nt] * r2 * gg;
                        *(u32x2*)(krow + nt * 16) = (u32x2){pk2(a.x, a.y), pk2(a.z, a.w)};
                    }
                    const f32x4 g1 = *(const f32x4*)(gk + 64 + g * 4), g2 = *(const f32x4*)(gk + 80 + g * 4);
                    float o1[4], o2[4];
#pragma unroll
                    for (int j = 0; j < 4; ++j) {
                        const float2 cs = ropeB[sp * 16 + g * 4 + j];
                        const float y1 = x1[j] * r2 * g1[j], y2 = x2[j] * r2 * g2[j];
                        o1[j] = y1 * cs.x - y2 * cs.y; o2[j] = y1 * cs.y + y2 * cs.x;
                    }
                    *(u32x2*)(krow + 64) = (u32x2){pk2(o1[0], o1[1]), pk2(o1[2], o1[3])};
                    *(u32x2*)(krow + 80) = (u32x2){pk2(o2[0], o2[1]), pk2(o2[2], o2[3])};
                    __builtin_amdgcn_sched_barrier(0);
                }
            }
        }
    }
    for (int it = blockIdx.x; it < NTL * 4; it += gridDim.x) {
        const int tile = it >> 2, hp = it & 3, t0 = tile * 128, b = t0 >> 12, s0 = t0 & (S - 1);
        {
            f32x4 acc[4][4]; zero_acc(acc);
            gemm_mainloop<128, 128, 2, 2>(acc, ZS + (size_t)t0 * NZ + 1024, NZ,
                                          (const bf16_t*)(ws + O_WUKV) + (size_t)(512 + hp * 128) * 128, 128, 128, lds);
            const int wm = wave >> 1, wn = wave & 1, h = hp * 2 + wn;
            {
                bf16_t* VT = (bf16_t*)(ws + O_VTB) + ((size_t)(b * 8 + h) * 64) * S;
#pragma unroll
                for (int mt = 0; mt < 4; ++mt) {
                    const int ml = wm * 64 + mt * 16 + r, sp = s0 + ml;
                    const float rstd = rsqrtf(row_sumsq<4>(ZS + (size_t)(t0 + ml) * NZ + 1024, g) * (1.f / 128.f) + EPS);
                    const int ps = perm32(sp);
#pragma unroll
                    for (int nt = 0; nt < 4; ++nt)
#pragma unroll
                        for (int j = 0; j < 4; ++j) VT[(size_t)(nt * 16 + g * 4 + j) * S + ps] = f2bf(acc[mt][nt][j] * rstd);
                    __builtin_amdgcn_sched_barrier(0);
                }
            }
        }
    }
    __syncthreads();
    for (int tile = blockIdx.x; tile < NTL; tile += gridDim.x) {
        const int t0 = tile * 128, b = t0 >> 12, s0 = t0 & (S - 1);
        {
            const float* gqa = p.in[8];
            const float* gka = p.in[9];
            const int half = lane >> 5, i = lane & 31;
            const float qs = 0.125f * LOG2E;
            for (int tt = wave; tt < 128; tt += 4) {
                const int sp = s0 + tt;
                const bf16_t* zrow = ZS + (size_t)(t0 + tt) * NZ;
                const float2 cs = ropeA[sp * 32 + i];
#pragma unroll
                for (int hh = 0; hh < 10; hh += 2) {
                    const int hd = hh + half;
                    const float x1 = bf2f(zrow[hd * 64 + i]), x2 = bf2f(zrow[hd * 64 + 32 + i]);
                    float ss = x1 * x1 + x2 * x2;
#pragma unroll
                    for (int o = 1; o < 32; o <<= 1) ss += __shfl_xor(ss, o);
                    const float rr = rsqrtf(ss * (1.f / 64.f) + EPS);
                    const float* gg = hd < 8 ? gqa : gka;
                    const float y1 = x1 * rr * gg[i], y2 = x2 * rr * gg[32 + i];
                    float o1 = y1 * cs.x - y2 * cs.y, o2 = y1 * cs.y + y2 * cs.x;
                    bf16_t* dst;
                    if (hd < 8) { o1 *= qs; o2 *= qs; dst = (bf16_t*)(ws + O_QA) + ((size_t)(b * 8 + hd) * S + sp) * 64; }
                    else dst = (bf16_t*)(ws + O_KA) + ((size_t)(b * 2 + (hd - 8)) * S + sp) * 64;
                    dst[i] = f2bf(o1); dst[32 + i] = f2bf(o2);
                }
            }
            __syncthreads();
            bf16_t* tl = (bf16_t*)lds;
            for (int idx = tid; idx < 128 * 16; idx += 256) {
                const int tt = idx >> 4, c = idx & 15;
                const u32x4 v = *(const u32x4*)(ZS + (size_t)(t0 + tt) * NZ + 640 + c * 8);
                u32x2* d2 = (u32x2*)(tl + tt * 132 + c * 8);
                d2[0] = (u32x2){v.x, v.y}; d2[1] = (u32x2){v.z, v.w};
            }
            __syncthreads();
            bf16_t* VT = (bf16_t*)(ws + O_VTA) + ((size_t)(b * 2) * 64) * S;
            for (int idx = tid; idx < 128 * 128; idx += 256) {
                const int pp = idx & 127, dd = idx >> 7;
                const int lo = pp & 31;
                const int tt = (pp & ~31) | (((lo >> 2) & 1) << 4) | ((lo >> 3) << 2) | (lo & 3);
                VT[(size_t)dd * S + s0 + pp] = tl[tt * 132 + dd];
            }
            __syncthreads();
        }
    }
}

template <int DQK, bool WIN>
DI void attn_item(const bf16_t* __restrict__ Qw, const bf16_t* __restrict__ Kb, const bf16_t* __restrict__ Vt, int key0, int ntiles, int q0,
                  float shift2, float sink_term, bf16_t* __restrict__ Ow, int ldo, char* lds) {
    constexpr int KS = DQK / 32, CH = DQK / 8, KSTR = DQK * 2 + 32, NKL = CH * 64 / 256, VSTR = 160, STAGE = 64 * 224 + 64 * VSTR;
    const int tid = threadIdx.x, lane = tid & 63, r = lane & 15, g = lane >> 4;
    bf16x8 qf[2][KS];
#pragma unroll
    for (int qt = 0; qt < 2; ++qt)
#pragma unroll
        for (int ks = 0; ks < KS; ++ks) qf[qt][ks] = *(const bf16x8*)(Qw + (size_t)(qt * 16 + r) * DQK + ks * 32 + g * 8);
    f32x4 oacc[4][2];
#pragma unroll
    for (int i = 0; i < 4; ++i) { oacc[i][0] = (f32x4){0.f, 0.f, 0.f, 0.f}; oacc[i][1] = (f32x4){0.f, 0.f, 0.f, 0.f}; }
    float lsum[2] = {0.f, 0.f};
    u32x4 rk[NKL], rv[2];
    int krow[NKL], kc[NKL];
#pragma unroll
    for (int i = 0; i < NKL; ++i) { const int idx = tid + 256 * i; krow[i] = idx / CH; kc[i] = idx % CH; }
    const int vrow = tid >> 3, vc = tid & 7;
    auto gload = [&](int tile) {
        const int kb = key0 + tile * 64;
#pragma unroll
        for (int i = 0; i < NKL; ++i) rk[i] = *(const u32x4*)(Kb + (size_t)(kb + krow[i]) * DQK + kc[i] * 8);
#pragma unroll
        for (int i = 0; i < 2; ++i) rv[i] = *(const u32x4*)(Vt + (size_t)(vrow + 32 * i) * S + kb + vc * 8);
    };
    auto lstore = [&](int st) {
        char* sK = lds + st * STAGE; char* sV = sK + 64 * 224;
#pragma unroll
        for (int i = 0; i < NKL; ++i) *(u32x4*)(sK + krow[i] * KSTR + kc[i] * 16) = rk[i];
#pragma unroll
        for (int i = 0; i < 2; ++i) *(u32x4*)(sV + (vrow + 32 * i) * VSTR + vc * 16) = rv[i];
    };
    __syncthreads();
    gload(0); lstore(0);
    __syncthreads();
    for (int tile = 0; tile < ntiles; ++tile) {
        const int cur = tile & 1;
        const bool more = tile + 1 < ntiles;
        if (more) gload(tile + 1);
        const char* sK = lds + cur * STAGE; const char* sV = sK + 64 * 224;
        f32x4 sacc[4][2];
#pragma unroll
        for (int kt = 0; kt < 4; ++kt) {
            sacc[kt][0] = (f32x4){0.f, 0.f, 0.f, 0.f}; sacc[kt][1] = (f32x4){0.f, 0.f, 0.f, 0.f};
#pragma unroll
            for (int ks = 0; ks < KS; ++ks) {
                const bf16x8 kf = *(const bf16x8*)(sK + (kt * 16 + r) * KSTR + (ks * 4 + g) * 16);
                sacc[kt][0] = __builtin_amdgcn_mfma_f32_16x16x32_bf16(kf, qf[0][ks], sacc[kt][0], 0, 0, 0);
                sacc[kt][1] = __builtin_amdgcn_mfma_f32_16x16x32_bf16(kf, qf[1][ks], sacc[kt][1], 0, 0, 0);
            }
        }
        const int kbase = key0 + tile * 64 + g * 4;
#pragma unroll
        for (int kt = 0; kt < 4; ++kt)
#pragma unroll
            for (int qt = 0; qt < 2; ++qt)
#pragma unroll
                for (int j = 0; j < 4; ++j) {
                    float pv = fast_exp2(sacc[kt][qt][j] - shift2);
                    if (WIN) { const int dlt = (kbase + kt * 16 + j) - (q0 + qt * 16 + r); if (dlt > 128 || dlt < -128) pv = 0.f; }
                    sacc[kt][qt][j] = pv; lsum[qt] += pv;
                }
#pragma unroll
        for (int kk = 0; kk < 2; ++kk) {
            bf16x8 pb[2];
#pragma unroll
            for (int qt = 0; qt < 2; ++qt) {
                u32x4 u;
                u.x = pk2(sacc[2 * kk][qt][0], sacc[2 * kk][qt][1]); u.y = pk2(sacc[2 * kk][qt][2], sacc[2 * kk][qt][3]);
                u.z = pk2(sacc[2 * kk + 1][qt][0], sacc[2 * kk + 1][qt][1]); u.w = pk2(sacc[2 * kk + 1][qt][2], sacc[2 * kk + 1][qt][3]);
                pb[qt] = __builtin_bit_cast(bf16x8, u);
            }
#pragma unroll
            for (int dt = 0; dt < 4; ++dt) {
                const bf16x8 vf = *(const bf16x8*)(sV + (dt * 16 + r) * VSTR + (kk * 4 + g) * 16);
                oacc[dt][0] = __builtin_amdgcn_mfma_f32_16x16x32_bf16(vf, pb[0], oacc[dt][0], 0, 0, 0);
                oacc[dt][1] = __builtin_amdgcn_mfma_f32_16x16x32_bf16(vf, pb[1], oacc[dt][1], 0, 0, 0);
            }
        }
        if (more) lstore(cur ^ 1);
        __syncthreads();
    }
#pragma unroll
    for (int qt = 0; qt < 2; ++qt) {
        const float inv = fast_rcp(xor_reduce_g(lsum[qt]) + sink_term);
        bf16_t* orow = Ow + (size_t)(qt * 16 + r) * ldo + g * 4;
#pragma unroll
        for (int dt = 0; dt < 4; ++dt) { const f32x4 a = oacc[dt][qt] * inv; *(u32x2*)(orow + dt * 16) = (u32x2){pk2(a.x, a.y), pk2(a.z, a.w)}; }
    }
}

DI float max_abs(const float* v, int n) { float m = 0.f; for (int i = 0; i < n; ++i) m = fmaxf(m, fabsf(v[i])); return m; }

DI void phase3(const Params& p, char* lds) {
    unsigned char* ws = p.ws;
    const int wave = threadIdx.x >> 6;
    const float shiftB = 9.797958971132712f * max_abs(p.in[15], 96) * max_abs(p.in[16], 96) * LOG2E;
    const float shiftA = 8.f * max_abs(p.in[8], 64) * max_abs(p.in[9], 64) * LOG2E;
    bf16_t* OA = (bf16_t*)(p.ws + O_OA);
    bf16_t* OB = (bf16_t*)(p.ws + O_OB);
    constexpr int NB_ITEMS = 24 * 8 * 32, NA_ITEMS = 24 * 2 * 128;
    for (int L = blockIdx.x; L < NB_ITEMS; L += gridDim.x) {
        const int idx = (L & 7) * (NB_ITEMS / 8) + (L >> 3);
        const int bh = idx >> 5, qb = idx & 31, b = bh >> 3, h = bh & 7;
        const int q0 = qb * 128 + wave * 32;
        attn_item<96, false>((const bf16_t*)(ws + O_QB) + ((size_t)bh * S + q0) * 96, (const bf16_t*)(ws + O_KB) + (size_t)bh * S * 96,
                             (const bf16_t*)(ws + O_VTB) + (size_t)bh * 64 * S, 0, S / 64, q0, shiftB, 0.f,
                             OB + ((size_t)b * S + q0) * 512 + h * 64, 512, lds);
    }
    for (int L = blockIdx.x; L < NA_ITEMS; L += gridDim.x) {
        const int idx = (L & 7) * (NA_ITEMS / 8) + (L >> 3);
        const int bk = idx >> 7, qb = idx & 127, b = bk >> 1, kvh = bk & 1;
        const int q0 = qb * 32, hd = kvh * 4 + wave;
        int ks = (q0 - 128) & ~63; if (ks < 0) ks = 0;
        int ke = (q0 + 32 + 128 + 63) & ~63; if (ke > S) ke = S;
        const float sink_term = fast_exp2(p.in[10][hd] * LOG2E - shiftA);
        attn_item<64, true>((const bf16_t*)(ws + O_QA) + ((size_t)(b * 8 + hd) * S + q0) * 64, (const bf16_t*)(ws + O_KA) + (size_t)bk * S * 64,
                            (const bf16_t*)(ws + O_VTA) + (size_t)bk * 64 * S, ks, (ke - ks) >> 6, q0, shiftA, sink_term,
                            OA + ((size_t)b * S + q0) * 512 + hd * 64, 512, lds);
    }
}

DI void phase4(const Params& p, char* lds) {
    const bf16_t* OA = (const bf16_t*)(p.ws + O_OA);
    const bf16_t* OB = (const bf16_t*)(p.ws + O_OB);
    const bf16_t* Gt = (const bf16_t*)((unsigned char*)p.out + OO_G);
    bf16_t* MIX = (bf16_t*)(p.ws + O_ZS);
    constexpr int nM = T / 128, nN = 8, NTILES = nM * nN;
    const int lane = threadIdx.x & 63, wave = threadIdx.x >> 6, wm = wave >> 1, wn = wave & 1, r = lane & 15, g = lane >> 4;
    for (int L = blockIdx.x; L < NTILES; L += gridDim.x) {
        int pm, pn; tile_map(L, nN, NTILES, pm, pn);
        f32x4 acc[4][4]; u32x2 mixp[4][4]; zero_acc(acc);
        gemm_mainloop<128, 128, 2, 2>(acc, OA + (size_t)pm * 128 * 512, 512, (const bf16_t*)(p.ws + O_WOA) + (size_t)pn * 128 * 512, 512, 512, lds);
        const int col0 = pn * 128 + wn * 64 + g * 4;
#pragma unroll
        for (int mt = 0; mt < 4; ++mt) {
            const int m = pm * 128 + wm * 64 + mt * 16 + r;
#pragma unroll
            for (int nt = 0; nt < 4; ++nt) {
                const u32x2 gv = *(const u32x2*)(Gt + (size_t)m * 2048 + col0 + nt * 16);
                const f32x4 a = acc[mt][nt];
                mixp[mt][nt] = (u32x2){pk2(a.x * bflo(gv.x), a.y * bfhi(gv.x)), pk2(a.z * bflo(gv.y), a.w * bfhi(gv.y))};
            }
        }
        zero_acc(acc);
        gemm_mainloop<128, 128, 2, 2>(acc, OB + (size_t)pm * 128 * 512, 512, (const bf16_t*)(p.ws + O_WOB) + (size_t)pn * 128 * 512, 512, 512, lds);
#pragma unroll
        for (int mt = 0; mt < 4; ++mt) {
            const int m = pm * 128 + wm * 64 + mt * 16 + r;
#pragma unroll
            for (int nt = 0; nt < 4; ++nt) {
                const u32x2 gv = *(const u32x2*)(Gt + (size_t)m * 2048 + 1024 + col0 + nt * 16);
                const f32x4 a = acc[mt][nt]; const u32x2 mx = mixp[mt][nt];
                const float o0 = bflo(mx.x) + a.x * bflo(gv.x), o1 = bfhi(mx.x) + a.y * bfhi(gv.x), o2 = bflo(mx.y) + a.z * bflo(gv.y), o3 = bfhi(mx.y) + a.w * bfhi(gv.y);
                *(u32x2*)(MIX + (size_t)m * 1024 + col0 + nt * 16) = (u32x2){pk2(o0, o1), pk2(o2, o3)};
            }
        }
    }
}

DI void phase5(const Params& p, char* lds) {
    const bf16_t* MIX = (const bf16_t*)(p.ws + O_ZS);
    const float* mod = (const float*)(p.ws + O_MOD);
    constexpr int nM = T / 128, nN = 8, NTILES = nM * nN;
    const int lane = threadIdx.x & 63, wave = threadIdx.x >> 6, wm = wave >> 1, wn = wave & 1, r = lane & 15, g = lane >> 4;
    for (int L = blockIdx.x; L < NTILES; L += gridDim.x) {
        int pm, pn; tile_map(L, nN, NTILES, pm, pn);
        f32x4 acc[4][4]; zero_acc(acc);
        gemm_mainloop<128, 128, 2, 2>(acc, MIX + (size_t)pm * 128 * 1024, 1024, (const bf16_t*)(p.ws + O_WOUT) + (size_t)pn * 128 * 1024, 1024, 1024, lds);
        const int col0 = pn * 128 + wn * 64 + g * 4;
        const int b = (pm * 128) >> 12;
        const float* gt1 = mod + (size_t)b * 6144 + 2048;
#pragma unroll
        for (int mt = 0; mt < 4; ++mt) {
            const int m = pm * 128 + wm * 64 + mt * 16 + r;
            const float* xr = xrow_ptr(p, m);
#pragma unroll
            for (int nt = 0; nt < 4; ++nt) {
                const int n = col0 + nt * 16;
                const f32x4 xv = *(const f32x4*)(xr + n), gv = *(const f32x4*)(gt1 + n);
                *(f32x4*)(p.out + (size_t)m * D + n) = xv + gv * acc[mt][nt];
            }
        }
    }
}

DI void phase7(const Params& p, char* lds, int chunk) {
    const bf16_t* H2 = (const bf16_t*)(p.ws + O_H) + (size_t)chunk * TCH * 1024;
    bf16_t* UP = (bf16_t*)(p.ws + O_UP);
    constexpr int nM = TCH / 128, nN = NUP / 128, NTILES = nM * nN;
    const int lane = threadIdx.x & 63, wave = threadIdx.x >> 6, wm = wave >> 1, wn = wave & 1, r = lane & 15, g = lane >> 4;
    for (int L = blockIdx.x; L < NTILES; L += gridDim.x) {
        int pm, pn; tile_map(L, nN, NTILES, pm, pn);
        f32x4 acc[4][4]; zero_acc(acc);
        gemm_mainloop<128, 128, 2, 2>(acc, H2 + (size_t)pm * 128 * 1024, 1024, (const bf16_t*)(p.ws + O_WUP) + (size_t)pn * 128 * 1024, 1024, 1024, lds);
        const int col0 = pn * 128 + wn * 64 + g * 4;
#pragma unroll
        for (int mt = 0; mt < 4; ++mt) {
            const int m = pm * 128 + wm * 64 + mt * 16 + r;
#pragma unroll
            for (int nt = 0; nt < 4; ++nt) {
                const f32x4 a = acc[mt][nt];
                *(u32x2*)(UP + (size_t)m * NUP + col0 + nt * 16) = (u32x2){pk2(a.x, a.y), pk2(a.z, a.w)};
            }
        }
    }
}

DI void unpack8(const u32x4 v, float (&f)[8]) {
    f[0] = bflo(v.x); f[1] = bfhi(v.x); f[2] = bflo(v.y); f[3] = bfhi(v.y); f[4] = bflo(v.z); f[5] = bfhi(v.z); f[6] = bflo(v.w); f[7] = bfhi(v.w);
}

DI void phase7b(const Params& p) {
    const bf16_t* UP = (const bf16_t*)(p.ws + O_UP);
    bf16_t* ACT = (bf16_t*)(p.ws + O_ACT);
    const float* cw = p.in[22];
    const float* cb = p.in[23];
    const int gt = blockIdx.x * 256 + threadIdx.x, NGT = gridDim.x * 256;
    constexpr int CPR = DFF / 8;
    for (int i = gt; i < TCH * CPR; i += NGT) {
        const int tl = i / CPR, c = (i % CPR) * 8;
        const int sp = tl & (S - 1);
        const bool hp = sp > 0, hn = sp < S - 1;
        float ua[8], ug[8];
#pragma unroll
        for (int half = 0; half < 2; ++half) {
            const int col = c + half * DFF;
            const bf16_t* u = UP + (size_t)tl * NUP + col;
            float x0[8], x1[8], x2[8];
            unpack8(*(const u32x4*)u, x1);
            if (hp) unpack8(*(const u32x4*)(u - NUP), x0);
            if (hn) unpack8(*(const u32x4*)(u + NUP), x2);
            float* dst = half ? ug : ua;
#pragma unroll
            for (int e = 0; e < 8; ++e) {
                float v = cb[col + e] + cw[NUP + col + e] * x1[e];
                if (hp) v += cw[col + e] * x0[e];
                if (hn) v += cw[2 * NUP + col + e] * x2[e];
                dst[e] = v;
            }
        }
        u32x4 o;
        float a[8];
#pragma unroll
        for (int e = 0; e < 8; ++e) a[e] = ug[e] * sigmoidf_(ug[e]) * ua[e];
        o.x = pk2(a[0], a[1]); o.y = pk2(a[2], a[3]); o.z = pk2(a[4], a[5]); o.w = pk2(a[6], a[7]);
        *(u32x4*)(ACT + (size_t)tl * DFF + c) = o;
    }
}

DI void phase8(const Params& p, char* lds, int chunk) {
    const bf16_t* ACT = (const bf16_t*)(p.ws + O_ACT);
    const float* mod = (const float*)(p.ws + O_MOD);
    constexpr int nM = TCH / 128, nN = 8, NTILES = nM * nN;
    const int lane = threadIdx.x & 63, wave = threadIdx.x >> 6, wm = wave >> 1, wn = wave & 1, r = lane & 15, g = lane >> 4;
    for (int L = blockIdx.x; L < NTILES; L += gridDim.x) {
        int pm, pn; tile_map(L, nN, NTILES, pm, pn);
        f32x4 acc[4][4]; zero_acc(acc);
        gemm_mainloop<128, 128, 2, 2>(acc, ACT + (size_t)pm * 128 * DFF, DFF, (const bf16_t*)(p.ws + O_WDN) + (size_t)pn * 128 * DFF, DFF, DFF, lds);
        const int col0 = pn * 128 + wn * 64 + g * 4;
        const int mg0 = chunk * TCH + pm * 128;
        const int b = mg0 >> 12;
        const float* gt2 = mod + (size_t)b * 6144 + 5120;
#pragma unroll
        for (int mt = 0; mt < 4; ++mt) {
            const int m = mg0 + wm * 64 + mt * 16 + r;
#pragma unroll
            for (int nt = 0; nt < 4; ++nt) {
                const int n = col0 + nt * 16;
                float* op = p.out + (size_t)m * D + n;
                const f32x4 xv = *(const f32x4*)op, gv = *(const f32x4*)(gt2 + n);
                *(f32x4*)op = xv + gv * acc[mt][nt];
            }
        }
    }
}

__global__ void __launch_bounds__(256, 2) fwd_megakernel(Params p) {
    __shared__ __attribute__((aligned(16))) char lds[65536];
    cg::grid_group grid = cg::this_grid();
#if PM & 1
    phase0(p, lds);
#endif
    grid.sync();
#if PM & 2
    phase0m(p);
#endif
    grid.sync();
#if PM & 4
    norm_pass(p, false, (bf16_t*)(p.ws + O_H));
#endif
    grid.sync();
#if PM & 8
    phase1(p, lds);
#endif
    grid.sync();
#if PM & 16
    phase2(p, lds);
#endif
    grid.sync();
#if PM & 32
    phase3(p, lds);
#endif
    grid.sync();
#if PM & 64
    phase4(p, lds);
#endif
    grid.sync();
#if PM & 128
    phase5(p, lds);
#endif
    grid.sync();
#if PM & 256
    norm_pass(p, true, (bf16_t*)(p.ws + O_H));
#endif
    grid.sync();
    for (int c = 0; c < NCHUNK; ++c) {
#if PM & 512
        phase7(p, lds, c);
#endif
        grid.sync();
#if PM & 1024
        phase7b(p);
#endif
        grid.sync();
#if PM & 2048
        phase8(p, lds, c);
#endif
        if (c + 1 < NCHUNK) grid.sync();
    }
}

extern "C" void kernel_launch(void* const* d_in, const int* in_sizes, int n_in, void* d_out, int out_size, void* d_ws, size_t ws_size,
                              hipStream_t stream) {
    static int grid_blocks = 0;
    if (!grid_blocks) {
        int dev = 0, cus = 0, per_cu = 0;
        hipGetDevice(&dev);
        hipDeviceGetAttribute(&cus, hipDeviceAttributeMultiprocessorCount, dev);
        hipOccupancyMaxActiveBlocksPerMultiprocessor(&per_cu, fwd_megakernel, 256, 0);
        if (per_cu < 1) per_cu = 1;
        if (per_cu > 2) per_cu = 2;
        grid_blocks = cus * per_cu;
        if (n_in != 25 || ws_size < WS_NEED || out_size != T * D)
            fprintf(stderr, "kernel_launch: unexpected sizes n_in=%d ws=%zu out=%d\n", n_in, ws_size, out_size);
    }
    Params p{};
    for (int i = 0; i < 25; ++i) p.in[i] = (const float*)d_in[i];
    p.out = (float*)d_out;
    p.ws = (unsigned char*)d_ws;
    void* args[] = {&p};
    hipError_t e = hipLaunchCooperativeKernel((void*)fwd_megakernel, dim3(grid_blocks), dim3(256), args, 0, stream);
    if (e != hipSuccess) fprintf(stderr, "cooperative launch failed: %s (grid %d)\n", hipGetErrorString(e), grid_blocks);
}
```

```cpp
#include <hip/hip_runtime.h>
#include <hip/hip_cooperative_groups.h>
#include <cstdio>
#include <cstdint>
namespace cg = cooperative_groups;
#ifndef PM
#define PM 4095
#endif
#ifndef DUP
#define DUP 0
#define XSYNC 0
#endif

typedef unsigned short bf16_t;
typedef short bf16x8 __attribute__((ext_vector_type(8)));
typedef float f32x4 __attribute__((ext_vector_type(4)));
typedef unsigned u32x4 __attribute__((ext_vector_type(4)));
typedef unsigned u32x2 __attribute__((ext_vector_type(2)));
#define DI __device__ __forceinline__

constexpr int D = 1024, S = 4096, NBATCH = 24, T = NBATCH * S;
constexpr int T_PROMPT = 8 * S;
constexpr int IN_TOTAL = 3232, NZ = 1280  , NIN = NZ + 2048;
constexpr int DFF = 2816, NUP = 2 * DFF;
constexpr float EPS = 1e-6f;
constexpr float LOG2E = 1.4426950408889634f;
constexpr int NCHUNK = 4, TCH = T / NCHUNK;

constexpr size_t MiB = 1024ull * 1024ull;
constexpr size_t O_WIN = 0;
constexpr size_t O_WUQ = O_WIN + (size_t)NIN * 1024 * 2;
constexpr size_t O_WUKV = O_WUQ + 768ull * 256 * 2;
constexpr size_t O_WOA = O_WUKV + 1024ull * 128 * 2;
constexpr size_t O_WOB = O_WOA + 1024ull * 512 * 2;
constexpr size_t O_WOUT = O_WOB + 1024ull * 512 * 2;
constexpr size_t O_WUP = O_WOUT + 1024ull * 1024 * 2;
constexpr size_t O_WDN = O_WUP + (size_t)NUP * 1024 * 2;
constexpr size_t O_MODP = O_WDN + 1024ull * DFF * 2;
constexpr size_t O_MOD = O_MODP + 16ull * 24 * 6144 * 4;
constexpr size_t O_ROPEA = O_MOD + 24ull * 6144 * 4;
constexpr size_t O_ROPEB = O_ROPEA + 4096ull * 32 * 8;
constexpr size_t O_WB_END = O_ROPEB + 4096ull * 16 * 8;
static_assert(O_WB_END <= 48 * MiB, "weights region");
constexpr size_t O_ZS = 48 * MiB;
constexpr size_t O_QA = 288 * MiB;
constexpr size_t O_KA = O_QA + 96 * MiB;
constexpr size_t O_VTA = O_KA + 24 * MiB;
constexpr size_t O_QB = O_VTA + 24 * MiB;
constexpr size_t O_KB = O_QB + 144 * MiB;
constexpr size_t O_VTB = O_KB + 144 * MiB;
constexpr size_t O_H = 816 * MiB;
constexpr size_t O_UP = 288 * MiB;
constexpr size_t O_ACT = 552 * MiB;
constexpr size_t WS_NEED = 1008 * MiB;
static_assert(O_VTB + 96 * MiB <= O_H, "qkv region");
constexpr size_t OO_G = 0, O_OA = O_H, O_OB = O_H + 96 * MiB;

struct Params {
    const float* in[25];
    float* out;
    unsigned char* ws;
};

typedef __bf16 bf16x2_t __attribute__((ext_vector_type(2)));
typedef float f32x2_t __attribute__((ext_vector_type(2)));
DI unsigned pk2(float lo, float hi) { const f32x2_t v = {lo, hi}; return __builtin_bit_cast(unsigned, __builtin_convertvector(v, bf16x2_t)); }
DI float bflo(unsigned u) { return __uint_as_float(u << 16); }
DI float bfhi(unsigned u) { return __uint_as_float(u & 0xffff0000u); }
DI float bf2f(bf16_t v) { return __uint_as_float(((unsigned)v) << 16); }
DI bf16_t f2bf(float v) { return (bf16_t)(pk2(v, v) & 0xffffu); }
DI float fast_rcp(float x) { return __builtin_amdgcn_rcpf(x); }
DI float fast_exp2(float x) { return __builtin_amdgcn_exp2f(x); }
DI float sigmoidf_(float v) { return fast_rcp(1.f + fast_exp2(-v * LOG2E)); }
DI float xor_reduce_g(float v) { v += __shfl_xor(v, 16); v += __shfl_xor(v, 32); return v; }
DI float wave_sum(float v) {
#pragma unroll
    for (int o = 1; o < 64; o <<= 1) v += __shfl_xor(v, o);
    return v;
}
DI int perm32(int s) { const int lo = s & 31; return (s & ~31) | (((lo >> 2) & 3) << 3) | ((lo >> 4) << 2) | (lo & 3); }
DI const float* xrow_ptr(const Params& p, int t) { return t < T_PROMPT ? p.in[0] + (size_t)t * D : p.in[1] + (size_t)(t - T_PROMPT) * D; }

DI void tile_map(int L, int nN, int ntiles, int& pm, int& pn) {
    const int xcd = L & 7, q = L >> 3;
    const int Lp = xcd * (ntiles >> 3) + q;
    const int grp = Lp / (8 * nN), rem = Lp % (8 * nN);
    pm = grp * 8 + (rem & 7); pn = rem >> 3;
}

template <int BM, int BN, int NWM, int NWN>
DI void gemm_mainloop(f32x4 (&acc)[BM / NWM / 16][BN / NWN / 16], const bf16_t* __restrict__ A, int lda,
                      const bf16_t* __restrict__ B, int ldb, int K, char* lds) {
    constexpr int MT = BM / NWM / 16, NT = BN / NWN / 16, NA = BM / 32, NB = BN / 32, STAGE = (BM + BN) * 128;
    const int tid = threadIdx.x, lane = tid & 63, wave = tid >> 6;
    const int wm = wave / NWN, wn = wave % NWN;
    const int r = lane & 15, g = lane >> 4;
    const int lr = tid >> 3, lc = tid & 7;
    const int lsw = (lc ^ ((lr >> 1) & 7)) * 16;
    u32x4 ra[NA], rb[NB];
    const bf16_t* Ap = A + (size_t)lr * lda + lc * 8;
    const bf16_t* Bp = B + (size_t)lr * ldb + lc * 8;
    const int nk = K >> 6;
#pragma unroll
    for (int i = 0; i < NA; ++i) ra[i] = *(const u32x4*)(Ap + (size_t)(32 * i) * lda);
#pragma unroll
    for (int i = 0; i < NB; ++i) rb[i] = *(const u32x4*)(Bp + (size_t)(32 * i) * ldb);
#pragma unroll
    for (int i = 0; i < NA; ++i) *(u32x4*)(lds + (lr + 32 * i) * 128 + lsw) = ra[i];
#pragma unroll
    for (int i = 0; i < NB; ++i) *(u32x4*)(lds + BM * 128 + (lr + 32 * i) * 128 + lsw) = rb[i];
    __syncthreads();
    const int rsw = (r >> 1) & 7;
    for (int kt = 0; kt < nk; ++kt) {
        const int cur = kt & 1;
        const bool more = (kt + 1 < nk);
        if (more) {
#pragma unroll
            for (int i = 0; i < NA; ++i) ra[i] = *(const u32x4*)(Ap + (size_t)(32 * i) * lda + (kt + 1) * 64);
#pragma unroll
            for (int i = 0; i < NB; ++i) rb[i] = *(const u32x4*)(Bp + (size_t)(32 * i) * ldb + (kt + 1) * 64);
        }
        const char* sA = lds + cur * STAGE;
        const char* sB = sA + BM * 128;
#pragma unroll
        for (int ks = 0; ks < 2; ++ks) {
            bf16x8 wf[NT], xf[MT];
            const int co = ((ks * 4 + g) ^ rsw) * 16;
#pragma unroll
            for (int nt = 0; nt < NT; ++nt) wf[nt] = *(const bf16x8*)(sB + (wn * (NT * 16) + nt * 16 + r) * 128 + co);
#pragma unroll
            for (int mt = 0; mt < MT; ++mt) xf[mt] = *(const bf16x8*)(sA + (wm * (MT * 16) + mt * 16 + r) * 128 + co);
#pragma unroll
            for (int mt = 0; mt < MT; ++mt)
#pragma unroll
                for (int nt = 0; nt < NT; ++nt) acc[mt][nt] = __builtin_amdgcn_mfma_f32_16x16x32_bf16(wf[nt], xf[mt], acc[mt][nt], 0, 0, 0);
        }
        if (more) {
            char* dA = lds + (cur ^ 1) * STAGE;
#pragma unroll
            for (int i = 0; i < NA; ++i) *(u32x4*)(dA + (lr + 32 * i) * 128 + lsw) = ra[i];
#pragma unroll
            for (int i = 0; i < NB; ++i) *(u32x4*)(dA + BM * 128 + (lr + 32 * i) * 128 + lsw) = rb[i];
        }
        __syncthreads();
    }
}

template <int MT, int NT>
DI void zero_acc(f32x4 (&acc)[MT][NT]) {
#pragma unroll
    for (int i = 0; i < MT; ++i)
#pragma unroll
        for (int j = 0; j < NT; ++j) acc[i][j] = (f32x4){0.f, 0.f, 0.f, 0.f};
}

DI void transpose_item(const float* __restrict__ W, int K, int N, bf16_t* __restrict__ WT, int mode, const float* __restrict__ scale,
                       float* scr, int item, int lane) {
    const int nblk = N >> 5, kb = item / nblk, nb = item % nblk, k0 = kb * 64, n0 = nb * 32;
#pragma unroll 8
    for (int i = 0; i < 32; ++i) {
        const int kk = 2 * i + (lane >> 5);
        float v = W[(size_t)(k0 + kk) * N + n0 + (lane & 31)];
        if (scale) v *= scale[k0 + kk];
        scr[kk * 33 + (lane & 31)] = v;
    }
    asm volatile("s_waitcnt lgkmcnt(0)" ::: "memory");
    const int c = lane & 7;
#pragma unroll
    for (int j = 0; j < 4; ++j) {
        const int nl = (lane >> 3) + 8 * j;
        const float* s = scr + (8 * c) * 33 + nl;
        u32x4 o;
        o.x = pk2(s[0 * 33], s[1 * 33]); o.y = pk2(s[2 * 33], s[3 * 33]); o.z = pk2(s[4 * 33], s[5 * 33]); o.w = pk2(s[6 * 33], s[7 * 33]);
        const int n = n0 + nl;
        int row;
        if (mode == 1) row = n < 1184 ? n : n + 96;
        else if (mode == 2) { const int h = n >> 7, jj = n & 127; row = jj < 64 ? h * 64 + jj : 512 + h * 64 + (jj - 64); }
        else row = n;
        *(u32x4*)(WT + (size_t)row * K + k0 + 8 * c) = o;
    }
    asm volatile("s_waitcnt lgkmcnt(0)" ::: "memory");
}

DI void phase0(const Params& p, char* lds) {
    const int tid = threadIdx.x, bid = blockIdx.x, G = gridDim.x, lane = tid & 63, wave = tid >> 6;
    unsigned char* ws = p.ws;
    float* sc = (float*)lds;
    for (int it = bid; it < 384; it += G) {
        const int cb = it % 24, ks = it / 24;
        __syncthreads();
        for (int i = tid; i < 24 * 64; i += 256) {
            const int b = i >> 6, k = i & 63;
            const float* c = b < 8 ? p.in[2] + b * 1024 : p.in[3] + (b - 8) * 1024;
            const float v = c[ks * 64 + k];
            sc[i] = v * sigmoidf_(v);
        }
        __syncthreads();
        float a[24];
#pragma unroll
        for (int b = 0; b < 24; ++b) a[b] = 0.f;
        const int n = cb * 256 + tid;
        const float* w = p.in[4] + (size_t)(ks * 64) * 6144 + n;
        for (int k = 0; k < 64; ++k) {
            const float wv = w[(size_t)k * 6144];
#pragma unroll
            for (int b = 0; b < 24; ++b) a[b] += sc[b * 64 + k] * wv;
        }
        float* mp = (float*)(ws + O_MODP) + (size_t)(ks * 24) * 6144 + n;
#pragma unroll
        for (int b = 0; b < 24; ++b) mp[(size_t)b * 6144] = a[b];
    }
    __syncthreads();
    {
        float* scr = (float*)(lds + wave * 8448);
        const int gw = bid * 4 + wave, NGW = G * 4;
        constexpr int I0 = 16 * 101, I1 = 4 * 24, I2 = 2 * 32, I3 = 8 * 32, I4 = 8 * 32, I5 = 16 * 32, I6 = 16 * 176, I7 = 44 * 32;
        constexpr int NI = I0 + I1 + I2 + I3 + I4 + I5 + I6 + I7;
        for (int it = gw; it < NI; it += NGW) {
            int q = it;
            if (q < I0) { transpose_item(p.in[7], 1024, IN_TOTAL, (bf16_t*)(ws + O_WIN), 1, nullptr, scr, q, lane); continue; } q -= I0;
            if (q < I1) { transpose_item(p.in[12], 256, 768, (bf16_t*)(ws + O_WUQ), 0, p.in[11], scr, q, lane); continue; } q -= I1;
            if (q < I2) { transpose_item(p.in[14], 128, 1024, (bf16_t*)(ws + O_WUKV), 2, p.in[13], scr, q, lane); continue; } q -= I2;
            if (q < I3) { transpose_item(p.in[17], 512, 1024, (bf16_t*)(ws + O_WOA), 0, nullptr, scr, q, lane); continue; } q -= I3;
            if (q < I4) { transpose_item(p.in[18], 512, 1024, (bf16_t*)(ws + O_WOB), 0, nullptr, scr, q, lane); continue; } q -= I4;
            if (q < I5) { transpose_item(p.in[19], 1024, 1024, (bf16_t*)(ws + O_WOUT), 0, nullptr, scr, q, lane); continue; } q -= I5;
            if (q < I6) { transpose_item(p.in[21], 1024, NUP, (bf16_t*)(ws + O_WUP), 0, nullptr, scr, q, lane); continue; } q -= I6;
            transpose_item(p.in[24], DFF, 1024, (bf16_t*)(ws + O_WDN), 0, nullptr, scr, q, lane);
        }
    }
    const int gt = bid * 256 + tid, NGT = G * 256;
    for (int i = gt; i < 4096 * 48; i += NGT) {
        const int pos = i / 48, j = i % 48;
        float inv;
        if (j < 32) inv = exp2f(-(float)(2 * j) * (1.f / 64.f) * 13.287712379549449f);
        else inv = exp2f(-(float)(2 * (j - 32)) * (1.f / 32.f) * 13.287712379549449f);
        const float ang = (float)pos * inv;
        float rev = ang * 0.15915494309189535f;
        rev -= floorf(rev);
        const float sn = __builtin_amdgcn_sinf(rev), cs = __builtin_amdgcn_cosf(rev);
        float2* dst = j < 32 ? (float2*)(ws + O_ROPEA) + pos * 32 + j : (float2*)(ws + O_ROPEB) + pos * 16 + (j - 32);
        *dst = make_float2(cs, sn);
    }
    for (int i = gt; i < 96 * 1024 / 8; i += NGT) *(u32x4*)((bf16_t*)(ws + O_WIN) + 1184 * 1024 + (size_t)i * 8) = (u32x4){0u, 0u, 0u, 0u};
}

DI void phase0m(const Params& p) {
    const int gt = blockIdx.x * 256 + threadIdx.x, NGT = gridDim.x * 256;
    const float* mp = (const float*)(p.ws + O_MODP);
    float* mod = (float*)(p.ws + O_MOD);
    for (int i = gt; i < 24 * 6144; i += NGT) {
        float s = p.in[5][i % 6144];
#pragma unroll
        for (int ks = 0; ks < 16; ++ks) s += mp[(size_t)ks * 24 * 6144 + i];
        mod[i] = s;
    }
}

DI void norm_pass(const Params& p, bool second, bf16_t* dst) {
    const int lane = threadIdx.x & 63, gw = blockIdx.x * 4 + (threadIdx.x >> 6), NGW = gridDim.x * 4;
    const float* gwt = second ? p.in[20] : p.in[6];
    const float* mod = (const float*)(p.ws + O_MOD);
    f32x4 gv[4];
#pragma unroll
    for (int j = 0; j < 4; ++j) gv[j] = *((const f32x4*)gwt + 64 * j + lane);
    for (int t = gw; t < T; t += NGW) {
        const float* xr = second ? p.out + (size_t)t * D : xrow_ptr(p, t);
        const int b = t >> 12;
        const float* sh = mod + (size_t)b * 6144 + (second ? 3072 : 0);
        const float* sc = sh + 1024;
        f32x4 v[4]; float s = 0.f;
#pragma unroll
        for (int j = 0; j < 4; ++j) { v[j] = *((const f32x4*)xr + 64 * j + lane); s += (v[j].x * v[j].x + v[j].y * v[j].y) + (v[j].z * v[j].z + v[j].w * v[j].w); }
        const float rstd = rsqrtf(wave_sum(s) * (1.f / D) + EPS);
        u32x2* o = (u32x2*)(dst + (size_t)t * D) + lane;
#pragma unroll
        for (int j = 0; j < 4; ++j) {
            const f32x4 scv = *((const f32x4*)sc + 64 * j + lane), shv = *((const f32x4*)sh + 64 * j + lane);
            f32x4 y;
            y.x = v[j].x * rstd * gv[j].x * (1.f + scv.x) + shv.x; y.y = v[j].y * rstd * gv[j].y * (1.f + scv.y) + shv.y;
            y.z = v[j].z * rstd * gv[j].z * (1.f + scv.z) + shv.z; y.w = v[j].w * rstd * gv[j].w * (1.f + scv.w) + shv.w;
            o[64 * j] = (u32x2){pk2(y.x, y.y), pk2(y.z, y.w)};
        }
    }
}

DI void phase1(const Params& p, char* lds) {
    const bf16_t* H = (const bf16_t*)(p.ws + O_H);
    const bf16_t* W = (const bf16_t*)(p.ws + O_WIN);
    bf16_t* ZS = (bf16_t*)(p.ws + O_ZS);
    bf16_t* Gt = (bf16_t*)((unsigned char*)p.out + OO_G);
    constexpr int nM = T / 128, nN = NIN / 128, NTILES = nM * nN;
    const int lane = threadIdx.x & 63, wave = threadIdx.x >> 6, wm = wave >> 1, wn = wave & 1, r = lane & 15, g = lane >> 4;
    for (int L = blockIdx.x; L < NTILES; L += gridDim.x) {
        int pm, pn; tile_map(L, nN, NTILES, pm, pn);
        f32x4 acc[4][4]; zero_acc(acc);
        gemm_mainloop<128, 128, 2, 2>(acc, H + (size_t)pm * 128 * 1024, 1024, W + (size_t)pn * 128 * 1024, 1024, 1024, lds);
        const int col0 = pn * 128 + wn * 64 + g * 4;
#pragma unroll
        for (int mt = 0; mt < 4; ++mt) {
            const int m = pm * 128 + wm * 64 + mt * 16 + r;
#pragma unroll
            for (int nt = 0; nt < 4; ++nt) {
                const int n = col0 + nt * 16;
                const f32x4 a = acc[mt][nt];
                if (pn < NZ / 128) *(u32x2*)(ZS + (size_t)m * NZ + n) = (u32x2){pk2(a.x, a.y), pk2(a.z, a.w)};
                else *(u32x2*)(Gt + (size_t)m * 2048 + (n - NZ)) = (u32x2){pk2(sigmoidf_(a.x), sigmoidf_(a.y)), pk2(sigmoidf_(a.z), sigmoidf_(a.w))};
            }
        }
    }
}

template <int NCH>
DI float row_sumsq(const bf16_t* rowp, int g) {
    float s = 0.f;
#pragma unroll
    for (int c = 0; c < NCH; ++c) {
        const u32x4 v = *(const u32x4*)(rowp + (g * NCH + c) * 8);
#pragma unroll
        for (int e = 0; e < 4; ++e) { const float a = bflo(v[e]), b = bfhi(v[e]); s += a * a + b * b; }
    }
    return xor_reduce_g(s);
}

DI void phase2(const Params& p, char* lds) {
    unsigned char* ws = p.ws;
    const bf16_t* ZS = (const bf16_t*)(ws + O_ZS);
    const int tid = threadIdx.x, lane = tid & 63, wave = tid >> 6, r = lane & 15, g = lane >> 4;
    const float2* ropeA = (const float2*)(ws + O_ROPEA);
    const float2* ropeB = (const float2*)(ws + O_ROPEB);
    constexpr int NTL = T / 128;
    for (int it = blockIdx.x; it < NTL * 8; it += gridDim.x) {
        const int tile = it >> 3, sub = it & 7, t0 = tile * 128, b = t0 >> 12, s0 = t0 & (S - 1);
        {
            const int h = sub;
            f32x4 acc[2][6]; zero_acc(acc);
            gemm_mainloop<128, 96, 4, 1>(acc, ZS + (size_t)t0 * NZ + 768, NZ, (const bf16_t*)(ws + O_WUQ) + (size_t)h * 96 * 256, 256, 256, lds);
            const float* gq = p.in[15];
            const float qs = 0.10206207261596577f * LOG2E;
            bf16_t* QB = (bf16_t*)(ws + O_QB) + ((size_t)(b * 8 + h) * S) * 96;
#pragma unroll
            for (int mt = 0; mt < 2; ++mt) {
                const int ml = wave * 32 + mt * 16 + r, sp = s0 + ml;
                const float rstd = rsqrtf(row_sumsq<8>(ZS + (size_t)(t0 + ml) * NZ + 768, g) * (1.f / 256.f) + EPS);
                float ss = 0.f;
#pragma unroll
                for (int nt = 0; nt < 6; ++nt) { acc[mt][nt] = acc[mt][nt] * rstd; const f32x4 a = acc[mt][nt]; ss += (a.x * a.x + a.y * a.y) + (a.z * a.z + a.w * a.w); }
                const float r2 = rsqrtf(xor_reduce_g(ss) * (1.f / 96.f) + EPS);
#pragma unroll
                for (int nt = 0; nt < 6; ++nt) {
                    const f32x4 gg = *(const f32x4*)(gq + nt * 16 + g * 4);
                    acc[mt][nt] = acc[mt][nt] * r2 * gg;
                }
#pragma unroll
                for (int j = 0; j < 4; ++j) {
                    const float2 cs = ropeB[sp * 16 + g * 4 + j];
                    const float x1 = acc[mt][4][j], x2 = acc[mt][5][j];
                    acc[mt][4][j] = x1 * cs.x - x2 * cs.y;
                    acc[mt][5][j] = x1 * cs.y + x2 * cs.x;
                }
                bf16_t* qrow = QB + (size_t)sp * 96 + g * 4;
#pragma unroll
                for (int nt = 0; nt < 6; ++nt) { const f32x4 a = acc[mt][nt] * qs; *(u32x2*)(qrow + nt * 16) = (u32x2){pk2(a.x, a.y), pk2(a.z, a.w)}; }
                __builtin_amdgcn_sched_barrier(0);
            }
        }
    }
    for (int it = blockIdx.x; it < NTL * 4; it += gridDim.x) {
        const int tile = it >> 2, hp = it & 3, t0 = tile * 128, b = t0 >> 12, s0 = t0 & (S - 1);
        {
            f32x4 acc[4][4]; zero_acc(acc);
            gemm_mainloop<128, 128, 2, 2>(acc, ZS + (size_t)t0 * NZ + 1024, NZ,
                                          (const bf16_t*)(ws + O_WUKV) + (size_t)(hp * 128) * 128, 128, 128, lds);
            const int wm = wave >> 1, wn = wave & 1, h = hp * 2 + wn;
            {
                const float* gk = p.in[16];
                bf16_t* KB = (bf16_t*)(ws + O_KB) + ((size_t)(b * 8 + h) * S) * 96;
#pragma unroll
                for (int mt = 0; mt < 4; ++mt) {
                    const int ml = wm * 64 + mt * 16 + r, sp = s0 + ml;
                    const bf16_t* zrow = ZS + (size_t)(t0 + ml) * NZ;
                    const float rstd = rsqrtf(row_sumsq<4>(zrow + 1024, g) * (1.f / 128.f) + EPS);
                    const u32x2 k1 = *(const u32x2*)(zrow + 1152 + g * 4), k2 = *(const u32x2*)(zrow + 1168 + g * 4);
                    float x1[4] = {bflo(k1.x), bfhi(k1.x), bflo(k1.y), bfhi(k1.y)};
                    float x2[4] = {bflo(k2.x), bfhi(k2.x), bflo(k2.y), bfhi(k2.y)};
                    float ss = 0.f;
#pragma unroll
                    for (int j = 0; j < 4; ++j) ss += x1[j] * x1[j] + x2[j] * x2[j];
#pragma unroll
                    for (int nt = 0; nt < 4; ++nt) { acc[mt][nt] = acc[mt][nt] * rstd; const f32x4 a = acc[mt][nt]; ss += (a.x * a.x + a.y * a.y) + (a.z * a.z + a.w * a.w); }
                    const float r2 = rsqrtf(xor_reduce_g(ss) * (1.f / 96.f) + EPS);
                    bf16_t* krow = KB + (size_t)sp * 96 + g * 4;
#pragma unroll
                    for (int nt = 0; nt < 4; ++nt) {
                        const f32x4 gg = *(const f32x4*)(gk + nt * 16 + g * 4);
                        const f32x4 a = acc[mt][nt] * r2 * gg;
                        *(u32x2*)(krow + nt * 16) = (u32x2){pk2(a.x, a.y), pk2(a.z, a.w)};
                    }
                    const f32x4 g1 = *(const f32x4*)(gk + 64 + g * 4), g2 = *(const f32x4*)(gk + 80 + g * 4);
                    float o1[4], o2[4];
#pragma unroll
                    for (int j = 0; j < 4; ++j) {
                        const float2 cs = ropeB[sp * 16 + g * 4 + j];
                        const float y1 = x1[j] * r2 * g1[j], y2 = x2[j] * r2 * g2[j];
                        o1[j] = y1 * cs.x - y2 * cs.y; o2[j] = y1 * cs.y + y2 * cs.x;
                    }
                    *(u32x2*)(krow + 64) = (u32x2){pk2(o1[0], o1[1]), pk2(o1[2], o1[3])};
                    *(u32x2*)(krow + 80) = (u32x2){pk2(o2[0], o2[1]), pk2(o2[2], o2[3])};
                    __builtin_amdgcn_sched_barrier(0);
                }
            }
        }
    }
    for (int it = blockIdx.x; it < NTL * 4; it += gridDim.x) {
        const int tile = it >> 2, hp = it & 3, t0 = tile * 128, b = t0 >> 12, s0 = t0 & (S - 1);
        {
            f32x4 acc[4][4]; zero_acc(acc);
            gemm_mainloop<128, 128, 2, 2>(acc, ZS + (size_t)t0 * NZ + 1024, NZ,
                                          (const bf16_t*)(ws + O_WUKV) + (size_t)(512 + hp * 128) * 128, 128, 128, lds);
            const int wm = wave >> 1, wn = wave & 1, h = hp * 2 + wn;
            {
                bf16_t* VT = (bf16_t*)(ws + O_VTB) + ((size_t)(b * 8 + h) * 64) * S;
#pragma unroll
                for (int mt = 0; mt < 4; ++mt) {
                    const int ml = wm * 64 + mt * 16 + r, sp = s0 + ml;
                    const float rstd = rsqrtf(row_sumsq<4>(ZS + (size_t)(t0 + ml) * NZ + 1024, g) * (1.f / 128.f) + EPS);
                    const int ps = perm32(sp);
#pragma unroll
                    for (int nt = 0; nt < 4; ++nt)
#pragma unroll
                        for (int j = 0; j < 4; ++j) VT[(size_t)(nt * 16 + g * 4 + j) * S + ps] = f2bf(acc[mt][nt][j] * rstd);
                    __builtin_amdgcn_sched_barrier(0);
                }
            }
        }
    }
    __syncthreads();
    for (int tile = blockIdx.x; tile < NTL; tile += gridDim.x) {
        const int t0 = tile * 128, b = t0 >> 12, s0 = t0 & (S - 1);
        {
            const float* gqa = p.in[8];
            const float* gka = p.in[9];
            const int half = lane >> 5, i = lane & 31;
            const float qs = 0.125f * LOG2E;
            for (int tt = wave; tt < 128; tt += 4) {
                const int sp = s0 + tt;
                const bf16_t* zrow = ZS + (size_t)(t0 + tt) * NZ;
                const float2 cs = ropeA[sp * 32 + i];
#pragma unroll
                for (int hh = 0; hh < 10; hh += 2) {
                    const int hd = hh + half;
                    const float x1 = bf2f(zrow[hd * 64 + i]), x2 = bf2f(zrow[hd * 64 + 32 + i]);
                    float ss = x1 * x1 + x2 * x2;
#pragma unroll
                    for (int o = 1; o < 32; o <<= 1) ss += __shfl_xor(ss, o);
                    const float rr = rsqrtf(ss * (1.f / 64.f) + EPS);
                    const float* gg = hd < 8 ? gqa : gka;
                    const float y1 = x1 * rr * gg[i], y2 = x2 * rr * gg[32 + i];
                    float o1 = y1 * cs.x - y2 * cs.y, o2 = y1 * cs.y + y2 * cs.x;
                    bf16_t* dst;
                    if (hd < 8) { o1 *= qs; o2 *= qs; dst = (bf16_t*)(ws + O_QA) + ((size_t)(b * 8 + hd) * S + sp) * 64; }
                    else dst = (bf16_t*)(ws + O_KA) + ((size_t)(b * 2 + (hd - 8)) * S + sp) * 64;
                    dst[i] = f2bf(o1); dst[32 + i] = f2bf(o2);
                }
            }
            __syncthreads();
            bf16_t* tl = (bf16_t*)lds;
            for (int idx = tid; idx < 128 * 16; idx += 256) {
                const int tt = idx >> 4, c = idx & 15;
                const u32x4 v = *(const u32x4*)(ZS + (size_t)(t0 + tt) * NZ + 640 + c * 8);
                u32x2* d2 = (u32x2*)(tl + tt * 132 + c * 8);
                d2[0] = (u32x2){v.x, v.y}; d2[1] = (u32x2){v.z, v.w};
            }
            __syncthreads();
            bf16_t* VT = (bf16_t*)(ws + O_VTA) + ((size_t)(b * 2) * 64) * S;
            for (int idx = tid; idx < 128 * 128; idx += 256) {
                const int pp = idx & 127, dd = idx >> 7;
                const int lo = pp & 31;
                const int tt = (pp & ~31) | (((lo >> 2) & 1) << 4) | ((lo >> 3) << 2) | (lo & 3);
                VT[(size_t)dd * S + s0 + pp] = tl[tt * 132 + dd];
            }
            __syncthreads();
        }
    }
}

template <int DQK, bool WIN>
DI void attn_item(const bf16_t* __restrict__ Qw, const bf16_t* __restrict__ Kb, const bf16_t* __restrict__ Vt, int key0, int ntiles, int q0,
                  float shift2, float sink_term, bf16_t* __restrict__ Ow, int ldo, char* lds) {
    constexpr int KS = DQK / 32, CH = DQK / 8, KSTR = DQK * 2 + 32, NKL = CH * 64 / 256, VSTR = 160, STAGE = 64 * 224 + 64 * VSTR;
    const int tid = threadIdx.x, lane = tid & 63, r = lane & 15, g = lane >> 4;
    bf16x8 qf[2][KS];
#pragma unroll
    for (int qt = 0; qt < 2; ++qt)
#pragma unroll
        for (int ks = 0; ks < KS; ++ks) qf[qt][ks] = *(const bf16x8*)(Qw + (size_t)(qt * 16 + r) * DQK + ks * 32 + g * 8);
    f32x4 oacc[4][2];
#pragma unroll
    for (int i = 0; i < 4; ++i) { oacc[i][0] = (f32x4){0.f, 0.f, 0.f, 0.f}; oacc[i][1] = (f32x4){0.f, 0.f, 0.f, 0.f}; }
    float lsum[2] = {0.f, 0.f};
    u32x4 rk[NKL], rv[2];
    int krow[NKL], kc[NKL];
#pragma unroll
    for (int i = 0; i < NKL; ++i) { const int idx = tid + 256 * i; krow[i] = idx / CH; kc[i] = idx % CH; }
    const int vrow = tid >> 3, vc = tid & 7;
    auto gload = [&](int tile) {
        const int kb = key0 + tile * 64;
#pragma unroll
        for (int i = 0; i < NKL; ++i) rk[i] = *(const u32x4*)(Kb + (size_t)(kb + krow[i]) * DQK + kc[i] * 8);
#pragma unroll
        for (int i = 0; i < 2; ++i) rv[i] = *(const u32x4*)(Vt + (size_t)(vrow + 32 * i) * S + kb + vc * 8);
    };
    auto lstore = [&](int st) {
        char* sK = lds + st * STAGE; char* sV = sK + 64 * 224;
#pragma unroll
        for (int i = 0; i < NKL; ++i) *(u32x4*)(sK + krow[i] * KSTR + kc[i] * 16) = rk[i];
#pragma unroll
        for (int i = 0; i < 2; ++i) *(u32x4*)(sV + (vrow + 32 * i) * VSTR + vc * 16) = rv[i];
    };
    __syncthreads();
    gload(0); lstore(0);
    __syncthreads();
    for (int tile = 0; tile < ntiles; ++tile) {
        const int cur = tile & 1;
        const bool more = tile + 1 < ntiles;
        if (more) gload(tile + 1);
        const char* sK = lds + cur * STAGE; const char* sV = sK + 64 * 224;
        f32x4 sacc[4][2];
#pragma unroll
        for (int kt = 0; kt < 4; ++kt) {
            sacc[kt][0] = (f32x4){0.f, 0.f, 0.f, 0.f}; sacc[kt][1] = (f32x4){0.f, 0.f, 0.f, 0.f};
#pragma unroll
            for (int ks = 0; ks < KS; ++ks) {
                const bf16x8 kf = *(const bf16x8*)(sK + (kt * 16 + r) * KSTR + (ks * 4 + g) * 16);
                sacc[kt][0] = __builtin_amdgcn_mfma_f32_16x16x32_bf16(kf, qf[0][ks], sacc[kt][0], 0, 0, 0);
                sacc[kt][1] = __builtin_amdgcn_mfma_f32_16x16x32_bf16(kf, qf[1][ks], sacc[kt][1], 0, 0, 0);
            }
        }
        const int kbase = key0 + tile * 64 + g * 4;
#pragma unroll
        for (int kt = 0; kt < 4; ++kt)
#pragma unroll
            for (int qt = 0; qt < 2; ++qt)
#pragma unroll
                for (int j = 0; j < 4; ++j) {
                    float pv = fast_exp2(sacc[kt][qt][j] - shift2);
                    if (WIN) { const int dlt = (kbase + kt * 16 + j) - (q0 + qt * 16 + r); if (dlt > 128 || dlt < -128) pv = 0.f; }
                    sacc[kt][qt][j] = pv; lsum[qt] += pv;
                }
#pragma unroll
        for (int kk = 0; kk < 2; ++kk) {
            bf16x8 pb[2];
#pragma unroll
            for (int qt = 0; qt < 2; ++qt) {
                u32x4 u;
                u.x = pk2(sacc[2 * kk][qt][0], sacc[2 * kk][qt][1]); u.y = pk2(sacc[2 * kk][qt][2], sacc[2 * kk][qt][3]);
                u.z = pk2(sacc[2 * kk + 1][qt][0], sacc[2 * kk + 1][qt][1]); u.w = pk2(sacc[2 * kk + 1][qt][2], sacc[2 * kk + 1][qt][3]);
                pb[qt] = __builtin_bit_cast(bf16x8, u);
            }
#pragma unroll
            for (int dt = 0; dt < 4; ++dt) {
                const bf16x8 vf = *(const bf16x8*)(sV + (dt * 16 + r) * VSTR + (kk * 4 + g) * 16);
                oacc[dt][0] = __builtin_amdgcn_mfma_f32_16x16x32_bf16(vf, pb[0], oacc[dt][0], 0, 0, 0);
                oacc[dt][1] = __builtin_amdgcn_mfma_f32_16x16x32_bf16(vf, pb[1], oacc[dt][1], 0, 0, 0);
            }
        }
        if (more) lstore(cur ^ 1);
        __syncthreads();
    }
#pragma unroll
    for (int qt = 0; qt < 2; ++qt) {
        const float inv = fast_rcp(xor_reduce_g(lsum[qt]) + sink_term);
        bf16_t* orow = Ow + (size_t)(qt * 16 + r) * ldo + g * 4;
#pragma unroll
        for (int dt = 0; dt < 4; ++dt) { const f32x4 a = oacc[dt][qt] * inv; *(u32x2*)(orow + dt * 16) = (u32x2){pk2(a.x, a.y), pk2(a.z, a.w)}; }
    }
}

DI float max_abs(const float* v, int n) { float m = 0.f; for (int i = 0; i < n; ++i) m = fmaxf(m, fabsf(v[i])); return m; }

DI void phase3(const Params& p, char* lds) {
    unsigned char* ws = p.ws;
    const int wave = threadIdx.x >> 6;
    const float shiftB = 9.797958971132712f * max_abs(p.in[15], 96) * max_abs(p.in[16], 96) * LOG2E;
    const float shiftA = 8.f * max_abs(p.in[8], 64) * max_abs(p.in[9], 64) * LOG2E;
    bf16_t* OA = (bf16_t*)(p.ws + O_OA);
    bf16_t* OB = (bf16_t*)(p.ws + O_OB);
    constexpr int NB_ITEMS = 24 * 8 * 32, NA_ITEMS = 24 * 2 * 128;
    for (int L = blockIdx.x; L < NB_ITEMS; L += gridDim.x) {
        const int idx = (L & 7) * (NB_ITEMS / 8) + (L >> 3);
        const int bh = idx >> 5, qb = idx & 31, b = bh >> 3, h = bh & 7;
        const int q0 = qb * 128 + wave * 32;
        attn_item<96, false>((const bf16_t*)(ws + O_QB) + ((size_t)bh * S + q0) * 96, (const bf16_t*)(ws + O_KB) + (size_t)bh * S * 96,
                             (const bf16_t*)(ws + O_VTB) + (size_t)bh * 64 * S, 0, S / 64, q0, shiftB, 0.f,
                             OB + ((size_t)b * S + q0) * 512 + h * 64, 512, lds);
    }
    for (int L = blockIdx.x; L < NA_ITEMS; L += gridDim.x) {
        const int idx = (L & 7) * (NA_ITEMS / 8) + (L >> 3);
        const int bk = idx >> 7, qb = idx & 127, b = bk >> 1, kvh = bk & 1;
        const int q0 = qb * 32, hd = kvh * 4 + wave;
        int ks = (q0 - 128) & ~63; if (ks < 0) ks = 0;
        int ke = (q0 + 32 + 128 + 63) & ~63; if (ke > S) ke = S;
        const float sink_term = fast_exp2(p.in[10][hd] * LOG2E - shiftA);
        attn_item<64, true>((const bf16_t*)(ws + O_QA) + ((size_t)(b * 8 + hd) * S + q0) * 64, (const bf16_t*)(ws + O_KA) + (size_t)bk * S * 64,
                            (const bf16_t*)(ws + O_VTA) + (size_t)bk * 64 * S, ks, (ke - ks) >> 6, q0, shiftA, sink_term,
                            OA + ((size_t)b * S + q0) * 512 + hd * 64, 512, lds);
    }
}

DI void phase4(const Params& p, char* lds) {
    const bf16_t* OA = (const bf16_t*)(p.ws + O_OA);
    const bf16_t* OB = (const bf16_t*)(p.ws + O_OB);
    const bf16_t* Gt = (const bf16_t*)((unsigned char*)p.out + OO_G);
    bf16_t* MIX = (bf16_t*)(p.ws + O_ZS);
    constexpr int nM = T / 128, nN = 8, NTILES = nM * nN;
    const int lane = threadIdx.x & 63, wave = threadIdx.x >> 6, wm = wave >> 1, wn = wave & 1, r = lane & 15, g = lane >> 4;
    for (int L = blockIdx.x; L < NTILES; L += gridDim.x) {
        int pm, pn; tile_map(L, nN, NTILES, pm, pn);
        f32x4 acc[4][4]; u32x2 mixp[4][4]; zero_acc(acc);
        gemm_mainloop<128, 128, 2, 2>(acc, OA + (size_t)pm * 128 * 512, 512, (const bf16_t*)(p.ws + O_WOA) + (size_t)pn * 128 * 512, 512, 512, lds);
        const int col0 = pn * 128 + wn * 64 + g * 4;
#pragma unroll
        for (int mt = 0; mt < 4; ++mt) {
            const int m = pm * 128 + wm * 64 + mt * 16 + r;
#pragma unroll
            for (int nt = 0; nt < 4; ++nt) {
                const u32x2 gv = *(const u32x2*)(Gt + (size_t)m * 2048 + col0 + nt * 16);
                const f32x4 a = acc[mt][nt];
                mixp[mt][nt] = (u32x2){pk2(a.x * bflo(gv.x), a.y * bfhi(gv.x)), pk2(a.z * bflo(gv.y), a.w * bfhi(gv.y))};
            }
        }
        zero_acc(acc);
        gemm_mainloop<128, 128, 2, 2>(acc, OB + (size_t)pm * 128 * 512, 512, (const bf16_t*)(p.ws + O_WOB) + (size_t)pn * 128 * 512, 512, 512, lds);
#pragma unroll
        for (int mt = 0; mt < 4; ++mt) {
            const int m = pm * 128 + wm * 64 + mt * 16 + r;
#pragma unroll
            for (int nt = 0; nt < 4; ++nt) {
                const u32x2 gv = *(const u32x2*)(Gt + (size_t)m * 2048 + 1024 + col0 + nt * 16);
                const f32x4 a = acc[mt][nt]; const u32x2 mx = mixp[mt][nt];
                const float o0 = bflo(mx.x) + a.x * bflo(gv.x), o1 = bfhi(mx.x) + a.y * bfhi(gv.x), o2 = bflo(mx.y) + a.z * bflo(gv.y), o3 = bfhi(mx.y) + a.w * bfhi(gv.y);
                *(u32x2*)(MIX + (size_t)m * 1024 + col0 + nt * 16) = (u32x2){pk2(o0, o1), pk2(o2, o3)};
            }
        }
    }
}

DI void phase5(const Params& p, char* lds) {
    const bf16_t* MIX = (const bf16_t*)(p.ws + O_ZS);
    const float* mod = (const float*)(p.ws + O_MOD);
    constexpr int nM = T / 128, nN = 8, NTILES = nM * nN;
    const int lane = threadIdx.x & 63, wave = threadIdx.x >> 6, wm = wave >> 1, wn = wave & 1, r = lane & 15, g = lane >> 4;
    for (int L = blockIdx.x; L < NTILES; L += gridDim.x) {
        int pm, pn; tile_map(L, nN, NTILES, pm, pn);
        f32x4 acc[4][4]; zero_acc(acc);
        gemm_mainloop<128, 128, 2, 2>(acc, MIX + (size_t)pm * 128 * 1024, 1024, (const bf16_t*)(p.ws + O_WOUT) + (size_t)pn * 128 * 1024, 1024, 1024, lds);
        const int col0 = pn * 128 + wn * 64 + g * 4;
        const int b = (pm * 128) >> 12;
        const float* gt1 = mod + (size_t)b * 6144 + 2048;
#pragma unroll
        for (int mt = 0; mt < 4; ++mt) {
            const int m = pm * 128 + wm * 64 + mt * 16 + r;
            const float* xr = xrow_ptr(p, m);
#pragma unroll
            for (int nt = 0; nt < 4; ++nt) {
                const int n = col0 + nt * 16;
                const f32x4 xv = *(const f32x4*)(xr + n), gv = *(const f32x4*)(gt1 + n);
                *(f32x4*)(p.out + (size_t)m * D + n) = xv + gv * acc[mt][nt];
            }
        }
    }
}

DI void phase7(const Params& p, char* lds, int chunk) {
    const bf16_t* H2 = (const bf16_t*)(p.ws + O_H) + (size_t)chunk * TCH * 1024;
    bf16_t* UP = (bf16_t*)(p.ws + O_UP);
    constexpr int nM = TCH / 128, nN = NUP / 128, NTILES = nM * nN;
    const int lane = threadIdx.x & 63, wave = threadIdx.x >> 6, wm = wave >> 1, wn = wave & 1, r = lane & 15, g = lane >> 4;
    for (int L = blockIdx.x; L < NTILES; L += gridDim.x) {
        int pm, pn; tile_map(L, nN, NTILES, pm, pn);
        f32x4 acc[4][4]; zero_acc(acc);
        gemm_mainloop<128, 128, 2, 2>(acc, H2 + (size_t)pm * 128 * 1024, 1024, (const bf16_t*)(p.ws + O_WUP) + (size_t)pn * 128 * 1024, 1024, 1024, lds);
        const int col0 = pn * 128 + wn * 64 + g * 4;
#pragma unroll
        for (int mt = 0; mt < 4; ++mt) {
            const int m = pm * 128 + wm * 64 + mt * 16 + r;
#pragma unroll
            for (int nt = 0; nt < 4; ++nt) {
                const f32x4 a = acc[mt][nt];
                *(u32x2*)(UP + (size_t)m * NUP + col0 + nt * 16) = (u32x2){pk2(a.x, a.y), pk2(a.z, a.w)};
            }
        }
    }
}

DI void unpack8(const u32x4 v, float (&f)[8]) {
    f[0] = bflo(v.x); f[1] = bfhi(v.x); f[2] = bflo(v.y); f[3] = bfhi(v.y); f[4] = bflo(v.z); f[5] = bfhi(v.z); f[6] = bflo(v.w); f[7] = bfhi(v.w);
}

DI void phase7b(const Params& p) {
    const bf16_t* UP = (const bf16_t*)(p.ws + O_UP);
    bf16_t* ACT = (bf16_t*)(p.ws + O_ACT);
    const float* cw = p.in[22];
    const float* cb = p.in[23];
    const int gt = blockIdx.x * 256 + threadIdx.x, NGT = gridDim.x * 256;
    constexpr int CPR = DFF / 8;
    for (int i = gt; i < TCH * CPR; i += NGT) {
        const int tl = i / CPR, c = (i % CPR) * 8;
        const int sp = tl & (S - 1);
        const float mp = sp > 0 ? 1.f : 0.f, mn = sp < S - 1 ? 1.f : 0.f;
        const int tp = sp > 0 ? tl - 1 : tl, tn = sp < S - 1 ? tl + 1 : tl;
        float u[2][8];
#pragma unroll
        for (int half = 0; half < 2; ++half) {
            const int col = c + half * DFF;
            float x0[8], x1[8], x2[8];
            unpack8(*(const u32x4*)(UP + (size_t)tp * NUP + col), x0);
            unpack8(*(const u32x4*)(UP + (size_t)tl * NUP + col), x1);
            unpack8(*(const u32x4*)(UP + (size_t)tn * NUP + col), x2);
#pragma unroll
            for (int q = 0; q < 2; ++q) {
                const f32x4 b4 = *(const f32x4*)(cb + col + 4 * q);
                const f32x4 w0 = *(const f32x4*)(cw + col + 4 * q) * mp, w1 = *(const f32x4*)(cw + NUP + col + 4 * q), w2 = *(const f32x4*)(cw + 2 * NUP + col + 4 * q) * mn;
#pragma unroll
                for (int e = 0; e < 4; ++e) u[half][4 * q + e] = b4[e] + w0[e] * x0[4 * q + e] + w1[e] * x1[4 * q + e] + w2[e] * x2[4 * q + e];
            }
        }
        float a[8];
#pragma unroll
        for (int e = 0; e < 8; ++e) a[e] = u[1][e] * sigmoidf_(u[1][e]) * u[0][e];
        u32x4 o;
        o.x = pk2(a[0], a[1]); o.y = pk2(a[2], a[3]); o.z = pk2(a[4], a[5]); o.w = pk2(a[6], a[7]);
        *(u32x4*)(ACT + (size_t)tl * DFF + c) = o;
    }
}

DI void phase8(const Params& p, char* lds, int chunk) {
    const bf16_t* ACT = (const bf16_t*)(p.ws + O_ACT);
    const float* mod = (const float*)(p.ws + O_MOD);
    constexpr int nM = TCH / 128, nN = 8, NTILES = nM * nN;
    const int lane = threadIdx.x & 63, wave = threadIdx.x >> 6, wm = wave >> 1, wn = wave & 1, r = lane & 15, g = lane >> 4;
    for (int L = blockIdx.x; L < NTILES; L += gridDim.x) {
        int pm, pn; tile_map(L, nN, NTILES, pm, pn);
        f32x4 acc[4][4]; zero_acc(acc);
        gemm_mainloop<128, 128, 2, 2>(acc, ACT + (size_t)pm * 128 * DFF, DFF, (const bf16_t*)(p.ws + O_WDN) + (size_t)pn * 128 * DFF, DFF, DFF, lds);
        const int col0 = pn * 128 + wn * 64 + g * 4;
        const int mg0 = chunk * TCH + pm * 128;
        const int b = mg0 >> 12;
        const float* gt2 = mod + (size_t)b * 6144 + 5120;
#pragma unroll
        for (int mt = 0; mt < 4; ++mt) {
            const int m = mg0 + wm * 64 + mt * 16 + r;
#pragma unroll
            for (int nt = 0; nt < 4; ++nt) {
                const int n = col0 + nt * 16;
                float* op = p.out + (size_t)m * D + n;
                const f32x4 xv = *(const f32x4*)op, gv = *(const f32x4*)(gt2 + n);
                *(f32x4*)op = xv + gv * acc[mt][nt];
            }
        }
    }
}

__global__ void __launch_bounds__(256, 2) fwd_megakernel(Params p) {
    __shared__ __attribute__((aligned(16))) char lds[65536];
    cg::grid_group grid = cg::this_grid();
#if PM & 1
    phase0(p, lds);
#endif
    grid.sync();
    for (int xs = 0; xs < XSYNC; ++xs) grid.sync();
#if PM & 2
    phase0m(p);
#endif
    grid.sync();
#if PM & 4
    norm_pass(p, false, (bf16_t*)(p.ws + O_H));
#endif
    grid.sync();
#if PM & 8
    phase1(p, lds);
#if DUP & 8
    grid.sync();
    phase1(p, lds);
#endif
#endif
    grid.sync();
#if PM & 16
    phase2(p, lds);
#if DUP & 16
    grid.sync();
    phase2(p, lds);
#endif
#endif
    grid.sync();
#if PM & 32
    phase3(p, lds);
#if DUP & 32
    grid.sync();
    phase3(p, lds);
#endif
#endif
    grid.sync();
#if PM & 64
    phase4(p, lds);
#endif
    grid.sync();
#if PM & 128
    phase5(p, lds);
#endif
    grid.sync();
#if PM & 256
    norm_pass(p, true, (bf16_t*)(p.ws + O_H));
#endif
    grid.sync();
    for (int c = 0; c < NCHUNK; ++c) {
#if PM & 512
        phase7(p, lds, c);
#endif
        grid.sync();
#if PM & 1024
        phase7b(p);
#endif
#if DUP & 512
        grid.sync();
        phase7(p, lds, c);
#endif
#if DUP & 1024
        grid.sync();
        phase7b(p);
#endif
        grid.sync();
#if PM & 2048
        phase8(p, lds, c);
#endif
        if (c + 1 < NCHUNK) grid.sync();
    }
}

extern "C" void kernel_launch(void* const* d_in, const int* in_sizes, int n_in, void* d_out, int out_size, void* d_ws, size_t ws_size,
                              hipStream_t stream) {
    static int grid_blocks = 0;
    if (!grid_blocks) {
        int dev = 0, cus = 0, per_cu = 0;
        hipGetDevice(&dev);
        hipDeviceGetAttribute(&cus, hipDeviceAttributeMultiprocessorCount, dev);
        hipOccupancyMaxActiveBlocksPerMultiprocessor(&per_cu, fwd_megakernel, 256, 0);
        if (per_cu < 1) per_cu = 1;
        if (per_cu > 2) per_cu = 2;
        grid_blocks = cus * per_cu;
        if (n_in != 25 || ws_size < WS_NEED || out_size != T * D)
            fprintf(stderr, "kernel_launch: unexpected sizes n_in=%d ws=%zu out=%d\n", n_in, ws_size, out_size);
    }
    Params p{};
    for (int i = 0; i < 25; ++i) p.in[i] = (const float*)d_in[i];
    p.out = (float*)d_out;
    p.ws = (unsigned char*)d_ws;
    void* args[] = {&p};
    hipError_t e = hipLaunchCooperativeKernel((void*)fwd_megakernel, dim3(grid_blocks), dim3(256), args, 0, stream);
    if (e != hipSuccess) fprintf(stderr, "cooperative launch failed: %s (grid %d)\n", hipGetErrorString(e), grid_blocks);
}
```

```cpp
#include <hip/hip_runtime.h>
#include <hip/hip_cooperative_groups.h>
#include <cstdio>
#include <cstdint>
namespace cg = cooperative_groups;
#ifndef PM
#define PM 4095
#endif
#ifndef DUP
#define DUP 0
#define XSYNC 0
#endif

typedef unsigned short bf16_t;
typedef short bf16x8 __attribute__((ext_vector_type(8)));
typedef float f32x4 __attribute__((ext_vector_type(4)));
typedef unsigned u32x4 __attribute__((ext_vector_type(4)));
typedef unsigned u32x2 __attribute__((ext_vector_type(2)));
#define DI __device__ __forceinline__

constexpr int D = 1024, S = 4096, NBATCH = 24, T = NBATCH * S;
constexpr int T_PROMPT = 8 * S;
constexpr int IN_TOTAL = 3232, NZ = 1280  , NIN = NZ + 2048;
constexpr int DFF = 2816, NUP = 2 * DFF;
constexpr float EPS = 1e-6f;
constexpr float LOG2E = 1.4426950408889634f;
constexpr int NCHUNK = 4, TCH = T / NCHUNK;

constexpr size_t MiB = 1024ull * 1024ull;
constexpr size_t O_WIN = 0;
constexpr size_t O_WUQ = O_WIN + (size_t)NIN * 1024 * 2;
constexpr size_t O_WUKV = O_WUQ + 768ull * 256 * 2;
constexpr size_t O_WOA = O_WUKV + 1024ull * 128 * 2;
constexpr size_t O_WOB = O_WOA + 1024ull * 512 * 2;
constexpr size_t O_WOUT = O_WOB + 1024ull * 512 * 2;
constexpr size_t O_WUP = O_WOUT + 1024ull * 1024 * 2;
constexpr size_t O_WDN = O_WUP + (size_t)NUP * 1024 * 2;
constexpr size_t O_MODP = O_WDN + 1024ull * DFF * 2;
constexpr size_t O_MOD = O_MODP + 16ull * 24 * 6144 * 4;
constexpr size_t O_ROPEA = O_MOD + 24ull * 6144 * 4;
constexpr size_t O_ROPEB = O_ROPEA + 4096ull * 32 * 8;
constexpr size_t O_WB_END = O_ROPEB + 4096ull * 16 * 8;
static_assert(O_WB_END <= 48 * MiB, "weights region");
constexpr size_t O_ZS = 48 * MiB;
constexpr size_t O_QA = 288 * MiB;
constexpr size_t O_KA = O_QA + 96 * MiB;
constexpr size_t O_VTA = O_KA + 24 * MiB;
constexpr size_t O_QB = O_VTA + 24 * MiB;
constexpr size_t O_KB = O_QB + 144 * MiB;
constexpr size_t O_VTB = O_KB + 144 * MiB;
constexpr size_t O_H = 816 * MiB;
constexpr size_t O_UP = 288 * MiB;
constexpr size_t O_ACT = 552 * MiB;
constexpr size_t WS_NEED = 1008 * MiB;
static_assert(O_VTB + 96 * MiB <= O_H, "qkv region");
constexpr size_t OO_G = 0, O_OA = O_H, O_OB = O_H + 96 * MiB;

struct Params {
    const float* in[25];
    float* out;
    unsigned char* ws;
};

typedef __bf16 bf16x2_t __attribute__((ext_vector_type(2)));
typedef float f32x2_t __attribute__((ext_vector_type(2)));
DI unsigned pk2(float lo, float hi) { const f32x2_t v = {lo, hi}; return __builtin_bit_cast(unsigned, __builtin_convertvector(v, bf16x2_t)); }
DI float bflo(unsigned u) { return __uint_as_float(u << 16); }
DI float bfhi(unsigned u) { return __uint_as_float(u & 0xffff0000u); }
DI float bf2f(bf16_t v) { return __uint_as_float(((unsigned)v) << 16); }
DI bf16_t f2bf(float v) { return (bf16_t)(pk2(v, v) & 0xffffu); }
DI float fast_rcp(float x) { return __builtin_amdgcn_rcpf(x); }
DI float fast_exp2(float x) { return __builtin_amdgcn_exp2f(x); }
DI float sigmoidf_(float v) { return fast_rcp(1.f + fast_exp2(-v * LOG2E)); }
DI float xor_reduce_g(float v) { v += __shfl_xor(v, 16); v += __shfl_xor(v, 32); return v; }
DI float wave_sum(float v) {
#pragma unroll
    for (int o = 1; o < 64; o <<= 1) v += __shfl_xor(v, o);
    return v;
}
DI int perm32(int s) { const int lo = s & 31; return (s & ~31) | (((lo >> 2) & 3) << 3) | ((lo >> 4) << 2) | (lo & 3); }
DI const float* xrow_ptr(const Params& p, int t) { return t < T_PROMPT ? p.in[0] + (size_t)t * D : p.in[1] + (size_t)(t - T_PROMPT) * D; }

DI void tile_map(int L, int nN, int ntiles, int& pm, int& pn) {
    const int xcd = L & 7, q = L >> 3;
    const int Lp = xcd * (ntiles >> 3) + q;
    const int grp = Lp / (8 * nN), rem = Lp % (8 * nN);
    pm = grp * 8 + (rem & 7); pn = rem >> 3;
}

#define LAS __attribute__((address_space(3)))
#define GAS __attribute__((address_space(1)))
template <int BM, int BN, int NWM, int NWN>
DI void gemm_mainloop(f32x4 (&acc)[BM / NWM / 16][BN / NWN / 16], const bf16_t* __restrict__ A, int lda,
                      const bf16_t* __restrict__ B, int ldb, int K, char* lds) {
    constexpr int MT = BM / NWM / 16, NT = BN / NWN / 16, NA = BM / 32, NB = BN / 32, STAGE = (BM + BN) * 128;
    const int tid = threadIdx.x, lane = tid & 63, wave = tid >> 6;
    const int wm = wave / NWN, wn = wave % NWN;
    const int r = lane & 15, g = lane >> 4;
    const int lr = tid >> 3, lc = tid & 7;
    const int csrc = (lc ^ ((lr >> 1) & 7)) * 8;
    const bf16_t* Ap = A + (size_t)lr * lda + csrc;
    const bf16_t* Bp = B + (size_t)lr * ldb + csrc;
    const int nk = K >> 6;
    auto issue = [&](int kt, int st) {
        char* d = lds + st * STAGE + tid * 16;
#pragma unroll
        for (int i = 0; i < NA; ++i)
            __builtin_amdgcn_global_load_lds((const GAS unsigned*)(Ap + (size_t)(32 * i) * lda + kt * 64), (LAS unsigned*)(d + i * 4096), 16, 0, 0);
#pragma unroll
        for (int i = 0; i < NB; ++i)
            __builtin_amdgcn_global_load_lds((const GAS unsigned*)(Bp + (size_t)(32 * i) * ldb + kt * 64), (LAS unsigned*)(d + BM * 128 + i * 4096), 16, 0, 0);
    };
    issue(0, 0);
    __syncthreads();
    const int rsw = (r >> 1) & 7;
    for (int kt = 0; kt < nk; ++kt) {
        const int cur = kt & 1;
        if (kt + 1 < nk) issue(kt + 1, cur ^ 1);
        const char* sA = lds + cur * STAGE;
        const char* sB = sA + BM * 128;
#pragma unroll
        for (int ks = 0; ks < 2; ++ks) {
            bf16x8 wf[NT], xf[MT];
            const int co = ((ks * 4 + g) ^ rsw) * 16;
#pragma unroll
            for (int nt = 0; nt < NT; ++nt) wf[nt] = *(const bf16x8*)(sB + (wn * (NT * 16) + nt * 16 + r) * 128 + co);
#pragma unroll
            for (int mt = 0; mt < MT; ++mt) xf[mt] = *(const bf16x8*)(sA + (wm * (MT * 16) + mt * 16 + r) * 128 + co);
#pragma unroll
            for (int mt = 0; mt < MT; ++mt)
#pragma unroll
                for (int nt = 0; nt < NT; ++nt) acc[mt][nt] = __builtin_amdgcn_mfma_f32_16x16x32_bf16(wf[nt], xf[mt], acc[mt][nt], 0, 0, 0);
        }
        __syncthreads();
    }
}

template <int MT, int NT>
DI void zero_acc(f32x4 (&acc)[MT][NT]) {
#pragma unroll
    for (int i = 0; i < MT; ++i)
#pragma unroll
        for (int j = 0; j < NT; ++j) acc[i][j] = (f32x4){0.f, 0.f, 0.f, 0.f};
}

DI void transpose_item(const float* __restrict__ W, int K, int N, bf16_t* __restrict__ WT, int mode, const float* __restrict__ scale,
                       float* scr, int item, int lane) {
    const int nblk = N >> 5, kb = item / nblk, nb = item % nblk, k0 = kb * 64, n0 = nb * 32;
#pragma unroll 8
    for (int i = 0; i < 32; ++i) {
        const int kk = 2 * i + (lane >> 5);
        float v = W[(size_t)(k0 + kk) * N + n0 + (lane & 31)];
        if (scale) v *= scale[k0 + kk];
        scr[kk * 33 + (lane & 31)] = v;
    }
    asm volatile("s_waitcnt lgkmcnt(0)" ::: "memory");
    const int c = lane & 7;
#pragma unroll
    for (int j = 0; j < 4; ++j) {
        const int nl = (lane >> 3) + 8 * j;
        const float* s = scr + (8 * c) * 33 + nl;
        u32x4 o;
        o.x = pk2(s[0 * 33], s[1 * 33]); o.y = pk2(s[2 * 33], s[3 * 33]); o.z = pk2(s[4 * 33], s[5 * 33]); o.w = pk2(s[6 * 33], s[7 * 33]);
        const int n = n0 + nl;
        int row;
        if (mode == 1) row = n < 1184 ? n : n + 96;
        else if (mode == 2) { const int h = n >> 7, jj = n & 127; row = jj < 64 ? h * 64 + jj : 512 + h * 64 + (jj - 64); }
        else row = n;
        *(u32x4*)(WT + (size_t)row * K + k0 + 8 * c) = o;
    }
    asm volatile("s_waitcnt lgkmcnt(0)" ::: "memory");
}

DI void phase0(const Params& p, char* lds) {
    const int tid = threadIdx.x, bid = blockIdx.x, G = gridDim.x, lane = tid & 63, wave = tid >> 6;
    unsigned char* ws = p.ws;
    float* sc = (float*)lds;
    for (int it = bid; it < 384; it += G) {
        const int cb = it % 24, ks = it / 24;
        __syncthreads();
        for (int i = tid; i < 24 * 64; i += 256) {
            const int b = i >> 6, k = i & 63;
            const float* c = b < 8 ? p.in[2] + b * 1024 : p.in[3] + (b - 8) * 1024;
            const float v = c[ks * 64 + k];
            sc[i] = v * sigmoidf_(v);
        }
        __syncthreads();
        float a[24];
#pragma unroll
        for (int b = 0; b < 24; ++b) a[b] = 0.f;
        const int n = cb * 256 + tid;
        const float* w = p.in[4] + (size_t)(ks * 64) * 6144 + n;
        for (int k = 0; k < 64; ++k) {
            const float wv = w[(size_t)k * 6144];
#pragma unroll
            for (int b = 0; b < 24; ++b) a[b] += sc[b * 64 + k] * wv;
        }
        float* mp = (float*)(ws + O_MODP) + (size_t)(ks * 24) * 6144 + n;
#pragma unroll
        for (int b = 0; b < 24; ++b) mp[(size_t)b * 6144] = a[b];
    }
    __syncthreads();
    {
        float* scr = (float*)(lds + wave * 8448);
        const int gw = bid * 4 + wave, NGW = G * 4;
        constexpr int I0 = 16 * 101, I1 = 4 * 24, I2 = 2 * 32, I3 = 8 * 32, I4 = 8 * 32, I5 = 16 * 32, I6 = 16 * 176, I7 = 44 * 32;
        constexpr int NI = I0 + I1 + I2 + I3 + I4 + I5 + I6 + I7;
        for (int it = gw; it < NI; it += NGW) {
            int q = it;
            if (q < I0) { transpose_item(p.in[7], 1024, IN_TOTAL, (bf16_t*)(ws + O_WIN), 1, nullptr, scr, q, lane); continue; } q -= I0;
            if (q < I1) { transpose_item(p.in[12], 256, 768, (bf16_t*)(ws + O_WUQ), 0, p.in[11], scr, q, lane); continue; } q -= I1;
            if (q < I2) { transpose_item(p.in[14], 128, 1024, (bf16_t*)(ws + O_WUKV), 2, p.in[13], scr, q, lane); continue; } q -= I2;
            if (q < I3) { transpose_item(p.in[17], 512, 1024, (bf16_t*)(ws + O_WOA), 0, nullptr, scr, q, lane); continue; } q -= I3;
            if (q < I4) { transpose_item(p.in[18], 512, 1024, (bf16_t*)(ws + O_WOB), 0, nullptr, scr, q, lane); continue; } q -= I4;
            if (q < I5) { transpose_item(p.in[19], 1024, 1024, (bf16_t*)(ws + O_WOUT), 0, nullptr, scr, q, lane); continue; } q -= I5;
            if (q < I6) { transpose_item(p.in[21], 1024, NUP, (bf16_t*)(ws + O_WUP), 0, nullptr, scr, q, lane); continue; } q -= I6;
            transpose_item(p.in[24], DFF, 1024, (bf16_t*)(ws + O_WDN), 0, nullptr, scr, q, lane);
        }
    }
    const int gt = bid * 256 + tid, NGT = G * 256;
    for (int i = gt; i < 4096 * 48; i += NGT) {
        const int pos = i / 48, j = i % 48;
        float inv;
        if (j < 32) inv = exp2f(-(float)(2 * j) * (1.f / 64.f) * 13.287712379549449f);
        else inv = exp2f(-(float)(2 * (j - 32)) * (1.f / 32.f) * 13.287712379549449f);
        const float ang = (float)pos * inv;
        float rev = ang * 0.15915494309189535f;
        rev -= floorf(rev);
        const float sn = __builtin_amdgcn_sinf(rev), cs = __builtin_amdgcn_cosf(rev);
        float2* dst = j < 32 ? (float2*)(ws + O_ROPEA) + pos * 32 + j : (float2*)(ws + O_ROPEB) + pos * 16 + (j - 32);
        *dst = make_float2(cs, sn);
    }
    for (int i = gt; i < 96 * 1024 / 8; i += NGT) *(u32x4*)((bf16_t*)(ws + O_WIN) + 1184 * 1024 + (size_t)i * 8) = (u32x4){0u, 0u, 0u, 0u};
}

DI void phase0m(const Params& p) {
    const int gt = blockIdx.x * 256 + threadIdx.x, NGT = gridDim.x * 256;
    const float* mp = (const float*)(p.ws + O_MODP);
    float* mod = (float*)(p.ws + O_MOD);
    for (int i = gt; i < 24 * 6144; i += NGT) {
        float s = p.in[5][i % 6144];
#pragma unroll
        for (int ks = 0; ks < 16; ++ks) s += mp[(size_t)ks * 24 * 6144 + i];
        mod[i] = s;
    }
}

DI void norm_pass(const Params& p, bool second, bf16_t* dst) {
    const int lane = threadIdx.x & 63, gw = blockIdx.x * 4 + (threadIdx.x >> 6), NGW = gridDim.x * 4;
    const float* gwt = second ? p.in[20] : p.in[6];
    const float* mod = (const float*)(p.ws + O_MOD);
    f32x4 gv[4];
#pragma unroll
    for (int j = 0; j < 4; ++j) gv[j] = *((const f32x4*)gwt + 64 * j + lane);
    for (int t = gw; t < T; t += NGW) {
        const float* xr = second ? p.out + (size_t)t * D : xrow_ptr(p, t);
        const int b = t >> 12;
        const float* sh = mod + (size_t)b * 6144 + (second ? 3072 : 0);
        const float* sc = sh + 1024;
        f32x4 v[4]; float s = 0.f;
#pragma unroll
        for (int j = 0; j < 4; ++j) { v[j] = *((const f32x4*)xr + 64 * j + lane); s += (v[j].x * v[j].x + v[j].y * v[j].y) + (v[j].z * v[j].z + v[j].w * v[j].w); }
        const float rstd = rsqrtf(wave_sum(s) * (1.f / D) + EPS);
        u32x2* o = (u32x2*)(dst + (size_t)t * D) + lane;
#pragma unroll
        for (int j = 0; j < 4; ++j) {
            const f32x4 scv = *((const f32x4*)sc + 64 * j + lane), shv = *((const f32x4*)sh + 64 * j + lane);
            f32x4 y;
            y.x = v[j].x * rstd * gv[j].x * (1.f + scv.x) + shv.x; y.y = v[j].y * rstd * gv[j].y * (1.f + scv.y) + shv.y;
            y.z = v[j].z * rstd * gv[j].z * (1.f + scv.z) + shv.z; y.w = v[j].w * rstd * gv[j].w * (1.f + scv.w) + shv.w;
            o[64 * j] = (u32x2){pk2(y.x, y.y), pk2(y.z, y.w)};
        }
    }
}

DI void phase1(const Params& p, char* lds) {
    const bf16_t* H = (const bf16_t*)(p.ws + O_H);
    const bf16_t* W = (const bf16_t*)(p.ws + O_WIN);
    bf16_t* ZS = (bf16_t*)(p.ws + O_ZS);
    bf16_t* Gt = (bf16_t*)((unsigned char*)p.out + OO_G);
    constexpr int nM = T / 128, nN = NIN / 128, NTILES = nM * nN;
    const int lane = threadIdx.x & 63, wave = threadIdx.x >> 6, wm = wave >> 1, wn = wave & 1, r = lane & 15, g = lane >> 4;
    for (int L = blockIdx.x; L < NTILES; L += gridDim.x) {
        int pm, pn; tile_map(L, nN, NTILES, pm, pn);
        f32x4 acc[4][4]; zero_acc(acc);
        gemm_mainloop<128, 128, 2, 2>(acc, H + (size_t)pm * 128 * 1024, 1024, W + (size_t)pn * 128 * 1024, 1024, 1024, lds);
        const int col0 = pn * 128 + wn * 64 + g * 4;
#pragma unroll
        for (int mt = 0; mt < 4; ++mt) {
            const int m = pm * 128 + wm * 64 + mt * 16 + r;
#pragma unroll
            for (int nt = 0; nt < 4; ++nt) {
                const int n = col0 + nt * 16;
                const f32x4 a = acc[mt][nt];
                if (pn < NZ / 128) *(u32x2*)(ZS + (size_t)m * NZ + n) = (u32x2){pk2(a.x, a.y), pk2(a.z, a.w)};
                else *(u32x2*)(Gt + (size_t)m * 2048 + (n - NZ)) = (u32x2){pk2(sigmoidf_(a.x), sigmoidf_(a.y)), pk2(sigmoidf_(a.z), sigmoidf_(a.w))};
            }
        }
    }
}

template <int NCH>
DI float row_sumsq(const bf16_t* rowp, int g) {
    float s = 0.f;
#pragma unroll
    for (int c = 0; c < NCH; ++c) {
        const u32x4 v = *(const u32x4*)(rowp + (g * NCH + c) * 8);
#pragma unroll
        for (int e = 0; e < 4; ++e) { const float a = bflo(v[e]), b = bfhi(v[e]); s += a * a + b * b; }
    }
    return xor_reduce_g(s);
}

DI void phase2(const Params& p, char* lds) {
    unsigned char* ws = p.ws;
    const bf16_t* ZS = (const bf16_t*)(ws + O_ZS);
    const int tid = threadIdx.x, lane = tid & 63, wave = tid >> 6, r = lane & 15, g = lane >> 4;
    const float2* ropeA = (const float2*)(ws + O_ROPEA);
    const float2* ropeB = (const float2*)(ws + O_ROPEB);
    constexpr int NTL = T / 128;
    for (int it = blockIdx.x; it < NTL * 8; it += gridDim.x) {
        const int tile = it >> 3, sub = it & 7, t0 = tile * 128, b = t0 >> 12, s0 = t0 & (S - 1);
        {
            const int h = sub;
            f32x4 acc[2][6]; zero_acc(acc);
            gemm_mainloop<128, 96, 4, 1>(acc, ZS + (size_t)t0 * NZ + 768, NZ, (const bf16_t*)(ws + O_WUQ) + (size_t)h * 96 * 256, 256, 256, lds);
            const float* gq = p.in[15];
            const float qs = 0.10206207261596577f * LOG2E;
            bf16_t* QB = (bf16_t*)(ws + O_QB) + ((size_t)(b * 8 + h) * S) * 96;
#pragma unroll
            for (int mt = 0; mt < 2; ++mt) {
                const int ml = wave * 32 + mt * 16 + r, sp = s0 + ml;
                const float rstd = rsqrtf(row_sumsq<8>(ZS + (size_t)(t0 + ml) * NZ + 768, g) * (1.f / 256.f) + EPS);
                float ss = 0.f;
#pragma unroll
                for (int nt = 0; nt < 6; ++nt) { acc[mt][nt] = acc[mt][nt] * rstd; const f32x4 a = acc[mt][nt]; ss += (a.x * a.x + a.y * a.y) + (a.z * a.z + a.w * a.w); }
                const float r2 = rsqrtf(xor_reduce_g(ss) * (1.f / 96.f) + EPS);
#pragma unroll
                for (int nt = 0; nt < 6; ++nt) {
                    const f32x4 gg = *(const f32x4*)(gq + nt * 16 + g * 4);
                    acc[mt][nt] = acc[mt][nt] * r2 * gg;
                }
#pragma unroll
                for (int j = 0; j < 4; ++j) {
                    const float2 cs = ropeB[sp * 16 + g * 4 + j];
                    const float x1 = acc[mt][4][j], x2 = acc[mt][5][j];
                    acc[mt][4][j] = x1 * cs.x - x2 * cs.y;
                    acc[mt][5][j] = x1 * cs.y + x2 * cs.x;
                }
                bf16_t* qrow = QB + (size_t)sp * 96 + g * 4;
#pragma unroll
                for (int nt = 0; nt < 6; ++nt) { const f32x4 a = acc[mt][nt] * qs; *(u32x2*)(qrow + nt * 16) = (u32x2){pk2(a.x, a.y), pk2(a.z, a.w)}; }
                __builtin_amdgcn_sched_barrier(0);
            }
        }
    }
    for (int it = blockIdx.x; it < NTL * 4; it += gridDim.x) {
        const int tile = it >> 2, hp = it & 3, t0 = tile * 128, b = t0 >> 12, s0 = t0 & (S - 1);
        {
            f32x4 acc[4][4]; zero_acc(acc);
            gemm_mainloop<128, 128, 2, 2>(acc, ZS + (size_t)t0 * NZ + 1024, NZ,
                                          (const bf16_t*)(ws + O_WUKV) + (size_t)(hp * 128) * 128, 128, 128, lds);
            const int wm = wave >> 1, wn = wave & 1, h = hp * 2 + wn;
            {
                const float* gk = p.in[16];
                bf16_t* KB = (bf16_t*)(ws + O_KB) + ((size_t)(b * 8 + h) * S) * 96;
#pragma unroll
                for (int mt = 0; mt < 4; ++mt) {
                    const int ml = wm * 64 + mt * 16 + r, sp = s0 + ml;
                    const bf16_t* zrow = ZS + (size_t)(t0 + ml) * NZ;
                    const float rstd = rsqrtf(row_sumsq<4>(zrow + 1024, g) * (1.f / 128.f) + EPS);
                    const u32x2 k1 = *(const u32x2*)(zrow + 1152 + g * 4), k2 = *(const u32x2*)(zrow + 1168 + g * 4);
                    float x1[4] = {bflo(k1.x), bfhi(k1.x), bflo(k1.y), bfhi(k1.y)};
                    float x2[4] = {bflo(k2.x), bfhi(k2.x), bflo(k2.y), bfhi(k2.y)};
                    float ss = 0.f;
#pragma unroll
                    for (int j = 0; j < 4; ++j) ss += x1[j] * x1[j] + x2[j] * x2[j];
#pragma unroll
                    for (int nt = 0; nt < 4; ++nt) { acc[mt][nt] = acc[mt][nt] * rstd; const f32x4 a = acc[mt][nt]; ss += (a.x * a.x + a.y * a.y) + (a.z * a.z + a.w * a.w); }
                    const float r2 = rsqrtf(xor_reduce_g(ss) * (1.f / 96.f) + EPS);
                    bf16_t* krow = KB + (size_t)sp * 96 + g * 4;
#pragma unroll
                    for (int nt = 0; nt < 4; ++nt) {
                        const f32x4 gg = *(const f32x4*)(gk + nt * 16 + g * 4);
                        const f32x4 a = acc[mt][nt] * r2 * gg;
                        *(u32x2*)(krow + nt * 16) = (u32x2){pk2(a.x, a.y), pk2(a.z, a.w)};
                    }
                    const f32x4 g1 = *(const f32x4*)(gk + 64 + g * 4), g2 = *(const f32x4*)(gk + 80 + g * 4);
                    float o1[4], o2[4];
#pragma unroll
                    for (int j = 0; j < 4; ++j) {
                        const float2 cs = ropeB[sp * 16 + g * 4 + j];
                        const float y1 = x1[j] * r2 * g1[j], y2 = x2[j] * r2 * g2[j];
                        o1[j] = y1 * cs.x - y2 * cs.y; o2[j] = y1 * cs.y + y2 * cs.x;
                    }
                    *(u32x2*)(krow + 64) = (u32x2){pk2(o1[0], o1[1]), pk2(o1[2], o1[3])};
                    *(u32x2*)(krow + 80) = (u32x2){pk2(o2[0], o2[1]), pk2(o2[2], o2[3])};
                    __builtin_amdgcn_sched_barrier(0);
                }
            }
        }
    }
    for (int it = blockIdx.x; it < NTL * 4; it += gridDim.x) {
        const int tile = it >> 2, hp = it & 3, t0 = tile * 128, b = t0 >> 12, s0 = t0 & (S - 1);
        {
            f32x4 acc[4][4]; zero_acc(acc);
            gemm_mainloop<128, 128, 2, 2>(acc, ZS + (size_t)t0 * NZ + 1024, NZ,
                                          (const bf16_t*)(ws + O_WUKV) + (size_t)(512 + hp * 128) * 128, 128, 128, lds);
            const int wm = wave >> 1, wn = wave & 1, h = hp * 2 + wn;
            {
                bf16_t* VT = (bf16_t*)(ws + O_VTB) + ((size_t)(b * 8 + h) * 64) * S;
#pragma unroll
                for (int mt = 0; mt < 4; ++mt) {
                    const int ml = wm * 64 + mt * 16 + r, sp = s0 + ml;
                    const float rstd = rsqrtf(row_sumsq<4>(ZS + (size_t)(t0 + ml) * NZ + 1024, g) * (1.f / 128.f) + EPS);
                    const int ps = perm32(sp);
#pragma unroll
                    for (int nt = 0; nt < 4; ++nt)
#pragma unroll
                        for (int j = 0; j < 4; ++j) VT[(size_t)(nt * 16 + g * 4 + j) * S + ps] = f2bf(acc[mt][nt][j] * rstd);
                    __builtin_amdgcn_sched_barrier(0);
                }
            }
        }
    }
    __syncthreads();
    for (int tile = blockIdx.x; tile < NTL; tile += gridDim.x) {
        const int t0 = tile * 128, b = t0 >> 12, s0 = t0 & (S - 1);
        {
            const float* gqa = p.in[8];
            const float* gka = p.in[9];
            const int half = lane >> 5, i = lane & 31;
            const float qs = 0.125f * LOG2E;
            for (int tt = wave; tt < 128; tt += 4) {
                const int sp = s0 + tt;
                const bf16_t* zrow = ZS + (size_t)(t0 + tt) * NZ;
                const float2 cs = ropeA[sp * 32 + i];
#pragma unroll
                for (int hh = 0; hh < 10; hh += 2) {
                    const int hd = hh + half;
                    const float x1 = bf2f(zrow[hd * 64 + i]), x2 = bf2f(zrow[hd * 64 + 32 + i]);
                    float ss = x1 * x1 + x2 * x2;
#pragma unroll
                    for (int o = 1; o < 32; o <<= 1) ss += __shfl_xor(ss, o);
                    const float rr = rsqrtf(ss * (1.f / 64.f) + EPS);
                    const float* gg = hd < 8 ? gqa : gka;
                    const float y1 = x1 * rr * gg[i], y2 = x2 * rr * gg[32 + i];
                    float o1 = y1 * cs.x - y2 * cs.y, o2 = y1 * cs.y + y2 * cs.x;
                    bf16_t* dst;
                    if (hd < 8) { o1 *= qs; o2 *= qs; dst = (bf16_t*)(ws + O_QA) + ((size_t)(b * 8 + hd) * S + sp) * 64; }
                    else dst = (bf16_t*)(ws + O_KA) + ((size_t)(b * 2 + (hd - 8)) * S + sp) * 64;
                    dst[i] = f2bf(o1); dst[32 + i] = f2bf(o2);
                }
            }
            __syncthreads();
            bf16_t* tl = (bf16_t*)lds;
            for (int idx = tid; idx < 128 * 16; idx += 256) {
                const int tt = idx >> 4, c = idx & 15;
                const u32x4 v = *(const u32x4*)(ZS + (size_t)(t0 + tt) * NZ + 640 + c * 8);
                u32x2* d2 = (u32x2*)(tl + tt * 132 + c * 8);
                d2[0] = (u32x2){v.x, v.y}; d2[1] = (u32x2){v.z, v.w};
            }
            __syncthreads();
            bf16_t* VT = (bf16_t*)(ws + O_VTA) + ((size_t)(b * 2) * 64) * S;
            for (int idx = tid; idx < 128 * 128; idx += 256) {
                const int pp = idx & 127, dd = idx >> 7;
                const int lo = pp & 31;
                const int tt = (pp & ~31) | (((lo >> 2) & 1) << 4) | ((lo >> 3) << 2) | (lo & 3);
                VT[(size_t)dd * S + s0 + pp] = tl[tt * 132 + dd];
            }
            __syncthreads();
        }
    }
}

template <int DQK, bool WIN>
DI void attn_item(const bf16_t* __restrict__ Qw, const bf16_t* __restrict__ Kb, const bf16_t* __restrict__ Vt, int key0, int ntiles, int q0,
                  float shift2, float sink_term, bf16_t* __restrict__ Ow, int ldo, char* lds) {
    constexpr int KS = DQK / 32, CH = DQK / 8, KSTR = DQK * 2 + 32, NKL = CH * 64 / 256, VSTR = 160, STAGE = 64 * 224 + 64 * VSTR;
    const int tid = threadIdx.x, lane = tid & 63, r = lane & 15, g = lane >> 4;
    bf16x8 qf[2][KS];
#pragma unroll
    for (int qt = 0; qt < 2; ++qt)
#pragma unroll
        for (int ks = 0; ks < KS; ++ks) qf[qt][ks] = *(const bf16x8*)(Qw + (size_t)(qt * 16 + r) * DQK + ks * 32 + g * 8);
    f32x4 oacc[4][2];
#pragma unroll
    for (int i = 0; i < 4; ++i) { oacc[i][0] = (f32x4){0.f, 0.f, 0.f, 0.f}; oacc[i][1] = (f32x4){0.f, 0.f, 0.f, 0.f}; }
    float lsum[2] = {0.f, 0.f};
    u32x4 rk[NKL], rv[2];
    int krow[NKL], kc[NKL];
#pragma unroll
    for (int i = 0; i < NKL; ++i) { const int idx = tid + 256 * i; krow[i] = idx / CH; kc[i] = idx % CH; }
    const int vrow = tid >> 3, vc = tid & 7;
    auto gload = [&](int tile) {
        const int kb = key0 + tile * 64;
#pragma unroll
        for (int i = 0; i < NKL; ++i) rk[i] = *(const u32x4*)(Kb + (size_t)(kb + krow[i]) * DQK + kc[i] * 8);
#pragma unroll
        for (int i = 0; i < 2; ++i) rv[i] = *(const u32x4*)(Vt + (size_t)(vrow + 32 * i) * S + kb + vc * 8);
    };
    auto lstore = [&](int st) {
        char* sK = lds + st * STAGE; char* sV = sK + 64 * 224;
#pragma unroll
        for (int i = 0; i < NKL; ++i) *(u32x4*)(sK + krow[i] * KSTR + kc[i] * 16) = rk[i];
#pragma unroll
        for (int i = 0; i < 2; ++i) *(u32x4*)(sV + (vrow + 32 * i) * VSTR + vc * 16) = rv[i];
    };
    __syncthreads();
    gload(0); lstore(0);
    __syncthreads();
    for (int tile = 0; tile < ntiles; ++tile) {
        const int cur = tile & 1;
        const bool more = tile + 1 < ntiles;
        if (more) gload(tile + 1);
        const char* sK = lds + cur * STAGE; const char* sV = sK + 64 * 224;
        f32x4 sacc[4][2];
#pragma unroll
        for (int kt = 0; kt < 4; ++kt) {
            sacc[kt][0] = (f32x4){0.f, 0.f, 0.f, 0.f}; sacc[kt][1] = (f32x4){0.f, 0.f, 0.f, 0.f};
#pragma unroll
            for (int ks = 0; ks < KS; ++ks) {
                const bf16x8 kf = *(const bf16x8*)(sK + (kt * 16 + r) * KSTR + (ks * 4 + g) * 16);
                sacc[kt][0] = __builtin_amdgcn_mfma_f32_16x16x32_bf16(kf, qf[0][ks], sacc[kt][0], 0, 0, 0);
                sacc[kt][1] = __builtin_amdgcn_mfma_f32_16x16x32_bf16(kf, qf[1][ks], sacc[kt][1], 0, 0, 0);
            }
        }
        const int kbase = key0 + tile * 64 + g * 4;
#pragma unroll
        for (int kt = 0; kt < 4; ++kt)
#pragma unroll
            for (int qt = 0; qt < 2; ++qt)
#pragma unroll
                for (int j = 0; j < 4; ++j) {
                    float pv = fast_exp2(sacc[kt][qt][j] - shift2);
                    if (WIN) { const int dlt = (kbase + kt * 16 + j) - (q0 + qt * 16 + r); if (dlt > 128 || dlt < -128) pv = 0.f; }
                    sacc[kt][qt][j] = pv; lsum[qt] += pv;
                }
#pragma unroll
        for (int kk = 0; kk < 2; ++kk) {
            bf16x8 pb[2];
#pragma unroll
            for (int qt = 0; qt < 2; ++qt) {
                u32x4 u;
                u.x = pk2(sacc[2 * kk][qt][0], sacc[2 * kk][qt][1]); u.y = pk2(sacc[2 * kk][qt][2], sacc[2 * kk][qt][3]);
                u.z = pk2(sacc[2 * kk + 1][qt][0], sacc[2 * kk + 1][qt][1]); u.w = pk2(sacc[2 * kk + 1][qt][2], sacc[2 * kk + 1][qt][3]);
                pb[qt] = __builtin_bit_cast(bf16x8, u);
            }
#pragma unroll
            for (int dt = 0; dt < 4; ++dt) {
                const bf16x8 vf = *(const bf16x8*)(sV + (dt * 16 + r) * VSTR + (kk * 4 + g) * 16);
                oacc[dt][0] = __builtin_amdgcn_mfma_f32_16x16x32_bf16(vf, pb[0], oacc[dt][0], 0, 0, 0);
                oacc[dt][1] = __builtin_amdgcn_mfma_f32_16x16x32_bf16(vf, pb[1], oacc[dt][1], 0, 0, 0);
            }
        }
        if (more) lstore(cur ^ 1);
        __syncthreads();
    }
#pragma unroll
    for (int qt = 0; qt < 2; ++qt) {
        const float inv = fast_rcp(xor_reduce_g(lsum[qt]) + sink_term);
        bf16_t* orow = Ow + (size_t)(qt * 16 + r) * ldo + g * 4;
#pragma unroll
        for (int dt = 0; dt < 4; ++dt) { const f32x4 a = oacc[dt][qt] * inv; *(u32x2*)(orow + dt * 16) = (u32x2){pk2(a.x, a.y), pk2(a.z, a.w)}; }
    }
}

DI float max_abs(const float* v, int n) { float m = 0.f; for (int i = 0; i < n; ++i) m = fmaxf(m, fabsf(v[i])); return m; }

DI void phase3(const Params& p, char* lds) {
    unsigned char* ws = p.ws;
    const int wave = threadIdx.x >> 6;
    const float shiftB = 9.797958971132712f * max_abs(p.in[15], 96) * max_abs(p.in[16], 96) * LOG2E;
    const float shiftA = 8.f * max_abs(p.in[8], 64) * max_abs(p.in[9], 64) * LOG2E;
    bf16_t* OA = (bf16_t*)(p.ws + O_OA);
    bf16_t* OB = (bf16_t*)(p.ws + O_OB);
    constexpr int NB_ITEMS = 24 * 8 * 32, NA_ITEMS = 24 * 2 * 128;
    for (int L = blockIdx.x; L < NB_ITEMS; L += gridDim.x) {
        const int idx = (L & 7) * (NB_ITEMS / 8) + (L >> 3);
        const int bh = idx >> 5, qb = idx & 31, b = bh >> 3, h = bh & 7;
        const int q0 = qb * 128 + wave * 32;
        attn_item<96, false>((const bf16_t*)(ws + O_QB) + ((size_t)bh * S + q0) * 96, (const bf16_t*)(ws + O_KB) + (size_t)bh * S * 96,
                             (const bf16_t*)(ws + O_VTB) + (size_t)bh * 64 * S, 0, S / 64, q0, shiftB, 0.f,
                             OB + ((size_t)b * S + q0) * 512 + h * 64, 512, lds);
    }
    for (int L = blockIdx.x; L < NA_ITEMS; L += gridDim.x) {
        const int idx = (L & 7) * (NA_ITEMS / 8) + (L >> 3);
        const int bk = idx >> 7, qb = idx & 127, b = bk >> 1, kvh = bk & 1;
        const int q0 = qb * 32, hd = kvh * 4 + wave;
        int ks = (q0 - 128) & ~63; if (ks < 0) ks = 0;
        int ke = (q0 + 32 + 128 + 63) & ~63; if (ke > S) ke = S;
        const float sink_term = fast_exp2(p.in[10][hd] * LOG2E - shiftA);
        attn_item<64, true>((const bf16_t*)(ws + O_QA) + ((size_t)(b * 8 + hd) * S + q0) * 64, (const bf16_t*)(ws + O_KA) + (size_t)bk * S * 64,
                            (const bf16_t*)(ws + O_VTA) + (size_t)bk * 64 * S, ks, (ke - ks) >> 6, q0, shiftA, sink_term,
                            OA + ((size_t)b * S + q0) * 512 + hd * 64, 512, lds);
    }
}

DI void phase4(const Params& p, char* lds) {
    const bf16_t* OA = (const bf16_t*)(p.ws + O_OA);
    const bf16_t* OB = (const bf16_t*)(p.ws + O_OB);
    const bf16_t* Gt = (const bf16_t*)((unsigned char*)p.out + OO_G);
    bf16_t* MIX = (bf16_t*)(p.ws + O_ZS);
    constexpr int nM = T / 128, nN = 8, NTILES = nM * nN;
    const int lane = threadIdx.x & 63, wave = threadIdx.x >> 6, wm = wave >> 1, wn = wave & 1, r = lane & 15, g = lane >> 4;
    for (int L = blockIdx.x; L < NTILES; L += gridDim.x) {
        int pm, pn; tile_map(L, nN, NTILES, pm, pn);
        f32x4 acc[4][4]; u32x2 mixp[4][4]; zero_acc(acc);
        gemm_mainloop<128, 128, 2, 2>(acc, OA + (size_t)pm * 128 * 512, 512, (const bf16_t*)(p.ws + O_WOA) + (size_t)pn * 128 * 512, 512, 512, lds);
        const int col0 = pn * 128 + wn * 64 + g * 4;
#pragma unroll
        for (int mt = 0; mt < 4; ++mt) {
            const int m = pm * 128 + wm * 64 + mt * 16 + r;
#pragma unroll
            for (int nt = 0; nt < 4; ++nt) {
                const u32x2 gv = *(const u32x2*)(Gt + (size_t)m * 2048 + col0 + nt * 16);
                const f32x4 a = acc[mt][nt];
                mixp[mt][nt] = (u32x2){pk2(a.x * bflo(gv.x), a.y * bfhi(gv.x)), pk2(a.z * bflo(gv.y), a.w * bfhi(gv.y))};
            }
        }
        zero_acc(acc);
        gemm_mainloop<128, 128, 2, 2>(acc, OB + (size_t)pm * 128 * 512, 512, (const bf16_t*)(p.ws + O_WOB) + (size_t)pn * 128 * 512, 512, 512, lds);
#pragma unroll
        for (int mt = 0; mt < 4; ++mt) {
            const int m = pm * 128 + wm * 64 + mt * 16 + r;
#pragma unroll
            for (int nt = 0; nt < 4; ++nt) {
                const u32x2 gv = *(const u32x2*)(Gt + (size_t)m * 2048 + 1024 + col0 + nt * 16);
                const f32x4 a = acc[mt][nt]; const u32x2 mx = mixp[mt][nt];
                const float o0 = bflo(mx.x) + a.x * bflo(gv.x), o1 = bfhi(mx.x) + a.y * bfhi(gv.x), o2 = bflo(mx.y) + a.z * bflo(gv.y), o3 = bfhi(mx.y) + a.w * bfhi(gv.y);
                *(u32x2*)(MIX + (size_t)m * 1024 + col0 + nt * 16) = (u32x2){pk2(o0, o1), pk2(o2, o3)};
            }
        }
    }
}

DI void phase5(const Params& p, char* lds) {
    const bf16_t* MIX = (const bf16_t*)(p.ws + O_ZS);
    const float* mod = (const float*)(p.ws + O_MOD);
    constexpr int nM = T / 128, nN = 8, NTILES = nM * nN;
    const int lane = threadIdx.x & 63, wave = threadIdx.x >> 6, wm = wave >> 1, wn = wave & 1, r = lane & 15, g = lane >> 4;
    for (int L = blockIdx.x; L < NTILES; L += gridDim.x) {
        int pm, pn; tile_map(L, nN, NTILES, pm, pn);
        f32x4 acc[4][4]; zero_acc(acc);
        gemm_mainloop<128, 128, 2, 2>(acc, MIX + (size_t)pm * 128 * 1024, 1024, (const bf16_t*)(p.ws + O_WOUT) + (size_t)pn * 128 * 1024, 1024, 1024, lds);
        const int col0 = pn * 128 + wn * 64 + g * 4;
        const int b = (pm * 128) >> 12;
        const float* gt1 = mod + (size_t)b * 6144 + 2048;
#pragma unroll
        for (int mt = 0; mt < 4; ++mt) {
            const int m = pm * 128 + wm * 64 + mt * 16 + r;
            const float* xr = xrow_ptr(p, m);
#pragma unroll
            for (int nt = 0; nt < 4; ++nt) {
                const int n = col0 + nt * 16;
                const f32x4 xv = *(const f32x4*)(xr + n), gv = *(const f32x4*)(gt1 + n);
                *(f32x4*)(p.out + (size_t)m * D + n) = xv + gv * acc[mt][nt];
            }
        }
    }
}

DI void phase7(const Params& p, char* lds, int chunk) {
    const bf16_t* H2 = (const bf16_t*)(p.ws + O_H) + (size_t)chunk * TCH * 1024;
    bf16_t* UP = (bf16_t*)(p.ws + O_UP);
    constexpr int nM = TCH / 128, nN = NUP / 128, NTILES = nM * nN;
    const int lane = threadIdx.x & 63, wave = threadIdx.x >> 6, wm = wave >> 1, wn = wave & 1, r = lane & 15, g = lane >> 4;
    for (int L = blockIdx.x; L < NTILES; L += gridDim.x) {
        int pm, pn; tile_map(L, nN, NTILES, pm, pn);
        f32x4 acc[4][4]; zero_acc(acc);
        gemm_mainloop<128, 128, 2, 2>(acc, H2 + (size_t)pm * 128 * 1024, 1024, (const bf16_t*)(p.ws + O_WUP) + (size_t)pn * 128 * 1024, 1024, 1024, lds);
        const int col0 = pn * 128 + wn * 64 + g * 4;
#pragma unroll
        for (int mt = 0; mt < 4; ++mt) {
            const int m = pm * 128 + wm * 64 + mt * 16 + r;
#pragma unroll
            for (int nt = 0; nt < 4; ++nt) {
                const f32x4 a = acc[mt][nt];
                *(u32x2*)(UP + (size_t)m * NUP + col0 + nt * 16) = (u32x2){pk2(a.x, a.y), pk2(a.z, a.w)};
            }
        }
    }
}

DI void unpack8(const u32x4 v, float (&f)[8]) {
    f[0] = bflo(v.x); f[1] = bfhi(v.x); f[2] = bflo(v.y); f[3] = bfhi(v.y); f[4] = bflo(v.z); f[5] = bfhi(v.z); f[6] = bflo(v.w); f[7] = bfhi(v.w);
}

DI void phase7b(const Params& p) {
    const bf16_t* UP = (const bf16_t*)(p.ws + O_UP);
    bf16_t* ACT = (bf16_t*)(p.ws + O_ACT);
    const float* cw = p.in[22];
    const float* cb = p.in[23];
    const int gt = blockIdx.x * 256 + threadIdx.x, NGT = gridDim.x * 256;
    constexpr int CPR = DFF / 8;
    for (int i = gt; i < TCH * CPR; i += NGT) {
        const int tl = i / CPR, c = (i % CPR) * 8;
        const int sp = tl & (S - 1);
        const float mp = sp > 0 ? 1.f : 0.f, mn = sp < S - 1 ? 1.f : 0.f;
        const int tp = sp > 0 ? tl - 1 : tl, tn = sp < S - 1 ? tl + 1 : tl;
        float u[2][8];
#pragma unroll
        for (int half = 0; half < 2; ++half) {
            const int col = c + half * DFF;
            float x0[8], x1[8], x2[8];
            unpack8(*(const u32x4*)(UP + (size_t)tp * NUP + col), x0);
            unpack8(*(const u32x4*)(UP + (size_t)tl * NUP + col), x1);
            unpack8(*(const u32x4*)(UP + (size_t)tn * NUP + col), x2);
#pragma unroll
            for (int q = 0; q < 2; ++q) {
                const f32x4 b4 = *(const f32x4*)(cb + col + 4 * q);
                const f32x4 w0 = *(const f32x4*)(cw + col + 4 * q) * mp, w1 = *(const f32x4*)(cw + NUP + col + 4 * q), w2 = *(const f32x4*)(cw + 2 * NUP + col + 4 * q) * mn;
#pragma unroll
                for (int e = 0; e < 4; ++e) u[half][4 * q + e] = b4[e] + w0[e] * x0[4 * q + e] + w1[e] * x1[4 * q + e] + w2[e] * x2[4 * q + e];
            }
        }
        float a[8];
#pragma unroll
        for (int e = 0; e < 8; ++e) a[e] = u[1][e] * sigmoidf_(u[1][e]) * u[0][e];
        u32x4 o;
        o.x = pk2(a[0], a[1]); o.y = pk2(a[2], a[3]); o.z = pk2(a[4], a[5]); o.w = pk2(a[6], a[7]);
        *(u32x4*)(ACT + (size_t)tl * DFF + c) = o;
    }
}

DI void phase8(const Params& p, char* lds, int chunk) {
    const bf16_t* ACT = (const bf16_t*)(p.ws + O_ACT);
    const float* mod = (const float*)(p.ws + O_MOD);
    constexpr int nM = TCH / 128, nN = 8, NTILES = nM * nN;
    const int lane = threadIdx.x & 63, wave = threadIdx.x >> 6, wm = wave >> 1, wn = wave & 1, r = lane & 15, g = lane >> 4;
    for (int L = blockIdx.x; L < NTILES; L += gridDim.x) {
        int pm, pn; tile_map(L, nN, NTILES, pm, pn);
        f32x4 acc[4][4]; zero_acc(acc);
        gemm_mainloop<128, 128, 2, 2>(acc, ACT + (size_t)pm * 128 * DFF, DFF, (const bf16_t*)(p.ws + O_WDN) + (size_t)pn * 128 * DFF, DFF, DFF, lds);
        const int col0 = pn * 128 + wn * 64 + g * 4;
        const int mg0 = chunk * TCH + pm * 128;
        const int b = mg0 >> 12;
        const float* gt2 = mod + (size_t)b * 6144 + 5120;
#pragma unroll
        for (int mt = 0; mt < 4; ++mt) {
            const int m = mg0 + wm * 64 + mt * 16 + r;
#pragma unroll
            for (int nt = 0; nt < 4; ++nt) {
                const int n = col0 + nt * 16;
                float* op = p.out + (size_t)m * D + n;
                const f32x4 xv = *(const f32x4*)op, gv = *(const f32x4*)(gt2 + n);
                *(f32x4*)op = xv + gv * acc[mt][nt];
            }
        }
    }
}

__global__ void __launch_bounds__(256, 2) fwd_megakernel(Params p) {
    __shared__ __attribute__((aligned(16))) char lds[65536];
    cg::grid_group grid = cg::this_grid();
#if PM & 1
    phase0(p, lds);
#endif
    grid.sync();
    for (int xs = 0; xs < XSYNC; ++xs) grid.sync();
#if PM & 2
    phase0m(p);
#endif
    grid.sync();
#if PM & 4
    norm_pass(p, false, (bf16_t*)(p.ws + O_H));
#endif
    grid.sync();
#if PM & 8
    phase1(p, lds);
#if DUP & 8
    grid.sync();
    phase1(p, lds);
#endif
#endif
    grid.sync();
#if PM & 16
    phase2(p, lds);
#if DUP & 16
    grid.sync();
    phase2(p, lds);
#endif
#endif
    grid.sync();
#if PM & 32
    phase3(p, lds);
#if DUP & 32
    grid.sync();
    phase3(p, lds);
#endif
#endif
    grid.sync();
#if PM & 64
    phase4(p, lds);
#endif
    grid.sync();
#if PM & 128
    phase5(p, lds);
#endif
    grid.sync();
#if PM & 256
    norm_pass(p, true, (bf16_t*)(p.ws + O_H));
#endif
    grid.sync();
    for (int c = 0; c < NCHUNK; ++c) {
#if PM & 512
        phase7(p, lds, c);
#endif
        grid.sync();
#if PM & 1024
        phase7b(p);
#endif
#if DUP & 512
        grid.sync();
        phase7(p, lds, c);
#endif
#if DUP & 1024
        grid.sync();
        phase7b(p);
#endif
        grid.sync();
#if PM & 2048
        phase8(p, lds, c);
#endif
        if (c + 1 < NCHUNK) grid.sync();
    }
}

extern "C" void kernel_launch(void* const* d_in, const int* in_sizes, int n_in, void* d_out, int out_size, void* d_ws, size_t ws_size,
                              hipStream_t stream) {
    static int grid_blocks = 0;
    if (!grid_blocks) {
        int dev = 0, cus = 0, per_cu = 0;
        hipGetDevice(&dev);
        hipDeviceGetAttribute(&cus, hipDeviceAttributeMultiprocessorCount, dev);
        hipOccupancyMaxActiveBlocksPerMultiprocessor(&per_cu, fwd_megakernel, 256, 0);
        if (per_cu < 1) per_cu = 1;
        if (per_cu > 2) per_cu = 2;
        grid_blocks = cus * per_cu;
        if (n_in != 25 || ws_size < WS_NEED || out_size != T * D)
            fprintf(stderr, "kernel_launch: unexpected sizes n_in=%d ws=%zu out=%d\n", n_in, ws_size, out_size);
    }
    Params p{};
    for (int i = 0; i < 25; ++i) p.in[i] = (const float*)d_in[i];
    p.out = (float*)d_out;
    p.ws = (unsigned char*)d_ws;
    void* args[] = {&p};
    hipError_t e = hipLaunchCooperativeKernel((void*)fwd_megakernel, dim3(grid_blocks), dim3(256), args, 0, stream);
    if (e != hipSuccess) fprintf(stderr, "cooperative launch failed: %s (grid %d)\n", hipGetErrorString(e), grid_blocks);
}
```

```cpp
#include <hip/hip_runtime.h>
#include <hip/hip_cooperative_groups.h>
#include <cstdio>
#include <cstdint>
namespace cg = cooperative_groups;
#ifndef PM
#define PM 4095
#endif
#ifndef DUP
#define DUP 0
#define XSYNC 0
#endif

typedef unsigned short bf16_t;
typedef short bf16x8 __attribute__((ext_vector_type(8)));
typedef float f32x4 __attribute__((ext_vector_type(4)));
typedef unsigned u32x4 __attribute__((ext_vector_type(4)));
typedef unsigned u32x2 __attribute__((ext_vector_type(2)));
#define DI __device__ __forceinline__

constexpr int D = 1024, S = 4096, NBATCH = 24, T = NBATCH * S;
constexpr int T_PROMPT = 8 * S;
constexpr int IN_TOTAL = 3232, NZ = 1280  , NIN = NZ + 2048;
constexpr int DFF = 2816, NUP = 2 * DFF;
constexpr float EPS = 1e-6f;
constexpr float LOG2E = 1.4426950408889634f;
constexpr int NCHUNK = 4, TCH = T / NCHUNK;

constexpr size_t MiB = 1024ull * 1024ull;
constexpr size_t O_WIN = 0;
constexpr size_t O_WUQ = O_WIN + (size_t)NIN * 1024 * 2;
constexpr size_t O_WUKV = O_WUQ + 768ull * 256 * 2;
constexpr size_t O_WOA = O_WUKV + 1024ull * 128 * 2;
constexpr size_t O_WOB = O_WOA + 1024ull * 512 * 2;
constexpr size_t O_WOUT = O_WOB + 1024ull * 512 * 2;
constexpr size_t O_WUP = O_WOUT + 1024ull * 1024 * 2;
constexpr size_t O_WDN = O_WUP + (size_t)NUP * 1024 * 2;
constexpr size_t O_MODP = O_WDN + 1024ull * DFF * 2;
constexpr size_t O_MOD = O_MODP + 16ull * 24 * 6144 * 4;
constexpr size_t O_ROPEA = O_MOD + 24ull * 6144 * 4;
constexpr size_t O_ROPEB = O_ROPEA + 4096ull * 32 * 8;
constexpr size_t O_ZROW = O_ROPEB + 4096ull * 16 * 8;
constexpr size_t O_WB_END = O_ZROW + 4096;
static_assert(O_WB_END <= 48 * MiB, "weights region");
constexpr size_t O_ZS = 48 * MiB;
constexpr size_t O_QA = 288 * MiB;
constexpr size_t O_KA = O_QA + 96 * MiB;
constexpr size_t O_VTA = O_KA + 24 * MiB;
constexpr size_t O_QB = O_VTA + 24 * MiB;
constexpr size_t O_KB = O_QB + 144 * MiB;
constexpr size_t O_VTB = O_KB + 144 * MiB;
constexpr size_t O_H = 816 * MiB;
constexpr size_t O_UP = 288 * MiB;
constexpr size_t O_ACT = 288 * MiB;
constexpr size_t WS_NEED = 1008 * MiB;
static_assert(O_VTB + 96 * MiB <= O_H, "qkv region");
constexpr size_t OO_G = 0, O_OA = O_H, O_OB = O_H + 96 * MiB;

struct Params {
    const float* in[25];
    float* out;
    unsigned char* ws;
};

typedef __bf16 bf16x2_t __attribute__((ext_vector_type(2)));
typedef float f32x2_t __attribute__((ext_vector_type(2)));
DI unsigned pk2(float lo, float hi) { const f32x2_t v = {lo, hi}; return __builtin_bit_cast(unsigned, __builtin_convertvector(v, bf16x2_t)); }
DI float bflo(unsigned u) { return __uint_as_float(u << 16); }
DI float bfhi(unsigned u) { return __uint_as_float(u & 0xffff0000u); }
DI float bf2f(bf16_t v) { return __uint_as_float(((unsigned)v) << 16); }
DI bf16_t f2bf(float v) { return (bf16_t)(pk2(v, v) & 0xffffu); }
DI float fast_rcp(float x) { return __builtin_amdgcn_rcpf(x); }
DI float fast_exp2(float x) { return __builtin_amdgcn_exp2f(x); }
DI float sigmoidf_(float v) { return fast_rcp(1.f + fast_exp2(-v * LOG2E)); }
DI float xor_reduce_g(float v) { v += __shfl_xor(v, 16); v += __shfl_xor(v, 32); return v; }
DI float wave_sum(float v) {
#pragma unroll
    for (int o = 1; o < 64; o <<= 1) v += __shfl_xor(v, o);
    return v;
}
DI int perm32(int s) { const int lo = s & 31; return (s & ~31) | (((lo >> 2) & 3) << 3) | ((lo >> 4) << 2) | (lo & 3); }
DI const float* xrow_ptr(const Params& p, int t) { return t < T_PROMPT ? p.in[0] + (size_t)t * D : p.in[1] + (size_t)(t - T_PROMPT) * D; }

DI void tile_map(int L, int nN, int ntiles, int& pm, int& pn) {
    const int xcd = L & 7, q = L >> 3;
    const int Lp = xcd * (ntiles >> 3) + q;
    const int grp = Lp / (8 * nN), rem = Lp % (8 * nN);
    pm = grp * 8 + (rem & 7); pn = rem >> 3;
}

#define LAS __attribute__((address_space(3)))
#define GAS __attribute__((address_space(1)))
template <int BM, int BN, int NWM, int NWN>
DI void gemm_mainloop_p(f32x4 (&acc)[BM / NWM / 16][BN / NWN / 16], const bf16_t* const (&Ar)[BM / 32],
                        const bf16_t* __restrict__ B, int ldb, int K, char* lds) {
    constexpr int MT = BM / NWM / 16, NT = BN / NWN / 16, NA = BM / 32, NB = BN / 32, STAGE = (BM + BN) * 128;
    const int tid = threadIdx.x, lane = tid & 63, wave = tid >> 6;
    const int wm = wave / NWN, wn = wave % NWN;
    const int r = lane & 15, g = lane >> 4;
    const int lr = tid >> 3, lc = tid & 7;
    const int csrc = (lc ^ ((lr >> 1) & 7)) * 8;
    const bf16_t* Bp = B + (size_t)lr * ldb + csrc;
    const int nk = K >> 6;
    auto issue = [&](int kt, int st) {
        char* d = lds + st * STAGE + tid * 16;
#pragma unroll
        for (int i = 0; i < NA; ++i)
            __builtin_amdgcn_global_load_lds((const GAS unsigned*)(Ar[i] + kt * 64), (LAS unsigned*)(d + i * 4096), 16, 0, 0);
#pragma unroll
        for (int i = 0; i < NB; ++i)
            __builtin_amdgcn_global_load_lds((const GAS unsigned*)(Bp + (size_t)(32 * i) * ldb + kt * 64), (LAS unsigned*)(d + BM * 128 + i * 4096), 16, 0, 0);
    };
    issue(0, 0);
    __syncthreads();
    const int rsw = (r >> 1) & 7;
    for (int kt = 0; kt < nk; ++kt) {
        const int cur = kt & 1;
        if (kt + 1 < nk) issue(kt + 1, cur ^ 1);
        const char* sA = lds + cur * STAGE;
        const char* sB = sA + BM * 128;
#pragma unroll
        for (int ks = 0; ks < 2; ++ks) {
            bf16x8 wf[NT], xf[MT];
            const int co = ((ks * 4 + g) ^ rsw) * 16;
#pragma unroll
            for (int nt = 0; nt < NT; ++nt) wf[nt] = *(const bf16x8*)(sB + (wn * (NT * 16) + nt * 16 + r) * 128 + co);
#pragma unroll
            for (int mt = 0; mt < MT; ++mt) xf[mt] = *(const bf16x8*)(sA + (wm * (MT * 16) + mt * 16 + r) * 128 + co);
#pragma unroll
            for (int mt = 0; mt < MT; ++mt)
#pragma unroll
                for (int nt = 0; nt < NT; ++nt) acc[mt][nt] = __builtin_amdgcn_mfma_f32_16x16x32_bf16(wf[nt], xf[mt], acc[mt][nt], 0, 0, 0);
        }
        __syncthreads();
    }
}

template <int BM, int BN, int NWM, int NWN>
DI void gemm_mainloop(f32x4 (&acc)[BM / NWM / 16][BN / NWN / 16], const bf16_t* __restrict__ A, int lda,
                      const bf16_t* __restrict__ B, int ldb, int K, char* lds) {
    const int tid = threadIdx.x, lr = tid >> 3, lc = tid & 7;
    const bf16_t* Ar[BM / 32];
#pragma unroll
    for (int i = 0; i < BM / 32; ++i) Ar[i] = A + (size_t)(lr + 32 * i) * lda + (lc ^ ((lr >> 1) & 7)) * 8;
    gemm_mainloop_p<BM, BN, NWM, NWN>(acc, Ar, B, ldb, K, lds);
}

template <int MT, int NT>
DI void zero_acc(f32x4 (&acc)[MT][NT]) {
#pragma unroll
    for (int i = 0; i < MT; ++i)
#pragma unroll
        for (int j = 0; j < NT; ++j) acc[i][j] = (f32x4){0.f, 0.f, 0.f, 0.f};
}

DI void transpose_item(const float* __restrict__ W, int K, int N, bf16_t* __restrict__ WT, int mode, const float* __restrict__ scale,
                       float* scr, int item, int lane) {
    const int nblk = N >> 5, kb = item / nblk, nb = item % nblk, k0 = kb * 64, n0 = nb * 32;
#pragma unroll 8
    for (int i = 0; i < 32; ++i) {
        const int kk = 2 * i + (lane >> 5);
        float v = W[(size_t)(k0 + kk) * N + n0 + (lane & 31)];
        if (scale) v *= scale[k0 + kk];
        scr[kk * 33 + (lane & 31)] = v;
    }
    asm volatile("s_waitcnt lgkmcnt(0)" ::: "memory");
    const int c = lane & 7;
#pragma unroll
    for (int j = 0; j < 4; ++j) {
        const int nl = (lane >> 3) + 8 * j;
        const float* s = scr + (8 * c) * 33 + nl;
        u32x4 o;
        o.x = pk2(s[0 * 33], s[1 * 33]); o.y = pk2(s[2 * 33], s[3 * 33]); o.z = pk2(s[4 * 33], s[5 * 33]); o.w = pk2(s[6 * 33], s[7 * 33]);
        const int n = n0 + nl;
        int row;
        if (mode == 1) row = n < 1184 ? n : n + 96;
        else if (mode == 2) { const int h = n >> 7, jj = n & 127; row = jj < 64 ? h * 64 + jj : 512 + h * 64 + (jj - 64); }
        else if (mode == 3) { const int hf = n >= DFF ? 1 : 0, m2 = n - hf * DFF; row = (m2 >> 6) * 128 + hf * 64 + (m2 & 63); }
        else row = n;
        *(u32x4*)(WT + (size_t)row * K + k0 + 8 * c) = o;
    }
    asm volatile("s_waitcnt lgkmcnt(0)" ::: "memory");
}

DI void phase0(const Params& p, char* lds) {
    const int tid = threadIdx.x, bid = blockIdx.x, G = gridDim.x, lane = tid & 63, wave = tid >> 6;
    unsigned char* ws = p.ws;
    float* sc = (float*)lds;
    for (int it = bid; it < 384; it += G) {
        const int cb = it % 24, ks = it / 24;
        __syncthreads();
        for (int i = tid; i < 24 * 64; i += 256) {
            const int b = i >> 6, k = i & 63;
            const float* c = b < 8 ? p.in[2] + b * 1024 : p.in[3] + (b - 8) * 1024;
            const float v = c[ks * 64 + k];
            sc[i] = v * sigmoidf_(v);
        }
        __syncthreads();
        float a[24];
#pragma unroll
        for (int b = 0; b < 24; ++b) a[b] = 0.f;
        const int n = cb * 256 + tid;
        const float* w = p.in[4] + (size_t)(ks * 64) * 6144 + n;
        for (int k = 0; k < 64; ++k) {
            const float wv = w[(size_t)k * 6144];
#pragma unroll
            for (int b = 0; b < 24; ++b) a[b] += sc[b * 64 + k] * wv;
        }
        float* mp = (float*)(ws + O_MODP) + (size_t)(ks * 24) * 6144 + n;
#pragma unroll
        for (int b = 0; b < 24; ++b) mp[(size_t)b * 6144] = a[b];
    }
    __syncthreads();
    {
        float* scr = (float*)(lds + wave * 8448);
        const int gw = bid * 4 + wave, NGW = G * 4;
        constexpr int I0 = 16 * 101, I1 = 4 * 24, I2 = 2 * 32, I3 = 8 * 32, I4 = 8 * 32, I5 = 16 * 32, I6 = 16 * 176, I7 = 44 * 32;
        constexpr int NI = I0 + I1 + I2 + I3 + I4 + I5 + I6 + I7;
        for (int it = gw; it < NI; it += NGW) {
            int q = it;
            if (q < I0) { transpose_item(p.in[7], 1024, IN_TOTAL, (bf16_t*)(ws + O_WIN), 1, nullptr, scr, q, lane); continue; } q -= I0;
            if (q < I1) { transpose_item(p.in[12], 256, 768, (bf16_t*)(ws + O_WUQ), 0, p.in[11], scr, q, lane); continue; } q -= I1;
            if (q < I2) { transpose_item(p.in[14], 128, 1024, (bf16_t*)(ws + O_WUKV), 2, p.in[13], scr, q, lane); continue; } q -= I2;
            if (q < I3) { transpose_item(p.in[17], 512, 1024, (bf16_t*)(ws + O_WOA), 0, nullptr, scr, q, lane); continue; } q -= I3;
            if (q < I4) { transpose_item(p.in[18], 512, 1024, (bf16_t*)(ws + O_WOB), 0, nullptr, scr, q, lane); continue; } q -= I4;
            if (q < I5) { transpose_item(p.in[19], 1024, 1024, (bf16_t*)(ws + O_WOUT), 0, nullptr, scr, q, lane); continue; } q -= I5;
            if (q < I6) { transpose_item(p.in[21], 1024, NUP, (bf16_t*)(ws + O_WUP), 3, nullptr, scr, q, lane); continue; } q -= I6;
            transpose_item(p.in[24], DFF, 1024, (bf16_t*)(ws + O_WDN), 0, nullptr, scr, q, lane);
        }
    }
    const int gt = bid * 256 + tid, NGT = G * 256;
    for (int i = gt; i < 4096 * 48; i += NGT) {
        const int pos = i / 48, j = i % 48;
        float inv;
        if (j < 32) inv = exp2f(-(float)(2 * j) * (1.f / 64.f) * 13.287712379549449f);
        else inv = exp2f(-(float)(2 * (j - 32)) * (1.f / 32.f) * 13.287712379549449f);
        const float ang = (float)pos * inv;
        float rev = ang * 0.15915494309189535f;
        rev -= floorf(rev);
        const float sn = __builtin_amdgcn_sinf(rev), cs = __builtin_amdgcn_cosf(rev);
        float2* dst = j < 32 ? (float2*)(ws + O_ROPEA) + pos * 32 + j : (float2*)(ws + O_ROPEB) + pos * 16 + (j - 32);
        *dst = make_float2(cs, sn);
    }
    for (int i = gt; i < 96 * 1024 / 8; i += NGT) *(u32x4*)((bf16_t*)(ws + O_WIN) + 1184 * 1024 + (size_t)i * 8) = (u32x4){0u, 0u, 0u, 0u};
    if (gt < 256) *(u32x4*)(ws + O_ZROW + gt * 16) = (u32x4){0u, 0u, 0u, 0u};
}

DI void phase0m(const Params& p) {
    const int gt = blockIdx.x * 256 + threadIdx.x, NGT = gridDim.x * 256;
    const float* mp = (const float*)(p.ws + O_MODP);
    float* mod = (float*)(p.ws + O_MOD);
    for (int i = gt; i < 24 * 6144; i += NGT) {
        float s = p.in[5][i % 6144];
#pragma unroll
        for (int ks = 0; ks < 16; ++ks) s += mp[(size_t)ks * 24 * 6144 + i];
        mod[i] = s;
    }
}

DI void norm_pass(const Params& p, bool second, bf16_t* dst) {
    const int lane = threadIdx.x & 63, gw = blockIdx.x * 4 + (threadIdx.x >> 6), NGW = gridDim.x * 4;
    const float* gwt = second ? p.in[20] : p.in[6];
    const float* mod = (const float*)(p.ws + O_MOD);
    f32x4 gv[4];
#pragma unroll
    for (int j = 0; j < 4; ++j) gv[j] = *((const f32x4*)gwt + 64 * j + lane);
    for (int t = gw; t < T; t += NGW) {
        const float* xr = second ? p.out + (size_t)t * D : xrow_ptr(p, t);
        const int b = t >> 12;
        const float* sh = mod + (size_t)b * 6144 + (second ? 3072 : 0);
        const float* sc = sh + 1024;
        f32x4 v[4]; float s = 0.f;
#pragma unroll
        for (int j = 0; j < 4; ++j) { v[j] = *((const f32x4*)xr + 64 * j + lane); s += (v[j].x * v[j].x + v[j].y * v[j].y) + (v[j].z * v[j].z + v[j].w * v[j].w); }
        const float rstd = rsqrtf(wave_sum(s) * (1.f / D) + EPS);
        u32x2* o = (u32x2*)(dst + (size_t)t * D) + lane;
#pragma unroll
        for (int j = 0; j < 4; ++j) {
            const f32x4 scv = *((const f32x4*)sc + 64 * j + lane), shv = *((const f32x4*)sh + 64 * j + lane);
            f32x4 y;
            y.x = v[j].x * rstd * gv[j].x * (1.f + scv.x) + shv.x; y.y = v[j].y * rstd * gv[j].y * (1.f + scv.y) + shv.y;
            y.z = v[j].z * rstd * gv[j].z * (1.f + scv.z) + shv.z; y.w = v[j].w * rstd * gv[j].w * (1.f + scv.w) + shv.w;
            o[64 * j] = (u32x2){pk2(y.x, y.y), pk2(y.z, y.w)};
        }
    }
}

DI void phase1(const Params& p, char* lds) {
    const bf16_t* H = (const bf16_t*)(p.ws + O_H);
    const bf16_t* W = (const bf16_t*)(p.ws + O_WIN);
    bf16_t* ZS = (bf16_t*)(p.ws + O_ZS);
    bf16_t* Gt = (bf16_t*)((unsigned char*)p.out + OO_G);
    constexpr int nM = T / 128, nN = NIN / 128, NTILES = nM * nN;
    const int lane = threadIdx.x & 63, wave = threadIdx.x >> 6, wm = wave >> 1, wn = wave & 1, r = lane & 15, g = lane >> 4;
    for (int L = blockIdx.x; L < NTILES; L += gridDim.x) {
        int pm, pn; tile_map(L, nN, NTILES, pm, pn);
        f32x4 acc[4][4]; zero_acc(acc);
        gemm_mainloop<128, 128, 2, 2>(acc, H + (size_t)pm * 128 * 1024, 1024, W + (size_t)pn * 128 * 1024, 1024, 1024, lds);
        const int col0 = pn * 128 + wn * 64 + g * 4;
#pragma unroll
        for (int mt = 0; mt < 4; ++mt) {
            const int m = pm * 128 + wm * 64 + mt * 16 + r;
#pragma unroll
            for (int nt = 0; nt < 4; ++nt) {
                const int n = col0 + nt * 16;
                const f32x4 a = acc[mt][nt];
                if (pn < NZ / 128) *(u32x2*)(ZS + (size_t)m * NZ + n) = (u32x2){pk2(a.x, a.y), pk2(a.z, a.w)};
                else *(u32x2*)(Gt + (size_t)m * 2048 + (n - NZ)) = (u32x2){pk2(sigmoidf_(a.x), sigmoidf_(a.y)), pk2(sigmoidf_(a.z), sigmoidf_(a.w))};
            }
        }
    }
}

template <int NCH>
DI float row_sumsq(const bf16_t* rowp, int g) {
    float s = 0.f;
#pragma unroll
    for (int c = 0; c < NCH; ++c) {
        const u32x4 v = *(const u32x4*)(rowp + (g * NCH + c) * 8);
#pragma unroll
        for (int e = 0; e < 4; ++e) { const float a = bflo(v[e]), b = bfhi(v[e]); s += a * a + b * b; }
    }
    return xor_reduce_g(s);
}

DI void phase2(const Params& p, char* lds) {
    unsigned char* ws = p.ws;
    const bf16_t* ZS = (const bf16_t*)(ws + O_ZS);
    const int tid = threadIdx.x, lane = tid & 63, wave = tid >> 6, r = lane & 15, g = lane >> 4;
    const float2* ropeA = (const float2*)(ws + O_ROPEA);
    const float2* ropeB = (const float2*)(ws + O_ROPEB);
    constexpr int NTL = T / 128;
    for (int it = blockIdx.x; it < NTL * 8; it += gridDim.x) {
        const int tile = it >> 3, sub = it & 7, t0 = tile * 128, b = t0 >> 12, s0 = t0 & (S - 1);
        {
            const int h = sub;
            f32x4 acc[2][6]; zero_acc(acc);
            gemm_mainloop<128, 96, 4, 1>(acc, ZS + (size_t)t0 * NZ + 768, NZ, (const bf16_t*)(ws + O_WUQ) + (size_t)h * 96 * 256, 256, 256, lds);
            const float* gq = p.in[15];
            const float qs = 0.10206207261596577f * LOG2E;
            bf16_t* QB = (bf16_t*)(ws + O_QB) + ((size_t)(b * 8 + h) * S) * 96;
#pragma unroll
            for (int mt = 0; mt < 2; ++mt) {
                const int ml = wave * 32 + mt * 16 + r, sp = s0 + ml;
                const float rstd = rsqrtf(row_sumsq<8>(ZS + (size_t)(t0 + ml) * NZ + 768, g) * (1.f / 256.f) + EPS);
                float ss = 0.f;
#pragma unroll
                for (int nt = 0; nt < 6; ++nt) { acc[mt][nt] = acc[mt][nt] * rstd; const f32x4 a = acc[mt][nt]; ss += (a.x * a.x + a.y * a.y) + (a.z * a.z + a.w * a.w); }
                const float r2 = rsqrtf(xor_reduce_g(ss) * (1.f / 96.f) + EPS);
#pragma unroll
                for (int nt = 0; nt < 6; ++nt) {
                    const f32x4 gg = *(const f32x4*)(gq + nt * 16 + g * 4);
                    acc[mt][nt] = acc[mt][nt] * r2 * gg;
                }
#pragma unroll
                for (int j = 0; j < 4; ++j) {
                    const float2 cs = ropeB[sp * 16 + g * 4 + j];
                    const float x1 = acc[mt][4][j], x2 = acc[mt][5][j];
                    acc[mt][4][j] = x1 * cs.x - x2 * cs.y;
                    acc[mt][5][j] = x1 * cs.y + x2 * cs.x;
                }
                bf16_t* qrow = QB + (size_t)sp * 96 + g * 4;
#pragma unroll
                for (int nt = 0; nt < 6; ++nt) { const f32x4 a = acc[mt][nt] * qs; *(u32x2*)(qrow + nt * 16) = (u32x2){pk2(a.x, a.y), pk2(a.z, a.w)}; }
                __builtin_amdgcn_sched_barrier(0);
            }
        }
    }
    for (int it = blockIdx.x; it < NTL * 4; it += gridDim.x) {
        const int tile = it >> 2, hp = it & 3, t0 = tile * 128, b = t0 >> 12, s0 = t0 & (S - 1);
        {
            f32x4 acc[4][4]; zero_acc(acc);
            gemm_mainloop<128, 128, 2, 2>(acc, ZS + (size_t)t0 * NZ + 1024, NZ,
                                          (const bf16_t*)(ws + O_WUKV) + (size_t)(hp * 128) * 128, 128, 128, lds);
            const int wm = wave >> 1, wn = wave & 1, h = hp * 2 + wn;
            {
                const float* gk = p.in[16];
                bf16_t* KB = (bf16_t*)(ws + O_KB) + ((size_t)(b * 8 + h) * S) * 96;
#pragma unroll
                for (int mt = 0; mt < 4; ++mt) {
                    const int ml = wm * 64 + mt * 16 + r, sp = s0 + ml;
                    const bf16_t* zrow = ZS + (size_t)(t0 + ml) * NZ;
                    const float rstd = rsqrtf(row_sumsq<4>(zrow + 1024, g) * (1.f / 128.f) + EPS);
                    const u32x2 k1 = *(const u32x2*)(zrow + 1152 + g * 4), k2 = *(const u32x2*)(zrow + 1168 + g * 4);
                    float x1[4] = {bflo(k1.x), bfhi(k1.x), bflo(k1.y), bfhi(k1.y)};
                    float x2[4] = {bflo(k2.x), bfhi(k2.x), bflo(k2.y), bfhi(k2.y)};
                    float ss = 0.f;
#pragma unroll
                    for (int j = 0; j < 4; ++j) ss += x1[j] * x1[j] + x2[j] * x2[j];
#pragma unroll
                    for (int nt = 0; nt < 4; ++nt) { acc[mt][nt] = acc[mt][nt] * rstd; const f32x4 a = acc[mt][nt]; ss += (a.x * a.x + a.y * a.y) + (a.z * a.z + a.w * a.w); }
                    const float r2 = rsqrtf(xor_reduce_g(ss) * (1.f / 96.f) + EPS);
                    bf16_t* krow = KB + (size_t)sp * 96 + g * 4;
#pragma unroll
                    for (int nt = 0; nt < 4; ++nt) {
                        const f32x4 gg = *(const f32x4*)(gk + nt * 16 + g * 4);
                        const f32x4 a = acc[mt][nt] * r2 * gg;
                        *(u32x2*)(krow + nt * 16) = (u32x2){pk2(a.x, a.y), pk2(a.z, a.w)};
                    }
                    const f32x4 g1 = *(const f32x4*)(gk + 64 + g * 4), g2 = *(const f32x4*)(gk + 80 + g * 4);
                    float o1[4], o2[4];
#pragma unroll
                    for (int j = 0; j < 4; ++j) {
                        const float2 cs = ropeB[sp * 16 + g * 4 + j];
                        const float y1 = x1[j] * r2 * g1[j], y2 = x2[j] * r2 * g2[j];
                        o1[j] = y1 * cs.x - y2 * cs.y; o2[j] = y1 * cs.y + y2 * cs.x;
                    }
                    *(u32x2*)(krow + 64) = (u32x2){pk2(o1[0], o1[1]), pk2(o1[2], o1[3])};
                    *(u32x2*)(krow + 80) = (u32x2){pk2(o2[0], o2[1]), pk2(o2[2], o2[3])};
                    __builtin_amdgcn_sched_barrier(0);
                }
            }
        }
    }
    for (int it = blockIdx.x; it < NTL * 4; it += gridDim.x) {
        const int tile = it >> 2, hp = it & 3, t0 = tile * 128, b = t0 >> 12, s0 = t0 & (S - 1);
        {
            f32x4 acc[4][4]; zero_acc(acc);
            gemm_mainloop<128, 128, 2, 2>(acc, ZS + (size_t)t0 * NZ + 1024, NZ,
                                          (const bf16_t*)(ws + O_WUKV) + (size_t)(512 + hp * 128) * 128, 128, 128, lds);
            const int wm = wave >> 1, wn = wave & 1, h = hp * 2 + wn;
            {
                bf16_t* VT = (bf16_t*)(ws + O_VTB) + ((size_t)(b * 8 + h) * 64) * S;
#pragma unroll
                for (int mt = 0; mt < 4; ++mt) {
                    const int ml = wm * 64 + mt * 16 + r, sp = s0 + ml;
                    const float rstd = rsqrtf(row_sumsq<4>(ZS + (size_t)(t0 + ml) * NZ + 1024, g) * (1.f / 128.f) + EPS);
                    const int ps = perm32(sp);
#pragma unroll
                    for (int nt = 0; nt < 4; ++nt)
#pragma unroll
                        for (int j = 0; j < 4; ++j) VT[(size_t)(nt * 16 + g * 4 + j) * S + ps] = f2bf(acc[mt][nt][j] * rstd);
                    __builtin_amdgcn_sched_barrier(0);
                }
            }
        }
    }
    __syncthreads();
    for (int tile = blockIdx.x; tile < NTL; tile += gridDim.x) {
        const int t0 = tile * 128, b = t0 >> 12, s0 = t0 & (S - 1);
        {
            const float* gqa = p.in[8];
            const float* gka = p.in[9];
            const int half = lane >> 5, i = lane & 31;
            const float qs = 0.125f * LOG2E;
            const float gq1 = gqa[i], gq2 = gqa[32 + i], gk1 = gka[i], gk2 = gka[32 + i];
            for (int tt0 = wave * 4; tt0 < 128; tt0 += 16) {
                float x1[4][5], x2[4][5]; float2 cs[4];
#pragma unroll
                for (int u = 0; u < 4; ++u) {
                    const bf16_t* zrow = ZS + (size_t)(t0 + tt0 + u) * NZ;
                    cs[u] = ropeA[(s0 + tt0 + u) * 32 + i];
#pragma unroll
                    for (int q = 0; q < 5; ++q) { const int hd = 2 * q + half; x1[u][q] = bf2f(zrow[hd * 64 + i]); x2[u][q] = bf2f(zrow[hd * 64 + 32 + i]); }
                }
#pragma unroll
                for (int u = 0; u < 4; ++u) {
                    const int sp = s0 + tt0 + u;
#pragma unroll
                    for (int q = 0; q < 5; ++q) {
                        const int hd = 2 * q + half;
                        float ss = x1[u][q] * x1[u][q] + x2[u][q] * x2[u][q];
#pragma unroll
                        for (int o = 1; o < 32; o <<= 1) ss += __shfl_xor(ss, o);
                        const float rr = rsqrtf(ss * (1.f / 64.f) + EPS);
                        const bool isq = q < 4;
                        const float y1 = x1[u][q] * rr * (isq ? gq1 : gk1), y2 = x2[u][q] * rr * (isq ? gq2 : gk2);
                        float o1 = y1 * cs[u].x - y2 * cs[u].y, o2 = y1 * cs[u].y + y2 * cs[u].x;
                        bf16_t* dst;
                        if (isq) { o1 *= qs; o2 *= qs; dst = (bf16_t*)(ws + O_QA) + ((size_t)(b * 8 + hd) * S + sp) * 64; }
                        else dst = (bf16_t*)(ws + O_KA) + ((size_t)(b * 2 + (hd - 8)) * S + sp) * 64;
                        dst[i] = f2bf(o1); dst[32 + i] = f2bf(o2);
                    }
                }
            }
            __syncthreads();
            bf16_t* tl = (bf16_t*)lds;
            for (int idx = tid; idx < 128 * 16; idx += 256) {
                const int tt = idx >> 4, c = idx & 15;
                const u32x4 v = *(const u32x4*)(ZS + (size_t)(t0 + tt) * NZ + 640 + c * 8);
                u32x2* d2 = (u32x2*)(tl + tt * 132 + c * 8);
                d2[0] = (u32x2){v.x, v.y}; d2[1] = (u32x2){v.z, v.w};
            }
            __syncthreads();
            bf16_t* VT = (bf16_t*)(ws + O_VTA) + ((size_t)(b * 2) * 64) * S;
            for (int idx = tid; idx < 128 * 128; idx += 256) {
                const int pp = idx & 127, dd = idx >> 7;
                const int lo = pp & 31;
                const int tt = (pp & ~31) | (((lo >> 2) & 1) << 4) | ((lo >> 3) << 2) | (lo & 3);
                VT[(size_t)dd * S + s0 + pp] = tl[tt * 132 + dd];
            }
            __syncthreads();
        }
    }
}

template <int DQK, bool WIN>
DI void attn_item(const bf16_t* __restrict__ Qw, const bf16_t* __restrict__ Kb, const bf16_t* __restrict__ Vt, int key0, int ntiles, int q0,
                  float shift2, float sink_term, bf16_t* __restrict__ Ow, int ldo, char* lds) {
    constexpr int KS = DQK / 32, CH = DQK / 8, KSTR = DQK * 2 + 32, NKL = CH * 64 / 256, VSTR = 160, STAGE = 64 * 224 + 64 * VSTR;
    const int tid = threadIdx.x, lane = tid & 63, r = lane & 15, g = lane >> 4;
    bf16x8 qf[2][KS];
#pragma unroll
    for (int qt = 0; qt < 2; ++qt)
#pragma unroll
        for (int ks = 0; ks < KS; ++ks) qf[qt][ks] = *(const bf16x8*)(Qw + (size_t)(qt * 16 + r) * DQK + ks * 32 + g * 8);
    f32x4 oacc[4][2];
#pragma unroll
    for (int i = 0; i < 4; ++i) { oacc[i][0] = (f32x4){0.f, 0.f, 0.f, 0.f}; oacc[i][1] = (f32x4){0.f, 0.f, 0.f, 0.f}; }
    float lsum[2] = {0.f, 0.f};
    u32x4 rk[NKL], rv[2];
    int krow[NKL], kc[NKL];
#pragma unroll
    for (int i = 0; i < NKL; ++i) { const int idx = tid + 256 * i; krow[i] = idx / CH; kc[i] = idx % CH; }
    const int vrow = tid >> 3, vc = tid & 7;
    auto gload = [&](int tile) {
        const int kb = key0 + tile * 64;
#pragma unroll
        for (int i = 0; i < NKL; ++i) rk[i] = *(const u32x4*)(Kb + (size_t)(kb + krow[i]) * DQK + kc[i] * 8);
#pragma unroll
        for (int i = 0; i < 2; ++i) rv[i] = *(const u32x4*)(Vt + (size_t)(vrow + 32 * i) * S + kb + vc * 8);
    };
    auto lstore = [&](int st) {
        char* sK = lds + st * STAGE; char* sV = sK + 64 * 224;
#pragma unroll
        for (int i = 0; i < NKL; ++i) *(u32x4*)(sK + krow[i] * KSTR + kc[i] * 16) = rk[i];
#pragma unroll
        for (int i = 0; i < 2; ++i) *(u32x4*)(sV + (vrow + 32 * i) * VSTR + vc * 16) = rv[i];
    };
    __syncthreads();
    gload(0); lstore(0);
    __syncthreads();
    for (int tile = 0; tile < ntiles; ++tile) {
        const int cur = tile & 1;
        const bool more = tile + 1 < ntiles;
        if (more) gload(tile + 1);
        const char* sK = lds + cur * STAGE; const char* sV = sK + 64 * 224;
        f32x4 sacc[4][2];
#pragma unroll
        for (int kt = 0; kt < 4; ++kt) {
            sacc[kt][0] = (f32x4){0.f, 0.f, 0.f, 0.f}; sacc[kt][1] = (f32x4){0.f, 0.f, 0.f, 0.f};
#pragma unroll
            for (int ks = 0; ks < KS; ++ks) {
                const bf16x8 kf = *(const bf16x8*)(sK + (kt * 16 + r) * KSTR + (ks * 4 + g) * 16);
                sacc[kt][0] = __builtin_amdgcn_mfma_f32_16x16x32_bf16(kf, qf[0][ks], sacc[kt][0], 0, 0, 0);
                sacc[kt][1] = __builtin_amdgcn_mfma_f32_16x16x32_bf16(kf, qf[1][ks], sacc[kt][1], 0, 0, 0);
            }
        }
        const int kbase = key0 + tile * 64 + g * 4;
#pragma unroll
        for (int kt = 0; kt < 4; ++kt)
#pragma unroll
            for (int qt = 0; qt < 2; ++qt)
#pragma unroll
                for (int j = 0; j < 4; ++j) {
                    float pv = fast_exp2(sacc[kt][qt][j] - shift2);
                    if (WIN) { const int dlt = (kbase + kt * 16 + j) - (q0 + qt * 16 + r); if (dlt > 128 || dlt < -128) pv = 0.f; }
                    sacc[kt][qt][j] = pv; lsum[qt] += pv;
                }
#pragma unroll
        for (int kk = 0; kk < 2; ++kk) {
            bf16x8 pb[2];
#pragma unroll
            for (int qt = 0; qt < 2; ++qt) {
                u32x4 u;
                u.x = pk2(sacc[2 * kk][qt][0], sacc[2 * kk][qt][1]); u.y = pk2(sacc[2 * kk][qt][2], sacc[2 * kk][qt][3]);
                u.z = pk2(sacc[2 * kk + 1][qt][0], sacc[2 * kk + 1][qt][1]); u.w = pk2(sacc[2 * kk + 1][qt][2], sacc[2 * kk + 1][qt][3]);
                pb[qt] = __builtin_bit_cast(bf16x8, u);
            }
#pragma unroll
            for (int dt = 0; dt < 4; ++dt) {
                const bf16x8 vf = *(const bf16x8*)(sV + (dt * 16 + r) * VSTR + (kk * 4 + g) * 16);
                oacc[dt][0] = __builtin_amdgcn_mfma_f32_16x16x32_bf16(vf, pb[0], oacc[dt][0], 0, 0, 0);
                oacc[dt][1] = __builtin_amdgcn_mfma_f32_16x16x32_bf16(vf, pb[1], oacc[dt][1], 0, 0, 0);
            }
        }
        if (more) lstore(cur ^ 1);
        __syncthreads();
    }
#pragma unroll
    for (int qt = 0; qt < 2; ++qt) {
        const float inv = fast_rcp(xor_reduce_g(lsum[qt]) + sink_term);
        bf16_t* orow = Ow + (size_t)(qt * 16 + r) * ldo + g * 4;
#pragma unroll
        for (int dt = 0; dt < 4; ++dt) { const f32x4 a = oacc[dt][qt] * inv; *(u32x2*)(orow + dt * 16) = (u32x2){pk2(a.x, a.y), pk2(a.z, a.w)}; }
    }
}

DI float max_abs(const float* v, int n) { float m = 0.f; for (int i = 0; i < n; ++i) m = fmaxf(m, fabsf(v[i])); return m; }

DI void phase3(const Params& p, char* lds) {
    unsigned char* ws = p.ws;
    const int wave = threadIdx.x >> 6;
    const float shiftB = 9.797958971132712f * max_abs(p.in[15], 96) * max_abs(p.in[16], 96) * LOG2E;
    const float shiftA = 8.f * max_abs(p.in[8], 64) * max_abs(p.in[9], 64) * LOG2E;
    bf16_t* OA = (bf16_t*)(p.ws + O_OA);
    bf16_t* OB = (bf16_t*)(p.ws + O_OB);
    constexpr int NB_ITEMS = 24 * 8 * 32, NA_ITEMS = 24 * 2 * 128;
    for (int L = blockIdx.x; L < NB_ITEMS; L += gridDim.x) {
        const int idx = (L & 7) * (NB_ITEMS / 8) + (L >> 3);
        const int bh = idx >> 5, qb = idx & 31, b = bh >> 3, h = bh & 7;
        const int q0 = qb * 128 + wave * 32;
        attn_item<96, false>((const bf16_t*)(ws + O_QB) + ((size_t)bh * S + q0) * 96, (const bf16_t*)(ws + O_KB) + (size_t)bh * S * 96,
                             (const bf16_t*)(ws + O_VTB) + (size_t)bh * 64 * S, 0, S / 64, q0, shiftB, 0.f,
                             OB + ((size_t)b * S + q0) * 512 + h * 64, 512, lds);
    }
    for (int L = blockIdx.x; L < NA_ITEMS; L += gridDim.x) {
        const int idx = (L & 7) * (NA_ITEMS / 8) + (L >> 3);
        const int bk = idx >> 7, qb = idx & 127, b = bk >> 1, kvh = bk & 1;
        const int q0 = qb * 32, hd = kvh * 4 + wave;
        int ks = (q0 - 128) & ~63; if (ks < 0) ks = 0;
        int ke = (q0 + 32 + 128 + 63) & ~63; if (ke > S) ke = S;
        const float sink_term = fast_exp2(p.in[10][hd] * LOG2E - shiftA);
        attn_item<64, true>((const bf16_t*)(ws + O_QA) + ((size_t)(b * 8 + hd) * S + q0) * 64, (const bf16_t*)(ws + O_KA) + (size_t)bk * S * 64,
                            (const bf16_t*)(ws + O_VTA) + (size_t)bk * 64 * S, ks, (ke - ks) >> 6, q0, shiftA, sink_term,
                            OA + ((size_t)b * S + q0) * 512 + hd * 64, 512, lds);
    }
}

DI void phase4(const Params& p, char* lds) {
    const bf16_t* OA = (const bf16_t*)(p.ws + O_OA);
    const bf16_t* OB = (const bf16_t*)(p.ws + O_OB);
    const bf16_t* Gt = (const bf16_t*)((unsigned char*)p.out + OO_G);
    bf16_t* MIX = (bf16_t*)(p.ws + O_ZS);
    constexpr int nM = T / 128, nN = 8, NTILES = nM * nN;
    const int lane = threadIdx.x & 63, wave = threadIdx.x >> 6, wm = wave >> 1, wn = wave & 1, r = lane & 15, g = lane >> 4;
    for (int L = blockIdx.x; L < NTILES; L += gridDim.x) {
        int pm, pn; tile_map(L, nN, NTILES, pm, pn);
        f32x4 acc[4][4]; u32x2 mixp[4][4]; zero_acc(acc);
        gemm_mainloop<128, 128, 2, 2>(acc, OA + (size_t)pm * 128 * 512, 512, (const bf16_t*)(p.ws + O_WOA) + (size_t)pn * 128 * 512, 512, 512, lds);
        const int col0 = pn * 128 + wn * 64 + g * 4;
#pragma unroll
        for (int mt = 0; mt < 4; ++mt) {
            const int m = pm * 128 + wm * 64 + mt * 16 + r;
#pragma unroll
            for (int nt = 0; nt < 4; ++nt) {
                const u32x2 gv = *(const u32x2*)(Gt + (size_t)m * 2048 + col0 + nt * 16);
                const f32x4 a = acc[mt][nt];
                mixp[mt][nt] = (u32x2){pk2(a.x * bflo(gv.x), a.y * bfhi(gv.x)), pk2(a.z * bflo(gv.y), a.w * bfhi(gv.y))};
            }
        }
        zero_acc(acc);
        gemm_mainloop<128, 128, 2, 2>(acc, OB + (size_t)pm * 128 * 512, 512, (const bf16_t*)(p.ws + O_WOB) + (size_t)pn * 128 * 512, 512, 512, lds);
#pragma unroll
        for (int mt = 0; mt < 4; ++mt) {
            const int m = pm * 128 + wm * 64 + mt * 16 + r;
#pragma unroll
            for (int nt = 0; nt < 4; ++nt) {
                const u32x2 gv = *(const u32x2*)(Gt + (size_t)m * 2048 + 1024 + col0 + nt * 16);
                const f32x4 a = acc[mt][nt]; const u32x2 mx = mixp[mt][nt];
                const float o0 = bflo(mx.x) + a.x * bflo(gv.x), o1 = bfhi(mx.x) + a.y * bfhi(gv.x), o2 = bflo(mx.y) + a.z * bflo(gv.y), o3 = bfhi(mx.y) + a.w * bfhi(gv.y);
                *(u32x2*)(MIX + (size_t)m * 1024 + col0 + nt * 16) = (u32x2){pk2(o0, o1), pk2(o2, o3)};
            }
        }
    }
}

DI void phase5(const Params& p, char* lds) {
    const bf16_t* MIX = (const bf16_t*)(p.ws + O_ZS);
    const float* mod = (const float*)(p.ws + O_MOD);
    constexpr int nM = T / 128, nN = 8, NTILES = nM * nN;
    const int lane = threadIdx.x & 63, wave = threadIdx.x >> 6, wm = wave >> 1, wn = wave & 1, r = lane & 15, g = lane >> 4;
    for (int L = blockIdx.x; L < NTILES; L += gridDim.x) {
        int pm, pn; tile_map(L, nN, NTILES, pm, pn);
        f32x4 acc[4][4]; zero_acc(acc);
        gemm_mainloop<128, 128, 2, 2>(acc, MIX + (size_t)pm * 128 * 1024, 1024, (const bf16_t*)(p.ws + O_WOUT) + (size_t)pn * 128 * 1024, 1024, 1024, lds);
        const int col0 = pn * 128 + wn * 64 + g * 4;
        const int b = (pm * 128) >> 12;
        const float* gt1 = mod + (size_t)b * 6144 + 2048;
#pragma unroll
        for (int mt = 0; mt < 4; ++mt) {
            const int m = pm * 128 + wm * 64 + mt * 16 + r;
            const float* xr = xrow_ptr(p, m);
#pragma unroll
            for (int nt = 0; nt < 4; ++nt) {
                const int n = col0 + nt * 16;
                const f32x4 xv = *(const f32x4*)(xr + n), gv = *(const f32x4*)(gt1 + n);
                *(f32x4*)(p.out + (size_t)m * D + n) = xv + gv * acc[mt][nt];
            }
        }
    }
}

DI void unpack8(const u32x4 v, float (&f)[8]) {
    f[0] = bflo(v.x); f[1] = bfhi(v.x); f[2] = bflo(v.y); f[3] = bfhi(v.y); f[4] = bflo(v.z); f[5] = bfhi(v.z); f[6] = bflo(v.w); f[7] = bfhi(v.w);
}

DI void phase7(const Params& p, char* lds) {
    const bf16_t* H2 = (const bf16_t*)(p.ws + O_H);
    const bf16_t* ZR = (const bf16_t*)(p.ws + O_ZROW);
    bf16_t* ACT = (bf16_t*)(p.ws + O_ACT);
    const float* cw = p.in[22];
    const float* cb = p.in[23];
    constexpr int TPS = 33, nM = NBATCH * TPS, nN = DFF / 64, NTILES = nM * nN, ROWB = 272;
    const int tid = threadIdx.x, lane = tid & 63, wave = tid >> 6, wm = wave >> 1, wn = wave & 1, r = lane & 15, g = lane >> 4;
    const int lr = tid >> 3, lc = tid & 7, csrc = (lc ^ ((lr >> 1) & 7)) * 8;
    for (int L = blockIdx.x; L < NTILES; L += gridDim.x) {
        int pm, pn; tile_map(L, nN, NTILES, pm, pn);
        const int b = pm / TPS, j = pm % TPS, u0 = 126 * j - 1;
        const bf16_t* Ar[4];
#pragma unroll
        for (int i = 0; i < 4; ++i) {
            const int sr = u0 + lr + 32 * i;
            Ar[i] = ((unsigned)sr < (unsigned)S ? H2 + ((size_t)b * S + sr) * 1024 : ZR) + csrc;
        }
        f32x4 acc[4][4]; zero_acc(acc);
        gemm_mainloop_p<128, 128, 2, 2>(acc, Ar, (const bf16_t*)(p.ws + O_WUP) + (size_t)pn * 128 * 1024, 1024, 1024, lds);
#pragma unroll
        for (int mt = 0; mt < 4; ++mt)
#pragma unroll
            for (int nt = 0; nt < 4; ++nt) {
                const f32x4 a = acc[mt][nt];
                *(u32x2*)(lds + (wm * 64 + mt * 16 + r) * ROWB + (wn * 64 + nt * 16 + g * 4) * 2) = (u32x2){pk2(a.x, a.y), pk2(a.z, a.w)};
            }
        __syncthreads();
        {
            const int cc = tid & 7, rr = tid >> 3;
            const int ca = pn * 64 + cc * 8, cg = DFF + ca;
            float wa[3][8], wg[3][8], ba[8], bg[8];
#pragma unroll
            for (int q = 0; q < 2; ++q) {
#pragma unroll
                for (int t = 0; t < 3; ++t) {
                    const f32x4 x = *(const f32x4*)(cw + t * NUP + ca + 4 * q), y = *(const f32x4*)(cw + t * NUP + cg + 4 * q);
#pragma unroll
                    for (int e = 0; e < 4; ++e) { wa[t][4 * q + e] = x[e]; wg[t][4 * q + e] = y[e]; }
                }
                const f32x4 x = *(const f32x4*)(cb + ca + 4 * q), y = *(const f32x4*)(cb + cg + 4 * q);
#pragma unroll
                for (int e = 0; e < 4; ++e) { ba[4 * q + e] = x[e]; bg[4 * q + e] = y[e]; }
            }
#pragma unroll
            for (int q = 0; q < 4; ++q) {
                const int o = rr + 32 * q, so = 126 * j + o;
                if (o < 126 && so < S) {
                    float a0[8], a1[8], a2[8], g0[8], g1[8], g2[8];
                    const char* e0 = lds + o * ROWB + cc * 16;
                    unpack8(*(const u32x4*)(e0), a0); unpack8(*(const u32x4*)(e0 + ROWB), a1); unpack8(*(const u32x4*)(e0 + 2 * ROWB), a2);
                    unpack8(*(const u32x4*)(e0 + 128), g0); unpack8(*(const u32x4*)(e0 + ROWB + 128), g1); unpack8(*(const u32x4*)(e0 + 2 * ROWB + 128), g2);
                    float av[8];
#pragma unroll
                    for (int e = 0; e < 8; ++e) {
                        const float ua = ba[e] + wa[0][e] * a0[e] + wa[1][e] * a1[e] + wa[2][e] * a2[e];
                        const float ug = bg[e] + wg[0][e] * g0[e] + wg[1][e] * g1[e] + wg[2][e] * g2[e];
                        av[e] = ug * sigmoidf_(ug) * ua;
                    }
                    u32x4 ov; ov.x = pk2(av[0], av[1]); ov.y = pk2(av[2], av[3]); ov.z = pk2(av[4], av[5]); ov.w = pk2(av[6], av[7]);
                    *(u32x4*)(ACT + ((size_t)b * S + so) * DFF + ca) = ov;
                }
            }
        }
        __syncthreads();
    }
}

DI void phase8(const Params& p, char* lds) {
    constexpr int chunk = 0;
    const bf16_t* ACT = (const bf16_t*)(p.ws + O_ACT);
    const float* mod = (const float*)(p.ws + O_MOD);
    constexpr int nM = T / 128, nN = 8, NTILES = nM * nN;
    const int lane = threadIdx.x & 63, wave = threadIdx.x >> 6, wm = wave >> 1, wn = wave & 1, r = lane & 15, g = lane >> 4;
    for (int L = blockIdx.x; L < NTILES; L += gridDim.x) {
        int pm, pn; tile_map(L, nN, NTILES, pm, pn);
        f32x4 acc[4][4]; zero_acc(acc);
        gemm_mainloop<128, 128, 2, 2>(acc, ACT + (size_t)pm * 128 * DFF, DFF, (const bf16_t*)(p.ws + O_WDN) + (size_t)pn * 128 * DFF, DFF, DFF, lds);
        const int col0 = pn * 128 + wn * 64 + g * 4;
        const int mg0 = chunk * TCH + pm * 128;
        const int b = mg0 >> 12;
        const float* gt2 = mod + (size_t)b * 6144 + 5120;
#pragma unroll
        for (int mt = 0; mt < 4; ++mt) {
            const int m = mg0 + wm * 64 + mt * 16 + r;
#pragma unroll
            for (int nt = 0; nt < 4; ++nt) {
                const int n = col0 + nt * 16;
                float* op = p.out + (size_t)m * D + n;
                const f32x4 xv = *(const f32x4*)op, gv = *(const f32x4*)(gt2 + n);
                *(f32x4*)op = xv + gv * acc[mt][nt];
            }
        }
    }
}

__global__ void __launch_bounds__(256, 2) fwd_megakernel(Params p) {
    __shared__ __attribute__((aligned(16))) char lds[65536];
    cg::grid_group grid = cg::this_grid();
#if PM & 1
    phase0(p, lds);
#endif
    grid.sync();
    for (int xs = 0; xs < XSYNC; ++xs) grid.sync();
#if PM & 2
    phase0m(p);
#endif
    grid.sync();
#if PM & 4
    norm_pass(p, false, (bf16_t*)(p.ws + O_H));
#endif
    grid.sync();
#if PM & 8
    phase1(p, lds);
#if DUP & 8
    grid.sync();
    phase1(p, lds);
#endif
#endif
    grid.sync();
#if PM & 16
    phase2(p, lds);
#if DUP & 16
    grid.sync();
    phase2(p, lds);
#endif
#endif
    grid.sync();
#if PM & 32
    phase3(p, lds);
#if DUP & 32
    grid.sync();
    phase3(p, lds);
#endif
#endif
    grid.sync();
#if PM & 64
    phase4(p, lds);
#endif
    grid.sync();
#if PM & 128
    phase5(p, lds);
#endif
    grid.sync();
#if PM & 256
    norm_pass(p, true, (bf16_t*)(p.ws + O_H));
#endif
    grid.sync();
#if PM & 512
    phase7(p, lds);
#endif
    grid.sync();
#if PM & 2048
    phase8(p, lds);
#endif
}

extern "C" void kernel_launch(void* const* d_in, const int* in_sizes, int n_in, void* d_out, int out_size, void* d_ws, size_t ws_size,
                              hipStream_t stream) {
    static int grid_blocks = 0;
    if (!grid_blocks) {
        int dev = 0, cus = 0, per_cu = 0;
        hipGetDevice(&dev);
        hipDeviceGetAttribute(&cus, hipDeviceAttributeMultiprocessorCount, dev);
        hipOccupancyMaxActiveBlocksPerMultiprocessor(&per_cu, fwd_megakernel, 256, 0);
        if (per_cu < 1) per_cu = 1;
        if (per_cu > 2) per_cu = 2;
        grid_blocks = cus * per_cu;
        if (n_in != 25 || ws_size < WS_NEED || out_size != T * D)
            fprintf(stderr, "kernel_launch: unexpected sizes n_in=%d ws=%zu out=%d\n", n_in, ws_size, out_size);
    }
    Params p{};
    for (int i = 0; i < 25; ++i) p.in[i] = (const float*)d_in[i];
    p.out = (float*)d_out;
    p.ws = (unsigned char*)d_ws;
    void* args[] = {&p};
    hipError_t e = hipLaunchCooperativeKernel((void*)fwd_megakernel, dim3(grid_blocks), dim3(256), args, 0, stream);
    if (e != hipSuccess) fprintf(stderr, "cooperative launch failed: %s (grid %d)\n", hipGetErrorString(e), grid_blocks);
}
```

```cpp
#include <hip/hip_runtime.h>
#include <hip/hip_cooperative_groups.h>
#include <cstdio>
#include <cstdint>
namespace cg = cooperative_groups;
#ifndef PM
#define PM 4095
#endif
#ifndef DUP
#define DUP 0
#define XSYNC 0
#endif

typedef unsigned short bf16_t;
typedef short bf16x8 __attribute__((ext_vector_type(8)));
typedef float f32x4 __attribute__((ext_vector_type(4)));
typedef unsigned u32x4 __attribute__((ext_vector_type(4)));
typedef unsigned u32x2 __attribute__((ext_vector_type(2)));
#define DI __device__ __forceinline__
#define TID4 ((int)(threadIdx.x & 255))
#define VBID ((int)(blockIdx.x * 2 + (threadIdx.x >> 8)))
#define VGRID ((int)(gridDim.x * 2))

constexpr int D = 1024, S = 4096, NBATCH = 24, T = NBATCH * S;
constexpr int T_PROMPT = 8 * S;
constexpr int IN_TOTAL = 3232, NZ = 1280  , NIN = NZ + 2048;
constexpr int DFF = 2816, NUP = 2 * DFF;
constexpr float EPS = 1e-6f;
constexpr float LOG2E = 1.4426950408889634f;
constexpr int NCHUNK = 4, TCH = T / NCHUNK;

constexpr size_t MiB = 1024ull * 1024ull;
constexpr size_t O_WIN = 0;
constexpr size_t O_WUQ = O_WIN + (size_t)NIN * 1024 * 2;
constexpr size_t O_WUKV = O_WUQ + 768ull * 256 * 2;
constexpr size_t O_WOA = O_WUKV + 1024ull * 128 * 2;
constexpr size_t O_WOB = O_WOA + 1024ull * 512 * 2;
constexpr size_t O_WOUT = O_WOB + 1024ull * 512 * 2;
constexpr size_t O_WUP = O_WOUT + 1024ull * 1024 * 2;
constexpr size_t O_WDN = O_WUP + (size_t)NUP * 1024 * 2;
constexpr size_t O_MODP = O_WDN + 1024ull * DFF * 2;
constexpr size_t O_MOD = O_MODP + 16ull * 24 * 6144 * 4;
constexpr size_t O_ROPEA = O_MOD + 24ull * 6144 * 4;
constexpr size_t O_ROPEB = O_ROPEA + 4096ull * 32 * 8;
constexpr size_t O_ZROW = O_ROPEB + 4096ull * 16 * 8;
constexpr size_t O_WB_END = O_ZROW + 4096;
static_assert(O_WB_END <= 48 * MiB, "weights region");
constexpr size_t O_ZS = 48 * MiB;
constexpr size_t O_QA = 288 * MiB;
constexpr size_t O_KA = O_QA + 96 * MiB;
constexpr size_t O_VTA = O_KA + 24 * MiB;
constexpr size_t O_QB = O_VTA + 24 * MiB;
constexpr size_t O_KB = O_QB + 144 * MiB;
constexpr size_t O_VTB = O_KB + 144 * MiB;
constexpr size_t O_H = 816 * MiB;
constexpr size_t O_UP = 288 * MiB;
constexpr size_t O_ACT = 288 * MiB;
constexpr size_t WS_NEED = 1008 * MiB;
static_assert(O_VTB + 96 * MiB <= O_H, "qkv region");
constexpr size_t OO_G = 0, O_OA = O_H, O_OB = O_H + 96 * MiB;

struct Params {
    const float* in[25];
    float* out;
    unsigned char* ws;
};

typedef __bf16 bf16x2_t __attribute__((ext_vector_type(2)));
typedef float f32x2_t __attribute__((ext_vector_type(2)));
DI unsigned pk2(float lo, float hi) { const f32x2_t v = {lo, hi}; return __builtin_bit_cast(unsigned, __builtin_convertvector(v, bf16x2_t)); }
DI float bflo(unsigned u) { return __uint_as_float(u << 16); }
DI float bfhi(unsigned u) { return __uint_as_float(u & 0xffff0000u); }
DI float bf2f(bf16_t v) { return __uint_as_float(((unsigned)v) << 16); }
DI bf16_t f2bf(float v) { return (bf16_t)(pk2(v, v) & 0xffffu); }
DI float fast_rcp(float x) { return __builtin_amdgcn_rcpf(x); }
DI float fast_exp2(float x) { return __builtin_amdgcn_exp2f(x); }
DI float sigmoidf_(float v) { return fast_rcp(1.f + fast_exp2(-v * LOG2E)); }
DI float xor_reduce_g(float v) { v += __shfl_xor(v, 16); v += __shfl_xor(v, 32); return v; }
DI float wave_sum(float v) {
#pragma unroll
    for (int o = 1; o < 64; o <<= 1) v += __shfl_xor(v, o);
    return v;
}
DI int perm32(int s) { const int lo = s & 31; return (s & ~31) | (((lo >> 2) & 3) << 3) | ((lo >> 4) << 2) | (lo & 3); }
DI const float* xrow_ptr(const Params& p, int t) { return t < T_PROMPT ? p.in[0] + (size_t)t * D : p.in[1] + (size_t)(t - T_PROMPT) * D; }

DI void tile_map(int L, int nN, int ntiles, int& pm, int& pn) {
    const int xcd = L & 7, q = L >> 3;
    const int Lp = xcd * (ntiles >> 3) + q;
    const int grp = Lp / (8 * nN), rem = Lp % (8 * nN);
    pm = grp * 8 + (rem & 7); pn = rem >> 3;
}

#define LAS __attribute__((address_space(3)))
#define GAS __attribute__((address_space(1)))
template <int BM, int BN, int NWM, int NWN>
DI void gemm_mainloop_p(f32x4 (&acc)[BM / NWM / 16][BN / NWN / 16], const bf16_t* const (&Ar)[BM / (NWM * NWN * 8)],
                        const bf16_t* __restrict__ B, int ldb, int K, char* lds, const int tid) {
    constexpr int RPR = NWM * NWN * 8;
    constexpr int MT = BM / NWM / 16, NT = BN / NWN / 16, NA = BM / RPR, NB = BN / RPR, STAGE = (BM + BN) * 128, RB = RPR * 128;
    const int lane = tid & 63, wave = tid >> 6;
    const int wm = wave / NWN, wn = wave % NWN;
    const int r = lane & 15, g = lane >> 4;
    const int lr = tid >> 3, lc = tid & 7;
    const int csrc = (lc ^ ((lr >> 1) & 7)) * 8;
    const bf16_t* Bp = B + (size_t)lr * ldb + csrc;
    const int nk = K >> 6;
    auto issue = [&](int kt, int st) {
        char* d = lds + st * STAGE + tid * 16;
#pragma unroll
        for (int i = 0; i < NA; ++i)
            __builtin_amdgcn_global_load_lds((const GAS unsigned*)(Ar[i] + kt * 64), (LAS unsigned*)(d + i * RB), 16, 0, 0);
#pragma unroll
        for (int i = 0; i < NB; ++i)
            __builtin_amdgcn_global_load_lds((const GAS unsigned*)(Bp + (size_t)(RPR * i) * ldb + kt * 64), (LAS unsigned*)(d + BM * 128 + i * RB), 16, 0, 0);
    };
    issue(0, 0);
    __syncthreads();
    const int rsw = (r >> 1) & 7;
    for (int kt = 0; kt < nk; ++kt) {
        const int cur = kt & 1;
        if (kt + 1 < nk) issue(kt + 1, cur ^ 1);
        const char* sA = lds + cur * STAGE;
        const char* sB = sA + BM * 128;
#pragma unroll
        for (int ks = 0; ks < 2; ++ks) {
            bf16x8 wf[NT], xf[MT];
            const int co = ((ks * 4 + g) ^ rsw) * 16;
#pragma unroll
            for (int nt = 0; nt < NT; ++nt) wf[nt] = *(const bf16x8*)(sB + (wn * (NT * 16) + nt * 16 + r) * 128 + co);
#pragma unroll
            for (int mt = 0; mt < MT; ++mt) xf[mt] = *(const bf16x8*)(sA + (wm * (MT * 16) + mt * 16 + r) * 128 + co);
#pragma unroll
            for (int mt = 0; mt < MT; ++mt)
#pragma unroll
                for (int nt = 0; nt < NT; ++nt) acc[mt][nt] = __builtin_amdgcn_mfma_f32_16x16x32_bf16(wf[nt], xf[mt], acc[mt][nt], 0, 0, 0);
        }
        __syncthreads();
    }
}

template <int BM, int BN, int NWM, int NWN>
DI void gemm_mainloop(f32x4 (&acc)[BM / NWM / 16][BN / NWN / 16], const bf16_t* __restrict__ A, int lda,
                      const bf16_t* __restrict__ B, int ldb, int K, char* lds, const int tid) {
    constexpr int RPR = NWM * NWN * 8;
    const int lr = tid >> 3, lc = tid & 7;
    const bf16_t* Ar[BM / RPR];
#pragma unroll
    for (int i = 0; i < BM / RPR; ++i) Ar[i] = A + (size_t)(lr + RPR * i) * lda + (lc ^ ((lr >> 1) & 7)) * 8;
    gemm_mainloop_p<BM, BN, NWM, NWN>(acc, Ar, B, ldb, K, lds, tid);
}

template <int MT, int NT>
DI void zero_acc(f32x4 (&acc)[MT][NT]) {
#pragma unroll
    for (int i = 0; i < MT; ++i)
#pragma unroll
        for (int j = 0; j < NT; ++j) acc[i][j] = (f32x4){0.f, 0.f, 0.f, 0.f};
}

DI void transpose_item(const float* __restrict__ W, int K, int N, bf16_t* __restrict__ WT, int mode, const float* __restrict__ scale,
                       float* scr, int item, int lane) {
    const int nblk = N >> 5, kb = item / nblk, nb = item % nblk, k0 = kb * 64, n0 = nb * 32;
#pragma unroll 8
    for (int i = 0; i < 32; ++i) {
        const int kk = 2 * i + (lane >> 5);
        float v = W[(size_t)(k0 + kk) * N + n0 + (lane & 31)];
        if (scale) v *= scale[k0 + kk];
        scr[kk * 33 + (lane & 31)] = v;
    }
    asm volatile("s_waitcnt lgkmcnt(0)" ::: "memory");
    const int c = lane & 7;
#pragma unroll
    for (int j = 0; j < 4; ++j) {
        const int nl = (lane >> 3) + 8 * j;
        const float* s = scr + (8 * c) * 33 + nl;
        u32x4 o;
        o.x = pk2(s[0 * 33], s[1 * 33]); o.y = pk2(s[2 * 33], s[3 * 33]); o.z = pk2(s[4 * 33], s[5 * 33]); o.w = pk2(s[6 * 33], s[7 * 33]);
        const int n = n0 + nl;
        int row;
        if (mode == 1) row = n < 1184 ? n : n + 96;
        else if (mode == 2) { const int h = n >> 7, jj = n & 127; row = jj < 64 ? h * 64 + jj : 512 + h * 64 + (jj - 64); }
        else if (mode == 3) { const int hf = n >= DFF ? 1 : 0, m2 = n - hf * DFF; row = (m2 >> 7) * 256 + hf * 128 + (m2 & 127); }
        else row = n;
        *(u32x4*)(WT + (size_t)row * K + k0 + 8 * c) = o;
    }
    asm volatile("s_waitcnt lgkmcnt(0)" ::: "memory");
}

DI void phase0(const Params& p, char* lds) {
    const int tid = TID4, bid = VBID, G = VGRID, lane = tid & 63, wave = tid >> 6;
    unsigned char* ws = p.ws;
    float* sc = (float*)lds;
    for (int it = bid; it < 384; it += G) {
        const int cb = it % 24, ks = it / 24;
        __syncthreads();
        for (int i = tid; i < 24 * 64; i += 256) {
            const int b = i >> 6, k = i & 63;
            const float* c = b < 8 ? p.in[2] + b * 1024 : p.in[3] + (b - 8) * 1024;
            const float v = c[ks * 64 + k];
            sc[i] = v * sigmoidf_(v);
        }
        __syncthreads();
        float a[24];
#pragma unroll
        for (int b = 0; b < 24; ++b) a[b] = 0.f;
        const int n = cb * 256 + tid;
        const float* w = p.in[4] + (size_t)(ks * 64) * 6144 + n;
        for (int k = 0; k < 64; ++k) {
            const float wv = w[(size_t)k * 6144];
#pragma unroll
            for (int b = 0; b < 24; ++b) a[b] += sc[b * 64 + k] * wv;
        }
        float* mp = (float*)(ws + O_MODP) + (size_t)(ks * 24) * 6144 + n;
#pragma unroll
        for (int b = 0; b < 24; ++b) mp[(size_t)b * 6144] = a[b];
    }
    __syncthreads();
    {
        float* scr = (float*)(lds + wave * 8448);
        const int gw = bid * 4 + wave, NGW = G * 4;
        constexpr int I0 = 16 * 101, I1 = 4 * 24, I2 = 2 * 32, I3 = 8 * 32, I4 = 8 * 32, I5 = 16 * 32, I6 = 16 * 176, I7 = 44 * 32;
        constexpr int NI = I0 + I1 + I2 + I3 + I4 + I5 + I6 + I7;
        for (int it = gw; it < NI; it += NGW) {
            int q = it;
            if (q < I0) { transpose_item(p.in[7], 1024, IN_TOTAL, (bf16_t*)(ws + O_WIN), 1, nullptr, scr, q, lane); continue; } q -= I0;
            if (q < I1) { transpose_item(p.in[12], 256, 768, (bf16_t*)(ws + O_WUQ), 0, p.in[11], scr, q, lane); continue; } q -= I1;
            if (q < I2) { transpose_item(p.in[14], 128, 1024, (bf16_t*)(ws + O_WUKV), 2, p.in[13], scr, q, lane); continue; } q -= I2;
            if (q < I3) { transpose_item(p.in[17], 512, 1024, (bf16_t*)(ws + O_WOA), 0, nullptr, scr, q, lane); continue; } q -= I3;
            if (q < I4) { transpose_item(p.in[18], 512, 1024, (bf16_t*)(ws + O_WOB), 0, nullptr, scr, q, lane); continue; } q -= I4;
            if (q < I5) { transpose_item(p.in[19], 1024, 1024, (bf16_t*)(ws + O_WOUT), 0, nullptr, scr, q, lane); continue; } q -= I5;
            if (q < I6) { transpose_item(p.in[21], 1024, NUP, (bf16_t*)(ws + O_WUP), 3, nullptr, scr, q, lane); continue; } q -= I6;
            transpose_item(p.in[24], DFF, 1024, (bf16_t*)(ws + O_WDN), 0, nullptr, scr, q, lane);
        }
    }
    const int gt = bid * 256 + tid, NGT = G * 256;
    for (int i = gt; i < 4096 * 48; i += NGT) {
        const int pos = i / 48, j = i % 48;
        float inv;
        if (j < 32) inv = exp2f(-(float)(2 * j) * (1.f / 64.f) * 13.287712379549449f);
        else inv = exp2f(-(float)(2 * (j - 32)) * (1.f / 32.f) * 13.287712379549449f);
        const float ang = (float)pos * inv;
        float rev = ang * 0.15915494309189535f;
        rev -= floorf(rev);
        const float sn = __builtin_amdgcn_sinf(rev), cs = __builtin_amdgcn_cosf(rev);
        float2* dst = j < 32 ? (float2*)(ws + O_ROPEA) + pos * 32 + j : (float2*)(ws + O_ROPEB) + pos * 16 + (j - 32);
        *dst = make_float2(cs, sn);
    }
    for (int i = gt; i < 96 * 1024 / 8; i += NGT) *(u32x4*)((bf16_t*)(ws + O_WIN) + 1184 * 1024 + (size_t)i * 8) = (u32x4){0u, 0u, 0u, 0u};
    if (gt < 256) *(u32x4*)(ws + O_ZROW + gt * 16) = (u32x4){0u, 0u, 0u, 0u};
}

DI void phase0m(const Params& p) {
    const int gt = VBID * 256 + TID4, NGT = VGRID * 256;
    const float* mp = (const float*)(p.ws + O_MODP);
    float* mod = (float*)(p.ws + O_MOD);
    for (int i = gt; i < 24 * 6144; i += NGT) {
        float s = p.in[5][i % 6144];
#pragma unroll
        for (int ks = 0; ks < 16; ++ks) s += mp[(size_t)ks * 24 * 6144 + i];
        mod[i] = s;
    }
}

DI void norm_pass(const Params& p, bool second, bf16_t* dst) {
    const int lane = TID4 & 63, gw = VBID * 4 + (TID4 >> 6), NGW = VGRID * 4;
    const float* gwt = second ? p.in[20] : p.in[6];
    const float* mod = (const float*)(p.ws + O_MOD);
    f32x4 gv[4];
#pragma unroll
    for (int j = 0; j < 4; ++j) gv[j] = *((const f32x4*)gwt + 64 * j + lane);
    for (int t = gw; t < T; t += NGW) {
        const float* xr = second ? p.out + (size_t)t * D : xrow_ptr(p, t);
        const int b = t >> 12;
        const float* sh = mod + (size_t)b * 6144 + (second ? 3072 : 0);
        const float* sc = sh + 1024;
        f32x4 v[4]; float s = 0.f;
#pragma unroll
        for (int j = 0; j < 4; ++j) { v[j] = *((const f32x4*)xr + 64 * j + lane); s += (v[j].x * v[j].x + v[j].y * v[j].y) + (v[j].z * v[j].z + v[j].w * v[j].w); }
        const float rstd = rsqrtf(wave_sum(s) * (1.f / D) + EPS);
        u32x2* o = (u32x2*)(dst + (size_t)t * D) + lane;
#pragma unroll
        for (int j = 0; j < 4; ++j) {
            const f32x4 scv = *((const f32x4*)sc + 64 * j + lane), shv = *((const f32x4*)sh + 64 * j + lane);
            f32x4 y;
            y.x = v[j].x * rstd * gv[j].x * (1.f + scv.x) + shv.x; y.y = v[j].y * rstd * gv[j].y * (1.f + scv.y) + shv.y;
            y.z = v[j].z * rstd * gv[j].z * (1.f + scv.z) + shv.z; y.w = v[j].w * rstd * gv[j].w * (1.f + scv.w) + shv.w;
            o[64 * j] = (u32x2){pk2(y.x, y.y), pk2(y.z, y.w)};
        }
    }
}

DI void phase1(const Params& p, char* lds) {
    const bf16_t* H = (const bf16_t*)(p.ws + O_H);
    const bf16_t* W = (const bf16_t*)(p.ws + O_WIN);
    bf16_t* ZS = (bf16_t*)(p.ws + O_ZS);
    bf16_t* Gt = (bf16_t*)((unsigned char*)p.out + OO_G);
    constexpr int nM = T / 256, nN = NIN / 256, NTILES = nM * nN;
    const int tid = threadIdx.x, lane = tid & 63, wave = tid >> 6, wm = wave >> 2, wn = wave & 3, r = lane & 15, g = lane >> 4;
    for (int L = blockIdx.x; L < NTILES; L += gridDim.x) {
        int pm, pn; tile_map(L, nN, NTILES, pm, pn);
        f32x4 acc[8][4]; zero_acc(acc);
        gemm_mainloop<256, 256, 2, 4>(acc, H + (size_t)pm * 256 * 1024, 1024, W + (size_t)pn * 256 * 1024, 1024, 1024, lds, tid);
        const int col0 = pn * 256 + wn * 64 + g * 4;
#pragma unroll
        for (int mt = 0; mt < 8; ++mt) {
            const int m = pm * 256 + wm * 128 + mt * 16 + r;
#pragma unroll
            for (int nt = 0; nt < 4; ++nt) {
                const int n = col0 + nt * 16;
                const f32x4 a = acc[mt][nt];
                if (pn < NZ / 256) *(u32x2*)(ZS + (size_t)m * NZ + n) = (u32x2){pk2(a.x, a.y), pk2(a.z, a.w)};
                else *(u32x2*)(Gt + (size_t)m * 2048 + (n - NZ)) = (u32x2){pk2(sigmoidf_(a.x), sigmoidf_(a.y)), pk2(sigmoidf_(a.z), sigmoidf_(a.w))};
            }
        }
    }
}

template <int NCH>
DI float row_sumsq(const bf16_t* rowp, int g) {
    float s = 0.f;
#pragma unroll
    for (int c = 0; c < NCH; ++c) {
        const u32x4 v = *(const u32x4*)(rowp + (g * NCH + c) * 8);
#pragma unroll
        for (int e = 0; e < 4; ++e) { const float a = bflo(v[e]), b = bfhi(v[e]); s += a * a + b * b; }
    }
    return xor_reduce_g(s);
}

DI void phase2(const Params& p, char* lds) {
    unsigned char* ws = p.ws;
    const bf16_t* ZS = (const bf16_t*)(ws + O_ZS);
    const int tid = TID4, lane = tid & 63, wave = tid >> 6, r = lane & 15, g = lane >> 4;
    const float2* ropeA = (const float2*)(ws + O_ROPEA);
    const float2* ropeB = (const float2*)(ws + O_ROPEB);
    constexpr int NTL = T / 128;
    for (int it = VBID; it < NTL * 8; it += VGRID) {
        const int tile = it >> 3, sub = it & 7, t0 = tile * 128, b = t0 >> 12, s0 = t0 & (S - 1);
        {
            const int h = sub;
            f32x4 acc[2][6]; zero_acc(acc);
            gemm_mainloop<128, 96, 4, 1>(acc, ZS + (size_t)t0 * NZ + 768, NZ, (const bf16_t*)(ws + O_WUQ) + (size_t)h * 96 * 256, 256, 256, lds, tid);
            const float* gq = p.in[15];
            const float qs = 0.10206207261596577f * LOG2E;
            bf16_t* QB = (bf16_t*)(ws + O_QB) + ((size_t)(b * 8 + h) * S) * 96;
#pragma unroll
            for (int mt = 0; mt < 2; ++mt) {
                const int ml = wave * 32 + mt * 16 + r, sp = s0 + ml;
                const float rstd = rsqrtf(row_sumsq<8>(ZS + (size_t)(t0 + ml) * NZ + 768, g) * (1.f / 256.f) + EPS);
                float ss = 0.f;
#pragma unroll
                for (int nt = 0; nt < 6; ++nt) { acc[mt][nt] = acc[mt][nt] * rstd; const f32x4 a = acc[mt][nt]; ss += (a.x * a.x + a.y * a.y) + (a.z * a.z + a.w * a.w); }
                const float r2 = rsqrtf(xor_reduce_g(ss) * (1.f / 96.f) + EPS);
#pragma unroll
                for (int nt = 0; nt < 6; ++nt) {
                    const f32x4 gg = *(const f32x4*)(gq + nt * 16 + g * 4);
                    acc[mt][nt] = acc[mt][nt] * r2 * gg;
                }
#pragma unroll
                for (int j = 0; j < 4; ++j) {
                    const float2 cs = ropeB[sp * 16 + g * 4 + j];
                    const float x1 = acc[mt][4][j], x2 = acc[mt][5][j];
                    acc[mt][4][j] = x1 * cs.x - x2 * cs.y;
                    acc[mt][5][j] = x1 * cs.y + x2 * cs.x;
                }
                bf16_t* qrow = QB + (size_t)sp * 96 + g * 4;
#pragma unroll
                for (int nt = 0; nt < 6; ++nt) { const f32x4 a = acc[mt][nt] * qs; *(u32x2*)(qrow + nt * 16) = (u32x2){pk2(a.x, a.y), pk2(a.z, a.w)}; }
                __builtin_amdgcn_sched_barrier(0);
            }
        }
    }
    for (int it = VBID; it < NTL * 4; it += VGRID) {
        const int tile = it >> 2, hp = it & 3, t0 = tile * 128, b = t0 >> 12, s0 = t0 & (S - 1);
        {
            f32x4 acc[4][4]; zero_acc(acc);
            gemm_mainloop<128, 128, 2, 2>(acc, ZS + (size_t)t0 * NZ + 1024, NZ,
                                          (const bf16_t*)(ws + O_WUKV) + (size_t)(hp * 128) * 128, 128, 128, lds, tid);
            const int wm = wave >> 1, wn = wave & 1, h = hp * 2 + wn;
            {
                const float* gk = p.in[16];
                bf16_t* KB = (bf16_t*)(ws + O_KB) + ((size_t)(b * 8 + h) * S) * 96;
#pragma unroll
                for (int mt = 0; mt < 4; ++mt) {
                    const int ml = wm * 64 + mt * 16 + r, sp = s0 + ml;
                    const bf16_t* zrow = ZS + (size_t)(t0 + ml) * NZ;
                    const float rstd = rsqrtf(row_sumsq<4>(zrow + 1024, g) * (1.f / 128.f) + EPS);
                    const u32x2 k1 = *(const u32x2*)(zrow + 1152 + g * 4), k2 = *(const u32x2*)(zrow + 1168 + g * 4);
                    float x1[4] = {bflo(k1.x), bfhi(k1.x), bflo(k1.y), bfhi(k1.y)};
                    float x2[4] = {bflo(k2.x), bfhi(k2.x), bflo(k2.y), bfhi(k2.y)};
                    float ss = 0.f;
#pragma unroll
                    for (int j = 0; j < 4; ++j) ss += x1[j] * x1[j] + x2[j] * x2[j];
#pragma unroll
                    for (int nt = 0; nt < 4; ++nt) { acc[mt][nt] = acc[mt][nt] * rstd; const f32x4 a = acc[mt][nt]; ss += (a.x * a.x + a.y * a.y) + (a.z * a.z + a.w * a.w); }
                    const float r2 = rsqrtf(xor_reduce_g(ss) * (1.f / 96.f) + EPS);
                    bf16_t* krow = KB + (size_t)sp * 96 + g * 4;
#pragma unroll
                    for (int nt = 0; nt < 4; ++nt) {
                        const f32x4 gg = *(const f32x4*)(gk + nt * 16 + g * 4);
                        const f32x4 a = acc[mt][nt] * r2 * gg;
                        *(u32x2*)(krow + nt * 16) = (u32x2){pk2(a.x, a.y), pk2(a.z, a.w)};
                    }
                    const f32x4 g1 = *(const f32x4*)(gk + 64 + g * 4), g2 = *(const f32x4*)(gk + 80 + g * 4);
                    float o1[4], o2[4];
#pragma unroll
                    for (int j = 0; j < 4; ++j) {
                        const float2 cs = ropeB[sp * 16 + g * 4 + j];
                        const float y1 = x1[j] * r2 * g1[j], y2 = x2[j] * r2 * g2[j];
                        o1[j] = y1 * cs.x - y2 * cs.y; o2[j] = y1 * cs.y + y2 * cs.x;
                    }
                    *(u32x2*)(krow + 64) = (u32x2){pk2(o1[0], o1[1]), pk2(o1[2], o1[3])};
                    *(u32x2*)(krow + 80) = (u32x2){pk2(o2[0], o2[1]), pk2(o2[2], o2[3])};
                    __builtin_amdgcn_sched_barrier(0);
                }
            }
        }
    }
    for (int it = VBID; it < NTL * 4; it += VGRID) {
        const int tile = it >> 2, hp = it & 3, t0 = tile * 128, b = t0 >> 12, s0 = t0 & (S - 1);
        {
            f32x4 acc[4][4]; zero_acc(acc);
            gemm_mainloop<128, 128, 2, 2>(acc, ZS + (size_t)t0 * NZ + 1024, NZ,
                                          (const bf16_t*)(ws + O_WUKV) + (size_t)(512 + hp * 128) * 128, 128, 128, lds, tid);
            const int wm = wave >> 1, wn = wave & 1, h = hp * 2 + wn;
            {
                bf16_t* VT = (bf16_t*)(ws + O_VTB) + ((size_t)(b * 8 + h) * 64) * S;
#pragma unroll
                for (int mt = 0; mt < 4; ++mt) {
                    const int ml = wm * 64 + mt * 16 + r, sp = s0 + ml;
                    const float rstd = rsqrtf(row_sumsq<4>(ZS + (size_t)(t0 + ml) * NZ + 1024, g) * (1.f / 128.f) + EPS);
                    const int ps = perm32(sp);
#pragma unroll
                    for (int nt = 0; nt < 4; ++nt)
#pragma unroll
                        for (int j = 0; j < 4; ++j) VT[(size_t)(nt * 16 + g * 4 + j) * S + ps] = f2bf(acc[mt][nt][j] * rstd);
                    __builtin_amdgcn_sched_barrier(0);
                }
            }
        }
    }
    __syncthreads();
    for (int tile = VBID; tile < NTL; tile += VGRID) {
        const int t0 = tile * 128, b = t0 >> 12, s0 = t0 & (S - 1);
        {
            const float* gqa = p.in[8];
            const float* gka = p.in[9];
            const int half = lane >> 5, i = lane & 31;
            const float qs = 0.125f * LOG2E;
            const float gq1 = gqa[i], gq2 = gqa[32 + i], gk1 = gka[i], gk2 = gka[32 + i];
            for (int tt0 = wave * 4; tt0 < 128; tt0 += 16) {
                float x1[4][5], x2[4][5]; float2 cs[4];
#pragma unroll
                for (int u = 0; u < 4; ++u) {
                    const bf16_t* zrow = ZS + (size_t)(t0 + tt0 + u) * NZ;
                    cs[u] = ropeA[(s0 + tt0 + u) * 32 + i];
#pragma unroll
                    for (int q = 0; q < 5; ++q) { const int hd = 2 * q + half; x1[u][q] = bf2f(zrow[hd * 64 + i]); x2[u][q] = bf2f(zrow[hd * 64 + 32 + i]); }
                }
#pragma unroll
                for (int u = 0; u < 4; ++u) {
                    const int sp = s0 + tt0 + u;
#pragma unroll
                    for (int q = 0; q < 5; ++q) {
                        const int hd = 2 * q + half;
                        float ss = x1[u][q] * x1[u][q] + x2[u][q] * x2[u][q];
#pragma unroll
                        for (int o = 1; o < 32; o <<= 1) ss += __shfl_xor(ss, o);
                        const float rr = rsqrtf(ss * (1.f / 64.f) + EPS);
                        const bool isq = q < 4;
                        const float y1 = x1[u][q] * rr * (isq ? gq1 : gk1), y2 = x2[u][q] * rr * (isq ? gq2 : gk2);
                        float o1 = y1 * cs[u].x - y2 * cs[u].y, o2 = y1 * cs[u].y + y2 * cs[u].x;
                        bf16_t* dst;
                        if (isq) { o1 *= qs; o2 *= qs; dst = (bf16_t*)(ws + O_QA) + ((size_t)(b * 8 + hd) * S + sp) * 64; }
                        else dst = (bf16_t*)(ws + O_KA) + ((size_t)(b * 2 + (hd - 8)) * S + sp) * 64;
                        dst[i] = f2bf(o1); dst[32 + i] = f2bf(o2);
                    }
                }
            }
            __syncthreads();
            bf16_t* tl = (bf16_t*)lds;
            for (int idx = tid; idx < 128 * 16; idx += 256) {
                const int tt = idx >> 4, c = idx & 15;
                const u32x4 v = *(const u32x4*)(ZS + (size_t)(t0 + tt) * NZ + 640 + c * 8);
                u32x2* d2 = (u32x2*)(tl + tt * 132 + c * 8);
                d2[0] = (u32x2){v.x, v.y}; d2[1] = (u32x2){v.z, v.w};
            }
            __syncthreads();
            bf16_t* VT = (bf16_t*)(ws + O_VTA) + ((size_t)(b * 2) * 64) * S;
            for (int idx = tid; idx < 128 * 128; idx += 256) {
                const int pp = idx & 127, dd = idx >> 7;
                const int lo = pp & 31;
                const int tt = (pp & ~31) | (((lo >> 2) & 1) << 4) | ((lo >> 3) << 2) | (lo & 3);
                VT[(size_t)dd * S + s0 + pp] = tl[tt * 132 + dd];
            }
            __syncthreads();
        }
    }
}

template <int DQK, bool WIN>
DI void attn_item(const bf16_t* __restrict__ Qw, const bf16_t* __restrict__ Kb, const bf16_t* __restrict__ Vt, int key0, int ntiles, int q0,
                  float shift2, float sink_term, bf16_t* __restrict__ Ow, int ldo, char* lds) {
    constexpr int KS = DQK / 32, CH = DQK / 8, KSTR = DQK * 2 + 32, NKL = CH * 64 / 256, VSTR = 160, STAGE = 64 * 224 + 64 * VSTR;
    const int tid = TID4, lane = tid & 63, r = lane & 15, g = lane >> 4;
    bf16x8 qf[2][KS];
#pragma unroll
    for (int qt = 0; qt < 2; ++qt)
#pragma unroll
        for (int ks = 0; ks < KS; ++ks) qf[qt][ks] = *(const bf16x8*)(Qw + (size_t)(qt * 16 + r) * DQK + ks * 32 + g * 8);
    f32x4 oacc[4][2];
#pragma unroll
    for (int i = 0; i < 4; ++i) { oacc[i][0] = (f32x4){0.f, 0.f, 0.f, 0.f}; oacc[i][1] = (f32x4){0.f, 0.f, 0.f, 0.f}; }
    float lsum[2] = {0.f, 0.f};
    u32x4 rk[NKL], rv[2];
    int krow[NKL], kc[NKL];
#pragma unroll
    for (int i = 0; i < NKL; ++i) { const int idx = tid + 256 * i; krow[i] = idx / CH; kc[i] = idx % CH; }
    const int vrow = tid >> 3, vc = tid & 7;
    auto gload = [&](int tile) {
        const int kb = key0 + tile * 64;
#pragma unroll
        for (int i = 0; i < NKL; ++i) rk[i] = *(const u32x4*)(Kb + (size_t)(kb + krow[i]) * DQK + kc[i] * 8);
#pragma unroll
        for (int i = 0; i < 2; ++i) rv[i] = *(const u32x4*)(Vt + (size_t)(vrow + 32 * i) * S + kb + vc * 8);
    };
    auto lstore = [&](int st) {
        char* sK = lds + st * STAGE; char* sV = sK + 64 * 224;
#pragma unroll
        for (int i = 0; i < NKL; ++i) *(u32x4*)(sK + krow[i] * KSTR + kc[i] * 16) = rk[i];
#pragma unroll
        for (int i = 0; i < 2; ++i) *(u32x4*)(sV + (vrow + 32 * i) * VSTR + vc * 16) = rv[i];
    };
    __syncthreads();
    gload(0); lstore(0);
    __syncthreads();
    for (int tile = 0; tile < ntiles; ++tile) {
        const int cur = tile & 1;
        const bool more = tile + 1 < ntiles;
        if (more) gload(tile + 1);
        const char* sK = lds + cur * STAGE; const char* sV = sK + 64 * 224;
        f32x4 sacc[4][2];
#pragma unroll
        for (int kt = 0; kt < 4; ++kt) {
            sacc[kt][0] = (f32x4){0.f, 0.f, 0.f, 0.f}; sacc[kt][1] = (f32x4){0.f, 0.f, 0.f, 0.f};
#pragma unroll
            for (int ks = 0; ks < KS; ++ks) {
                const bf16x8 kf = *(const bf16x8*)(sK + (kt * 16 + r) * KSTR + (ks * 4 + g) * 16);
                sacc[kt][0] = __builtin_amdgcn_mfma_f32_16x16x32_bf16(kf, qf[0][ks], sacc[kt][0], 0, 0, 0);
                sacc[kt][1] = __builtin_amdgcn_mfma_f32_16x16x32_bf16(kf, qf[1][ks], sacc[kt][1], 0, 0, 0);
            }
        }
        const int kbase = key0 + tile * 64 + g * 4;
#pragma unroll
        for (int kt = 0; kt < 4; ++kt)
#pragma unroll
            for (int qt = 0; qt < 2; ++qt)
#pragma unroll
                for (int j = 0; j < 4; ++j) {
                    float pv = fast_exp2(sacc[kt][qt][j] - shift2);
                    if (WIN) { const int dlt = (kbase + kt * 16 + j) - (q0 + qt * 16 + r); if (dlt > 128 || dlt < -128) pv = 0.f; }
                    sacc[kt][qt][j] = pv; lsum[qt] += pv;
                }
#pragma unroll
        for (int kk = 0; kk < 2; ++kk) {
            bf16x8 pb[2];
#pragma unroll
            for (int qt = 0; qt < 2; ++qt) {
                u32x4 u;
                u.x = pk2(sacc[2 * kk][qt][0], sacc[2 * kk][qt][1]); u.y = pk2(sacc[2 * kk][qt][2], sacc[2 * kk][qt][3]);
                u.z = pk2(sacc[2 * kk + 1][qt][0], sacc[2 * kk + 1][qt][1]); u.w = pk2(sacc[2 * kk + 1][qt][2], sacc[2 * kk + 1][qt][3]);
                pb[qt] = __builtin_bit_cast(bf16x8, u);
            }
#pragma unroll
            for (int dt = 0; dt < 4; ++dt) {
                const bf16x8 vf = *(const bf16x8*)(sV + (dt * 16 + r) * VSTR + (kk * 4 + g) * 16);
                oacc[dt][0] = __builtin_amdgcn_mfma_f32_16x16x32_bf16(vf, pb[0], oacc[dt][0], 0, 0, 0);
                oacc[dt][1] = __builtin_amdgcn_mfma_f32_16x16x32_bf16(vf, pb[1], oacc[dt][1], 0, 0, 0);
            }
        }
        if (more) lstore(cur ^ 1);
        __syncthreads();
    }
#pragma unroll
    for (int qt = 0; qt < 2; ++qt) {
        const float inv = fast_rcp(xor_reduce_g(lsum[qt]) + sink_term);
        bf16_t* orow = Ow + (size_t)(qt * 16 + r) * ldo + g * 4;
#pragma unroll
        for (int dt = 0; dt < 4; ++dt) { const f32x4 a = oacc[dt][qt] * inv; *(u32x2*)(orow + dt * 16) = (u32x2){pk2(a.x, a.y), pk2(a.z, a.w)}; }
    }
}

DI float max_abs(const float* v, int n) { float m = 0.f; for (int i = 0; i < n; ++i) m = fmaxf(m, fabsf(v[i])); return m; }

DI void phase3(const Params& p, char* lds) {
    unsigned char* ws = p.ws;
    const int wave = TID4 >> 6;
    const float shiftB = 9.797958971132712f * max_abs(p.in[15], 96) * max_abs(p.in[16], 96) * LOG2E;
    const float shiftA = 8.f * max_abs(p.in[8], 64) * max_abs(p.in[9], 64) * LOG2E;
    bf16_t* OA = (bf16_t*)(p.ws + O_OA);
    bf16_t* OB = (bf16_t*)(p.ws + O_OB);
    constexpr int NB_ITEMS = 24 * 8 * 32, NA_ITEMS = 24 * 2 * 128;
    for (int L = VBID; L < NB_ITEMS; L += VGRID) {
        const int idx = (L & 7) * (NB_ITEMS / 8) + (L >> 3);
        const int bh = idx >> 5, qb = idx & 31, b = bh >> 3, h = bh & 7;
        const int q0 = qb * 128 + wave * 32;
        attn_item<96, false>((const bf16_t*)(ws + O_QB) + ((size_t)bh * S + q0) * 96, (const bf16_t*)(ws + O_KB) + (size_t)bh * S * 96,
                             (const bf16_t*)(ws + O_VTB) + (size_t)bh * 64 * S, 0, S / 64, q0, shiftB, 0.f,
                             OB + ((size_t)b * S + q0) * 512 + h * 64, 512, lds);
    }
    for (int L = VBID; L < NA_ITEMS; L += VGRID) {
        const int idx = (L & 7) * (NA_ITEMS / 8) + (L >> 3);
        const int bk = idx >> 7, qb = idx & 127, b = bk >> 1, kvh = bk & 1;
        const int q0 = qb * 32, hd = kvh * 4 + wave;
        int ks = (q0 - 128) & ~63; if (ks < 0) ks = 0; if (ks > S - 320) ks = S - 320;
        const float sink_term = fast_exp2(p.in[10][hd] * LOG2E - shiftA);
        attn_item<64, true>((const bf16_t*)(ws + O_QA) + ((size_t)(b * 8 + hd) * S + q0) * 64, (const bf16_t*)(ws + O_KA) + (size_t)bk * S * 64,
                            (const bf16_t*)(ws + O_VTA) + (size_t)bk * 64 * S, ks, 5, q0, shiftA, sink_term,
                            OA + ((size_t)b * S + q0) * 512 + hd * 64, 512, lds);
    }
}

DI void phase4(const Params& p, char* lds) {
    const bf16_t* OA = (const bf16_t*)(p.ws + O_OA);
    const bf16_t* OB = (const bf16_t*)(p.ws + O_OB);
    const bf16_t* Gt = (const bf16_t*)((unsigned char*)p.out + OO_G);
    bf16_t* MIX = (bf16_t*)(p.ws + O_ZS);
    constexpr int nM = T / 128, nN = 4, NTILES = nM * nN;
    const int tid = threadIdx.x, lane = tid & 63, wave = tid >> 6, wm = wave >> 2, wn = wave & 3, r = lane & 15, g = lane >> 4;
    for (int L = blockIdx.x; L < NTILES; L += gridDim.x) {
        int pm, pn; tile_map(L, nN, NTILES, pm, pn);
        f32x4 acc[4][4]; u32x2 mixp[4][4]; zero_acc(acc);
        gemm_mainloop<128, 256, 2, 4>(acc, OA + (size_t)pm * 128 * 512, 512, (const bf16_t*)(p.ws + O_WOA) + (size_t)pn * 256 * 512, 512, 512, lds, tid);
        const int col0 = pn * 256 + wn * 64 + g * 4;
#pragma unroll
        for (int mt = 0; mt < 4; ++mt) {
            const int m = pm * 128 + wm * 64 + mt * 16 + r;
#pragma unroll
            for (int nt = 0; nt < 4; ++nt) {
                const u32x2 gv = *(const u32x2*)(Gt + (size_t)m * 2048 + col0 + nt * 16);
                const f32x4 a = acc[mt][nt];
                mixp[mt][nt] = (u32x2){pk2(a.x * bflo(gv.x), a.y * bfhi(gv.x)), pk2(a.z * bflo(gv.y), a.w * bfhi(gv.y))};
            }
        }
        zero_acc(acc);
        gemm_mainloop<128, 256, 2, 4>(acc, OB + (size_t)pm * 128 * 512, 512, (const bf16_t*)(p.ws + O_WOB) + (size_t)pn * 256 * 512, 512, 512, lds, tid);
#pragma unroll
        for (int mt = 0; mt < 4; ++mt) {
            const int m = pm * 128 + wm * 64 + mt * 16 + r;
#pragma unroll
            for (int nt = 0; nt < 4; ++nt) {
                const u32x2 gv = *(const u32x2*)(Gt + (size_t)m * 2048 + 1024 + col0 + nt * 16);
                const f32x4 a = acc[mt][nt]; const u32x2 mx = mixp[mt][nt];
                const float o0 = bflo(mx.x) + a.x * bflo(gv.x), o1 = bfhi(mx.x) + a.y * bfhi(gv.x), o2 = bflo(mx.y) + a.z * bflo(gv.y), o3 = bfhi(mx.y) + a.w * bfhi(gv.y);
                *(u32x2*)(MIX + (size_t)m * 1024 + col0 + nt * 16) = (u32x2){pk2(o0, o1), pk2(o2, o3)};
            }
        }
    }
}

DI void phase5(const Params& p, char* lds) {
    const bf16_t* MIX = (const bf16_t*)(p.ws + O_ZS);
    const float* mod = (const float*)(p.ws + O_MOD);
    constexpr int nM = T / 256, nN = 4, NTILES = nM * nN;
    const int tid = threadIdx.x, lane = tid & 63, wave = tid >> 6, wm = wave >> 2, wn = wave & 3, r = lane & 15, g = lane >> 4;
    for (int L = blockIdx.x; L < NTILES; L += gridDim.x) {
        int pm, pn; tile_map(L, nN, NTILES, pm, pn);
        f32x4 acc[8][4]; zero_acc(acc);
        gemm_mainloop<256, 256, 2, 4>(acc, MIX + (size_t)pm * 256 * 1024, 1024, (const bf16_t*)(p.ws + O_WOUT) + (size_t)pn * 256 * 1024, 1024, 1024, lds, tid);
        const int col0 = pn * 256 + wn * 64 + g * 4;
        const int b = (pm * 256) >> 12;
        const float* gt1 = mod + (size_t)b * 6144 + 2048;
#pragma unroll
        for (int mt = 0; mt < 8; ++mt) {
            const int m = pm * 256 + wm * 128 + mt * 16 + r;
            const float* xr = xrow_ptr(p, m);
#pragma unroll
            for (int nt = 0; nt < 4; ++nt) {
                const int n = col0 + nt * 16;
                const f32x4 xv = *(const f32x4*)(xr + n), gv = *(const f32x4*)(gt1 + n);
                *(f32x4*)(p.out + (size_t)m * D + n) = xv + gv * acc[mt][nt];
            }
        }
    }
}

DI void unpack8(const u32x4 v, float (&f)[8]) {
    f[0] = bflo(v.x); f[1] = bfhi(v.x); f[2] = bflo(v.y); f[3] = bfhi(v.y); f[4] = bflo(v.z); f[5] = bfhi(v.z); f[6] = bflo(v.w); f[7] = bfhi(v.w);
}

DI void phase7(const Params& p, char* lds) {
    const bf16_t* H2 = (const bf16_t*)(p.ws + O_H);
    const bf16_t* ZR = (const bf16_t*)(p.ws + O_ZROW);
    bf16_t* ACT = (bf16_t*)(p.ws + O_ACT);
    const float* cw = p.in[22];
    const float* cb = p.in[23];
    constexpr int TPS = 33, nM = NBATCH * TPS, nN = DFF / 128, NTILES = nM * nN, ROWB = 528;
    const int tid = threadIdx.x, lane = tid & 63, wave = tid >> 6, wm = wave >> 2, wn = wave & 3, r = lane & 15, g = lane >> 4;
    const int lr = tid >> 3, lc = tid & 7, csrc = (lc ^ ((lr >> 1) & 7)) * 8;
    for (int L = blockIdx.x; L < NTILES; L += gridDim.x) {
        int pm, pn; tile_map(L, nN, NTILES, pm, pn);
        const int b = pm / TPS, j = pm % TPS, u0 = 126 * j - 1;
        const bf16_t* Ar[2];
#pragma unroll
        for (int i = 0; i < 2; ++i) {
            const int sr = u0 + lr + 64 * i;
            Ar[i] = ((unsigned)sr < (unsigned)S ? H2 + ((size_t)b * S + sr) * 1024 : ZR) + csrc;
        }
        f32x4 acc[4][4]; zero_acc(acc);
        gemm_mainloop_p<128, 256, 2, 4>(acc, Ar, (const bf16_t*)(p.ws + O_WUP) + (size_t)pn * 256 * 1024, 1024, 1024, lds, tid);
#pragma unroll
        for (int mt = 0; mt < 4; ++mt)
#pragma unroll
            for (int nt = 0; nt < 4; ++nt) {
                const f32x4 a = acc[mt][nt];
                *(u32x2*)(lds + (wm * 64 + mt * 16 + r) * ROWB + (wn * 64 + nt * 16 + g * 4) * 2) = (u32x2){pk2(a.x, a.y), pk2(a.z, a.w)};
            }
        __syncthreads();
        {
            const int cc = tid & 15, rr = tid >> 4;
            const int ca = pn * 128 + cc * 8, cg = DFF + ca;
            float wa[3][8], wg[3][8], ba[8], bg[8];
#pragma unroll
            for (int q = 0; q < 2; ++q) {
#pragma unroll
                for (int t = 0; t < 3; ++t) {
                    const f32x4 x = *(const f32x4*)(cw + t * NUP + ca + 4 * q), y = *(const f32x4*)(cw + t * NUP + cg + 4 * q);
#pragma unroll
                    for (int e = 0; e < 4; ++e) { wa[t][4 * q + e] = x[e]; wg[t][4 * q + e] = y[e]; }
                }
                const f32x4 x = *(const f32x4*)(cb + ca + 4 * q), y = *(const f32x4*)(cb + cg + 4 * q);
#pragma unroll
                for (int e = 0; e < 4; ++e) { ba[4 * q + e] = x[e]; bg[4 * q + e] = y[e]; }
            }
#pragma unroll
            for (int q = 0; q < 4; ++q) {
                const int o = rr + 32 * q, so = 126 * j + o;
                if (o < 126 && so < S) {
                    float a0[8], a1[8], a2[8], g0[8], g1[8], g2[8];
                    const char* e0 = lds + o * ROWB + cc * 16;
                    unpack8(*(const u32x4*)(e0), a0); unpack8(*(const u32x4*)(e0 + ROWB), a1); unpack8(*(const u32x4*)(e0 + 2 * ROWB), a2);
                    unpack8(*(const u32x4*)(e0 + 256), g0); unpack8(*(const u32x4*)(e0 + ROWB + 256), g1); unpack8(*(const u32x4*)(e0 + 2 * ROWB + 256), g2);
                    float av[8];
#pragma unroll
                    for (int e = 0; e < 8; ++e) {
                        const float ua = ba[e] + wa[0][e] * a0[e] + wa[1][e] * a1[e] + wa[2][e] * a2[e];
                        const float ug = bg[e] + wg[0][e] * g0[e] + wg[1][e] * g1[e] + wg[2][e] * g2[e];
                        av[e] = ug * sigmoidf_(ug) * ua;
                    }
                    u32x4 ov; ov.x = pk2(av[0], av[1]); ov.y = pk2(av[2], av[3]); ov.z = pk2(av[4], av[5]); ov.w = pk2(av[6], av[7]);
                    *(u32x4*)(ACT + ((size_t)b * S + so) * DFF + ca) = ov;
                }
            }
        }
        __syncthreads();
    }
}

DI void phase8(const Params& p, char* lds) {
    const bf16_t* ACT = (const bf16_t*)(p.ws + O_ACT);
    const float* mod = (const float*)(p.ws + O_MOD);
    constexpr int nM = T / 256, nN = 4, NTILES = nM * nN;
    const int tid = threadIdx.x, lane = tid & 63, wave = tid >> 6, wm = wave >> 2, wn = wave & 3, r = lane & 15, g = lane >> 4;
    for (int L = blockIdx.x; L < NTILES; L += gridDim.x) {
        int pm, pn; tile_map(L, nN, NTILES, pm, pn);
        f32x4 acc[8][4]; zero_acc(acc);
        gemm_mainloop<256, 256, 2, 4>(acc, ACT + (size_t)pm * 256 * DFF, DFF, (const bf16_t*)(p.ws + O_WDN) + (size_t)pn * 256 * DFF, DFF, DFF, lds, tid);
        const int col0 = pn * 256 + wn * 64 + g * 4;
        const int b = (pm * 256) >> 12;
        const float* gt2 = mod + (size_t)b * 6144 + 5120;
#pragma unroll
        for (int mt = 0; mt < 8; ++mt) {
            const int m = pm * 256 + wm * 128 + mt * 16 + r;
#pragma unroll
            for (int nt = 0; nt < 4; ++nt) {
                const int n = col0 + nt * 16;
                float* op = p.out + (size_t)m * D + n;
                const f32x4 xv = *(const f32x4*)op, gv = *(const f32x4*)(gt2 + n);
                *(f32x4*)op = xv + gv * acc[mt][nt];
            }
        }
    }
}

__global__ void __launch_bounds__(512) fwd_megakernel(Params p) {
    __shared__ __attribute__((aligned(16))) char lds[131072];
    cg::grid_group grid = cg::this_grid();
    char* lds4 = lds + (threadIdx.x >> 8) * 65536;
    phase0(p, lds4);
    grid.sync();
    phase0m(p);
    grid.sync();
    norm_pass(p, false, (bf16_t*)(p.ws + O_H));
    grid.sync();
    phase1(p, lds);
    grid.sync();
    phase2(p, lds4);
    grid.sync();
    phase3(p, lds4);
    grid.sync();
    phase4(p, lds);
    grid.sync();
    phase5(p, lds);
    grid.sync();
    norm_pass(p, true, (bf16_t*)(p.ws + O_H));
    grid.sync();
    phase7(p, lds);
    grid.sync();
    phase8(p, lds);
}

extern "C" void kernel_launch(void* const* d_in, const int* in_sizes, int n_in, void* d_out, int out_size, void* d_ws, size_t ws_size,
                              hipStream_t stream) {
    static int grid_blocks = 0;
    if (!grid_blocks) {
        int dev = 0, cus = 0, per_cu = 0;
        hipGetDevice(&dev);
        hipDeviceGetAttribute(&cus, hipDeviceAttributeMultiprocessorCount, dev);
        hipOccupancyMaxActiveBlocksPerMultiprocessor(&per_cu, fwd_megakernel, 512, 0);
        if (per_cu < 1) per_cu = 1;
        if (per_cu > 1) per_cu = 1;
        grid_blocks = cus * per_cu;
        if (n_in != 25 || ws_size < WS_NEED || out_size != T * D)
            fprintf(stderr, "kernel_launch: unexpected sizes n_in=%d ws=%zu out=%d\n", n_in, ws_size, out_size);
    }
    Params p{};
    for (int i = 0; i < 25; ++i) p.in[i] = (const float*)d_in[i];
    p.out = (float*)d_out;
    p.ws = (unsigned char*)d_ws;
    void* args[] = {&p};
    hipError_t e = hipLaunchCooperativeKernel((void*)fwd_megakernel, dim3(grid_blocks), dim3(512), args, 0, stream);
    if (e != hipSuccess) fprintf(stderr, "cooperative launch failed: %s (grid %d)\n", hipGetErrorString(e), grid_blocks);
}
```

```cpp
#include <hip/hip_runtime.h>
#include <hip/hip_cooperative_groups.h>
#include <cstdio>
#include <cstdint>
namespace cg = cooperative_groups;
#ifndef PM
#define PM 4095
#endif
#ifndef DUP
#define DUP 0
#define XSYNC 0
#endif

typedef unsigned short bf16_t;
typedef short bf16x8 __attribute__((ext_vector_type(8)));
typedef float f32x4 __attribute__((ext_vector_type(4)));
typedef unsigned u32x4 __attribute__((ext_vector_type(4)));
typedef unsigned u32x2 __attribute__((ext_vector_type(2)));
#define DI __device__ __forceinline__
__device__ __forceinline__ int opaque_tid() { int t = threadIdx.x; asm volatile("" : "+v"(t)); return t; }
#define TID4 (tid_ & 255)
#define VBID ((int)(blockIdx.x * 2 + (tid_ >> 8)))
#define VGRID ((int)(gridDim.x * 2))

constexpr int D = 1024, S = 4096, NBATCH = 24, T = NBATCH * S;
constexpr int T_PROMPT = 8 * S;
constexpr int IN_TOTAL = 3232, NZ = 1280  , NIN = NZ + 2048;
constexpr int DFF = 2816, NUP = 2 * DFF;
constexpr float EPS = 1e-6f;
constexpr float LOG2E = 1.4426950408889634f;
constexpr int NCHUNK = 4, TCH = T / NCHUNK;

constexpr size_t MiB = 1024ull * 1024ull;
constexpr size_t O_WIN = 0;
constexpr size_t O_WUQ = O_WIN + (size_t)NIN * 1024 * 2;
constexpr size_t O_WUKV = O_WUQ + 768ull * 256 * 2;
constexpr size_t O_WOA = O_WUKV + 1024ull * 128 * 2;
constexpr size_t O_WOB = O_WOA + 1024ull * 512 * 2;
constexpr size_t O_WOUT = O_WOB + 1024ull * 512 * 2;
constexpr size_t O_WUP = O_WOUT + 1024ull * 1024 * 2;
constexpr size_t O_WDN = O_WUP + (size_t)NUP * 1024 * 2;
constexpr size_t O_MODP = O_WDN + 1024ull * DFF * 2;
constexpr size_t O_MOD = O_MODP + 16ull * 24 * 6144 * 4;
constexpr size_t O_ROPEA = O_MOD + 24ull * 6144 * 4;
constexpr size_t O_ROPEB = O_ROPEA + 4096ull * 32 * 8;
constexpr size_t O_ZROW = O_ROPEB + 4096ull * 16 * 8;
constexpr size_t O_WB_END = O_ZROW + 4096;
static_assert(O_WB_END <= 48 * MiB, "weights region");
constexpr size_t O_ZS = 48 * MiB;
constexpr size_t O_QA = 288 * MiB;
constexpr size_t O_KA = O_QA + 96 * MiB;
constexpr size_t O_VTA = O_KA + 24 * MiB;
constexpr size_t O_QB = O_VTA + 24 * MiB;
constexpr size_t O_KB = O_QB + 144 * MiB;
constexpr size_t O_VTB = O_KB + 144 * MiB;
constexpr size_t O_H = 816 * MiB;
constexpr size_t O_UP = 288 * MiB;
constexpr size_t O_ACT = 288 * MiB;
constexpr size_t WS_NEED = 1008 * MiB;
static_assert(O_VTB + 96 * MiB <= O_H, "qkv region");
constexpr size_t OO_G = 0, O_OA = O_H, O_OB = O_H + 96 * MiB;

struct Params {
    const float* in[25];
    float* out;
    unsigned char* ws;
};

typedef __bf16 bf16x2_t __attribute__((ext_vector_type(2)));
typedef float f32x2_t __attribute__((ext_vector_type(2)));
DI unsigned pk2(float lo, float hi) { const f32x2_t v = {lo, hi}; return __builtin_bit_cast(unsigned, __builtin_convertvector(v, bf16x2_t)); }
DI float bflo(unsigned u) { return __uint_as_float(u << 16); }
DI float bfhi(unsigned u) { return __uint_as_float(u & 0xffff0000u); }
DI float bf2f(bf16_t v) { return __uint_as_float(((unsigned)v) << 16); }
DI bf16_t f2bf(float v) { return (bf16_t)(pk2(v, v) & 0xffffu); }
DI void unpack8(const u32x4 v, float (&f)[8]) {
    f[0] = bflo(v.x); f[1] = bfhi(v.x); f[2] = bflo(v.y); f[3] = bfhi(v.y); f[4] = bflo(v.z); f[5] = bfhi(v.z); f[6] = bflo(v.w); f[7] = bfhi(v.w);
}
DI float fast_rcp(float x) { return __builtin_amdgcn_rcpf(x); }
DI float fast_exp2(float x) { return __builtin_amdgcn_exp2f(x); }
DI float sigmoidf_(float v) { return fast_rcp(1.f + fast_exp2(-v * LOG2E)); }
DI float xor_reduce_g(float v) { v += __shfl_xor(v, 16); v += __shfl_xor(v, 32); return v; }
DI float wave_sum(float v) {
#pragma unroll
    for (int o = 1; o < 64; o <<= 1) v += __shfl_xor(v, o);
    return v;
}
DI int perm32(int s) { const int lo = s & 31; return (s & ~31) | (((lo >> 2) & 3) << 3) | ((lo >> 4) << 2) | (lo & 3); }
DI const float* xrow_ptr(const Params& p, int t) { return t < T_PROMPT ? p.in[0] + (size_t)t * D : p.in[1] + (size_t)(t - T_PROMPT) * D; }

DI void tile_map(int L, int nN, int ntiles, int& pm, int& pn) {
    const int xcd = L & 7, q = L >> 3;
    const int Lp = xcd * (ntiles >> 3) + q;
    const int grp = Lp / (8 * nN), rem = Lp % (8 * nN);
    pm = grp * 8 + (rem & 7); pn = rem >> 3;
}

#define LAS __attribute__((address_space(3)))
#define GAS __attribute__((address_space(1)))
template <int BM, int BN, int NWM, int NWN>
DI void gemm_mainloop_p(f32x4 (&acc)[BM / NWM / 16][BN / NWN / 16], const bf16_t* const (&Ar)[BM / (NWM * NWN * 8)],
                        const bf16_t* __restrict__ B, int ldb, int K, char* lds, const int tid) {
    constexpr int RPR = NWM * NWN * 8;
    constexpr int MT = BM / NWM / 16, NT = BN / NWN / 16, NA = BM / RPR, NB = BN / RPR, STAGE = (BM + BN) * 128, RB = RPR * 128;
    const int lane = tid & 63, wave = tid >> 6;
    const int wm = wave / NWN, wn = wave % NWN;
    const int r = lane & 15, g = lane >> 4;
    const int lr = tid >> 3, lc = tid & 7;
    const int csrc = (lc ^ ((lr >> 1) & 7)) * 8;
    const bf16_t* Bp = B + (size_t)lr * ldb + csrc;
    const int nk = K >> 6;
    auto issue = [&](int kt, int st) {
        char* d = lds + st * STAGE + tid * 16;
#pragma unroll
        for (int i = 0; i < NA; ++i)
            __builtin_amdgcn_global_load_lds((const GAS unsigned*)(Ar[i] + kt * 64), (LAS unsigned*)(d + i * RB), 16, 0, 0);
#pragma unroll
        for (int i = 0; i < NB; ++i)
            __builtin_amdgcn_global_load_lds((const GAS unsigned*)(Bp + (size_t)(RPR * i) * ldb + kt * 64), (LAS unsigned*)(d + BM * 128 + i * RB), 16, 0, 0);
    };
    issue(0, 0);
    __syncthreads();
    const int rsw = (r >> 1) & 7;
    for (int kt = 0; kt < nk; ++kt) {
        const int cur = kt & 1;
        if (kt + 1 < nk) issue(kt + 1, cur ^ 1);
        const char* sA = lds + cur * STAGE;
        const char* sB = sA + BM * 128;
#pragma unroll
        for (int ks = 0; ks < 2; ++ks) {
            bf16x8 wf[NT], xf[MT];
            const int co = ((ks * 4 + g) ^ rsw) * 16;
#pragma unroll
            for (int nt = 0; nt < NT; ++nt) wf[nt] = *(const bf16x8*)(sB + (wn * (NT * 16) + nt * 16 + r) * 128 + co);
#pragma unroll
            for (int mt = 0; mt < MT; ++mt) xf[mt] = *(const bf16x8*)(sA + (wm * (MT * 16) + mt * 16 + r) * 128 + co);
#pragma unroll
            for (int mt = 0; mt < MT; ++mt)
#pragma unroll
                for (int nt = 0; nt < NT; ++nt) acc[mt][nt] = __builtin_amdgcn_mfma_f32_16x16x32_bf16(wf[nt], xf[mt], acc[mt][nt], 0, 0, 0);
        }
        __syncthreads();
    }
}

template <int BM, int BN, int NWM, int NWN>
DI void gemm_mainloop(f32x4 (&acc)[BM / NWM / 16][BN / NWN / 16], const bf16_t* __restrict__ A, int lda,
                      const bf16_t* __restrict__ B, int ldb, int K, char* lds, const int tid) {
    constexpr int RPR = NWM * NWN * 8;
    const int lr = tid >> 3, lc = tid & 7;
    const bf16_t* Ar[BM / RPR];
#pragma unroll
    for (int i = 0; i < BM / RPR; ++i) Ar[i] = A + (size_t)(lr + RPR * i) * lda + (lc ^ ((lr >> 1) & 7)) * 8;
    gemm_mainloop_p<BM, BN, NWM, NWN>(acc, Ar, B, ldb, K, lds, tid);
}

template <int MT, int NT>
DI void zero_acc(f32x4 (&acc)[MT][NT]) {
#pragma unroll
    for (int i = 0; i < MT; ++i)
#pragma unroll
        for (int j = 0; j < NT; ++j) acc[i][j] = (f32x4){0.f, 0.f, 0.f, 0.f};
}

namespace pg8 {
#define PG8_LAS __attribute__((address_space(3)))
constexpr int BM = 256, BK = 64, HALF = 128, HTB = HALF * BK * 2, STAGE_BYTES = 8 * HTB, NXCD = 8, WGM = 8;
__host__ __device__ __forceinline__ int lds_byte(int r, int c) { const int st = (r >> 4) * 2 + (c >> 5), rr = r & 15, cc = c & 31, ob = rr * 64 + cc * 2; return st * 1024 + (ob ^ (((ob >> 9) & 1) << 5)); }
__host__ __device__ __forceinline__ void stage_rc(int b, int& R, int& C) { const int st = b / 1024, sb = b % 1024, swz = sb ^ (((sb >> 9) & 1) << 5); R = (st >> 1) * 16 + swz / 64; C = (st & 1) * 32 + (swz % 64) / 2; }
__host__ __device__ __forceinline__ int perm32(int rho) { const int n = rho >> 4, i = rho & 15; return 8 * (i >> 2) + 4 * n + (i & 3); }
struct Unit { int pm, pn; };
struct Gemm { const bf16_t* A; const bf16_t* Bt; int M, N, K; };
struct StaticOrder {
    int nM, nN, nwg, G, c;
    __host__ __device__ void init(int M, int N, int G_, int c_) { nM = M / BM; nN = N / BM; nwg = nM * nN; G = G_; c = c_; }
    __host__ __device__ bool next(int i, Unit& u) const {
        const long L = (long)i * G + c; if (L >= nwg) return false;
        int wgid = (int)L; { const int q = nwg / NXCD, r = nwg % NXCD, xcd = wgid % NXCD, off = wgid / NXCD; wgid = (xcd < r ? xcd * (q + 1) : r * (q + 1) + (xcd - r) * q) + off; }
        const int nig = WGM * nN, gid = wgid / nig, fm = gid * WGM, gsz = (nM - fm) < WGM ? (nM - fm) : WGM;
        u.pm = fm + ((wgid % nig) % gsz); u.pn = (wgid % nig) / gsz; return true;
    }
    __device__ __forceinline__ void a_ready(const Unit&) const {}
    __device__ __forceinline__ void done(const Unit&) const {}
};
template <class Epi, class Sched, bool STAMP = false>
__device__ __forceinline__ void gemm_phase(PG8_LAS unsigned char* lds, const Gemm g, const Sched& S, const Epi& E, unsigned long long* stamps) {
    const int tid = opaque_tid(), wid = __builtin_amdgcn_readfirstlane(tid >> 6), lane = tid & 63, wr = wid >> 2, wc = wid & 3, fr = lane & 15, fq = lane >> 4;
    const int K = g.K, nt = K / BK;
    int ts_lo = 0, ts_hi = 0, nts = 0; const unsigned long long rt_entry = STAMP ? (unsigned long long)wall_clock64() : 0ull;
#define PG8_STAMP() do { if (STAMP && wid == 0 && nts < 64) { const unsigned long long _c = (unsigned long long)clock64(); \
        ts_lo = (lane == nts) ? (int)(unsigned)_c : ts_lo; ts_hi = (lane == nts) ? (int)(unsigned)(_c >> 32) : ts_hi; ++nts; } } while (0)
    PG8_STAMP();
    unsigned voffA[2], voffB[2];
#pragma unroll
    for (int i = 0; i < 2; ++i) { int R, C; stage_rc(tid * 16 + i * 8192, R, C); const int Rb = Epi::PERM ? ((R & ~31) + perm32(R & 31)) : R;
        voffA[i] = (unsigned)(R * K + C) * 2u; voffB[i] = (unsigned)(Rb * K + C) * 2u; }
    const size_t kstep = (size_t)(BK * 2);
    const size_t hstep = (size_t)HALF * K * 2;
    const size_t tstep = 2 * hstep;
    const unsigned ldsw = (unsigned)wid * 1024u;
    const int aoff = lds_byte(wr * 64 + fr, fq * 8), boff = lds_byte(wc * 32 + fr, fq * 8);
#define PG8_SA(b, h) (((b) * 2 + (h)) * HTB)
#define PG8_SB(b, h) ((4 + (b) * 2 + (h)) * HTB)
#define PG8_STAGE(bufoff, gbase, voff) do { _Pragma("unroll") for (int _i = 0; _i < 2; ++_i) \
        __builtin_amdgcn_global_load_lds((const unsigned*)((const char*)(gbase) + (voff)[_i]), (PG8_LAS unsigned*)(lds + (bufoff) + ldsw + _i * 8192), 16, 0, 0); } while (0)
#define PG8_LDA(dst, b, h) do { _Pragma("unroll") for (int m = 0; m < 4; ++m) _Pragma("unroll") for (int k = 0; k < 2; ++k) dst[m][k] = *(const PG8_LAS bf16x8*)(lds + PG8_SA(b, h) + aoff + m * 2048 + k * 1024); } while (0)
#define PG8_LDB(dst, b, h) do { _Pragma("unroll") for (int n = 0; n < 2; ++n) _Pragma("unroll") for (int k = 0; k < 2; ++k) dst[n][k] = *(const PG8_LAS bf16x8*)(lds + PG8_SB(b, h) + boff + n * 2048 + k * 1024); } while (0)
#define PG8_MMA(ai, bj, At, Bt) do { __builtin_amdgcn_s_setprio(1); _Pragma("unroll") for (int m = 0; m < 4; ++m) _Pragma("unroll") for (int n = 0; n < 2; ++n) _Pragma("unroll") for (int k = 0; k < 2; ++k) \
        acc[ai][bj][m][n] = __builtin_amdgcn_mfma_f32_16x16x32_bf16(Bt[n][k], At[m][k], acc[ai][bj][m][n], 0, 0, 0); __builtin_amdgcn_s_setprio(0); } while (0)
#define PG8_WAIT_V(n) asm volatile("s_waitcnt vmcnt(" #n ")" ::: "memory")
#define PG8_WAIT_L(n) asm volatile("s_waitcnt lgkmcnt(" #n ")" ::: "memory")
#define PG8_BAR __builtin_amdgcn_s_barrier()
#define PG8_SCHED __builtin_amdgcn_sched_barrier(0)
    Unit cur, nxt; int ui = 0;
    if (!S.next(0, cur)) return;
    f32x4 acc[2][2][4][2];
#pragma unroll
    for (int a = 0; a < 2; ++a)
#pragma unroll
        for (int b = 0; b < 2; ++b)
#pragma unroll
            for (int m = 0; m < 4; ++m)
#pragma unroll
                for (int n = 0; n < 2; ++n) acc[a][b][m][n] = (f32x4){0.f, 0.f, 0.f, 0.f};
    bf16x8 At[4][2], B0[2][2], B1[2][2];
    const char* cA = (const char*)g.A + (size_t)cur.pm * tstep; const char* cB = (const char*)g.Bt + (size_t)cur.pn * tstep;
    S.a_ready(cur);
    PG8_STAGE(PG8_SB(0, 0), cB, voffB); PG8_STAGE(PG8_SA(0, 0), cA, voffA); PG8_STAGE(PG8_SB(0, 1), cB + hstep, voffB); PG8_STAGE(PG8_SA(0, 1), cA + hstep, voffA);
    if (wr == 1) PG8_BAR;
    PG8_WAIT_V(4); PG8_BAR;
    PG8_STAGE(PG8_SB(1, 0), cB + kstep, voffB); PG8_STAGE(PG8_SA(1, 0), cA + kstep, voffA); PG8_STAGE(PG8_SB(1, 1), cB + hstep + kstep, voffB);
    PG8_WAIT_V(6); PG8_BAR;
    PG8_STAMP();
    for (;;) {
        const bool has_next = S.next(ui + 1, nxt);
        const char* nA = has_next ? (const char*)g.A + (size_t)nxt.pm * tstep : cA; const char* nB = has_next ? (const char*)g.Bt + (size_t)nxt.pn * tstep : cB;
        for (int t = 0; t < nt; t += 2) {
            const bool last = (t == nt - 2);
            const char* a1 = cA + (size_t)(t + 1) * kstep;
            const char* a2 = last ? nA : cA + (size_t)(t + 2) * kstep; const char* b2 = last ? nB : cB + (size_t)(t + 2) * kstep;
            const char* a3 = a2 + kstep; const char* b3 = b2 + kstep;
            if (last && has_next) S.a_ready(nxt);
            PG8_LDB(B0, 0, 0); PG8_SCHED; PG8_LDA(At, 0, 0); PG8_STAGE(PG8_SA(1, 1), a1 + hstep, voffA);
            PG8_WAIT_L(8); PG8_BAR; PG8_WAIT_L(0); PG8_MMA(0, 0, At, B0); PG8_BAR; PG8_SCHED;
            PG8_LDB(B1, 0, 1); PG8_STAGE(PG8_SB(0, 0), b2, voffB);
            PG8_BAR; PG8_WAIT_L(0); PG8_MMA(0, 1, At, B1); PG8_BAR;
            PG8_LDA(At, 0, 1); PG8_STAGE(PG8_SA(0, 0), a2, voffA);
            PG8_BAR; PG8_WAIT_L(0); PG8_MMA(1, 0, At, B0); PG8_BAR; PG8_SCHED;
            PG8_STAGE(PG8_SB(0, 1), b2 + hstep, voffB);
            PG8_WAIT_V(6); PG8_BAR; PG8_MMA(1, 1, At, B1); PG8_BAR;
            PG8_LDB(B0, 1, 0); PG8_SCHED; PG8_LDA(At, 1, 0); PG8_STAGE(PG8_SA(0, 1), a2 + hstep, voffA);
            PG8_WAIT_L(8); PG8_BAR; PG8_WAIT_L(0); PG8_MMA(0, 0, At, B0); PG8_BAR; PG8_SCHED;
            PG8_LDB(B1, 1, 1); PG8_STAGE(PG8_SB(1, 0), b3, voffB);
            PG8_BAR; PG8_WAIT_L(0); PG8_MMA(0, 1, At, B1); PG8_BAR;
            PG8_LDA(At, 1, 1); PG8_STAGE(PG8_SA(1, 0), a3, voffA);
            PG8_BAR; PG8_WAIT_L(0); PG8_MMA(1, 0, At, B0); PG8_BAR; PG8_SCHED;
            PG8_STAGE(PG8_SB(1, 1), b3 + hstep, voffB);
            PG8_WAIT_V(6); PG8_BAR; PG8_MMA(1, 1, At, B1); PG8_BAR;
        }
        PG8_STAMP();
        if constexpr (!Epi::AFTER_DRAIN) { E(acc, cur, wr, wc, fr, fq); S.done(cur); }
        PG8_STAMP();
        if (!has_next) break;
#pragma unroll
        for (int a = 0; a < 2; ++a)
#pragma unroll
            for (int b = 0; b < 2; ++b)
#pragma unroll
                for (int m = 0; m < 4; ++m)
#pragma unroll
                    for (int n = 0; n < 2; ++n) acc[a][b][m][n] = (f32x4){0.f, 0.f, 0.f, 0.f};
        cur = nxt; cA = nA; cB = nB; ++ui;
    }
    PG8_WAIT_V(0);
    if (wr == 0) PG8_BAR;
    PG8_BAR;
    if constexpr (Epi::AFTER_DRAIN) { E.fused(acc, cur, wr, wc, fr, fq, lds, wid, lane); S.done(cur); }
    PG8_STAMP();
    if (STAMP && wid == 0) { stamps[lane] = lane < nts ? (((unsigned long long)(unsigned)ts_hi << 32) | (unsigned)ts_lo) : 0ull;
        if (lane == 62) stamps[62] = rt_entry; if (lane == 63) stamps[63] = (unsigned long long)wall_clock64(); }
#undef PG8_STAMP
#undef PG8_SA
#undef PG8_SB
#undef PG8_STAGE
#undef PG8_LDA
#undef PG8_LDB
#undef PG8_MMA
#undef PG8_WAIT_V
#undef PG8_WAIT_L
#undef PG8_BAR
#undef PG8_SCHED
}
}


struct EpiP1 {
    static constexpr bool PERM = true, AFTER_DRAIN = false;
    bf16_t* ZS; bf16_t* G;
    DI void operator()(const f32x4 (&acc)[2][2][4][2], const pg8::Unit& u, int wr, int wc, int fr, int fq) const {
        const int row0 = u.pm * 256 + wr * 64 + fr, colt = u.pn * 256 + wc * 32 + 8 * fq;
        const bool small = u.pn < NZ / 256;
#pragma unroll
        for (int ai = 0; ai < 2; ++ai)
#pragma unroll
            for (int m = 0; m < 4; ++m) {
                const size_t row = (size_t)(row0 + ai * 128 + m * 16);
#pragma unroll
                for (int bj = 0; bj < 2; ++bj) {
                    const int col = colt + bj * 128;
                    const f32x4 v0 = acc[ai][bj][m][0], v1 = acc[ai][bj][m][1];
                    u32x4 w;
                    if (small) { w.x = pk2(v0.x, v0.y); w.y = pk2(v0.z, v0.w); w.z = pk2(v1.x, v1.y); w.w = pk2(v1.z, v1.w); *(u32x4*)(ZS + row * NZ + col) = w; }
                    else { w.x = pk2(sigmoidf_(v0.x), sigmoidf_(v0.y)); w.y = pk2(sigmoidf_(v0.z), sigmoidf_(v0.w)); w.z = pk2(sigmoidf_(v1.x), sigmoidf_(v1.y)); w.w = pk2(sigmoidf_(v1.z), sigmoidf_(v1.w));
                           *(u32x4*)(G + row * 2048 + (col - NZ)) = w; }
                }
            }
    }
};
template <bool SECOND> struct EpiMix {
    static constexpr bool PERM = true, AFTER_DRAIN = false;
    const bf16_t* G; bf16_t* MIX;
    DI void operator()(const f32x4 (&acc)[2][2][4][2], const pg8::Unit& u, int wr, int wc, int fr, int fq) const {
        const int row0 = u.pm * 256 + wr * 64 + fr, colt = u.pn * 256 + wc * 32 + 8 * fq;
#pragma unroll
        for (int ai = 0; ai < 2; ++ai)
#pragma unroll
            for (int m = 0; m < 4; ++m) {
                const size_t row = (size_t)(row0 + ai * 128 + m * 16);
#pragma unroll
                for (int bj = 0; bj < 2; ++bj) {
                    const int col = colt + bj * 128;
                    float gv[8], o[8];
                    unpack8(*(const u32x4*)(G + row * 2048 + (SECOND ? 1024 : 0) + col), gv);
                    const f32x4 v0 = acc[ai][bj][m][0], v1 = acc[ai][bj][m][1];
                    if (SECOND) unpack8(*(const u32x4*)(MIX + row * 1024 + col), o);
                    else { for (int e = 0; e < 8; ++e) o[e] = 0.f; }
                    o[0] += gv[0] * v0.x; o[1] += gv[1] * v0.y; o[2] += gv[2] * v0.z; o[3] += gv[3] * v0.w;
                    o[4] += gv[4] * v1.x; o[5] += gv[5] * v1.y; o[6] += gv[6] * v1.z; o[7] += gv[7] * v1.w;
                    u32x4 w; w.x = pk2(o[0], o[1]); w.y = pk2(o[2], o[3]); w.z = pk2(o[4], o[5]); w.w = pk2(o[6], o[7]);
                    *(u32x4*)(MIX + row * 1024 + col) = w;
                }
            }
    }
};
template <bool INPLACE> struct EpiRes {
    static constexpr bool PERM = false, AFTER_DRAIN = false;
    const float* xp; const float* xs; float* out; const float* gate;
    DI void operator()(const f32x4 (&acc)[2][2][4][2], const pg8::Unit& u, int wr, int wc, int fr, int fq) const {
        const int row0 = u.pm * 256 + wr * 64 + fr, colt = u.pn * 256 + wc * 32 + 4 * fq;
        const float* gt = gate + (size_t)((u.pm * 256) >> 12) * 6144;
#pragma unroll
        for (int ai = 0; ai < 2; ++ai)
#pragma unroll
            for (int m = 0; m < 4; ++m) {
                const int row = row0 + ai * 128 + m * 16;
                float* orow = out + (size_t)row * D;
                const float* brow = INPLACE ? orow : (row < T_PROMPT ? xp + (size_t)row * D : xs + (size_t)(row - T_PROMPT) * D);
#pragma unroll
                for (int bj = 0; bj < 2; ++bj)
#pragma unroll
                    for (int n = 0; n < 2; ++n) {
                        const int col = colt + bj * 128 + n * 16;
                        const f32x4 xv = *(const f32x4*)(brow + col), gv = *(const f32x4*)(gt + col);
                        *(f32x4*)(orow + col) = xv + gv * acc[ai][bj][m][n];
                    }
            }
    }
};

DI void transpose_item(const float* __restrict__ W, int K, int N, bf16_t* __restrict__ WT, int mode, const float* __restrict__ scale,
                       float* scr, int item, int lane) {
    const int nblk = N >> 5, kb = item / nblk, nb = item % nblk, k0 = kb * 64, n0 = nb * 32;
#pragma unroll 8
    for (int i = 0; i < 32; ++i) {
        const int kk = 2 * i + (lane >> 5);
        float v = W[(size_t)(k0 + kk) * N + n0 + (lane & 31)];
        if (scale) v *= scale[k0 + kk];
        scr[kk * 33 + (lane & 31)] = v;
    }
    asm volatile("s_waitcnt lgkmcnt(0)" ::: "memory");
    const int c = lane & 7;
#pragma unroll
    for (int j = 0; j < 4; ++j) {
        const int nl = (lane >> 3) + 8 * j;
        const float* s = scr + (8 * c) * 33 + nl;
        u32x4 o;
        o.x = pk2(s[0 * 33], s[1 * 33]); o.y = pk2(s[2 * 33], s[3 * 33]); o.z = pk2(s[4 * 33], s[5 * 33]); o.w = pk2(s[6 * 33], s[7 * 33]);
        const int n = n0 + nl;
        int row;
        if (mode == 1) row = n < 1184 ? n : n + 96;
        else if (mode == 2) { const int h = n >> 7, jj = n & 127; row = jj < 64 ? h * 64 + jj : 512 + h * 64 + (jj - 64); }
        else if (mode == 3) { const int hf = n >= DFF ? 1 : 0, m2 = n - hf * DFF; row = (m2 >> 7) * 256 + hf * 128 + (m2 & 127); }
        else row = n;
        *(u32x4*)(WT + (size_t)row * K + k0 + 8 * c) = o;
    }
    asm volatile("s_waitcnt lgkmcnt(0)" ::: "memory");
}

DI void phase0(const Params& p, char* lds) {
    const int tid_ = opaque_tid();
    const int tid = TID4, bid = VBID, G = VGRID, lane = tid & 63, wave = tid >> 6;
    unsigned char* ws = p.ws;
    float* sc = (float*)lds;
    for (int it = bid; it < 384; it += G) {
        const int cb = it % 24, ks = it / 24;
        __syncthreads();
        for (int i = tid; i < 24 * 64; i += 256) {
            const int b = i >> 6, k = i & 63;
            const float* c = b < 8 ? p.in[2] + b * 1024 : p.in[3] + (b - 8) * 1024;
            const float v = c[ks * 64 + k];
            sc[i] = v * sigmoidf_(v);
        }
        __syncthreads();
        float a[24];
#pragma unroll
        for (int b = 0; b < 24; ++b) a[b] = 0.f;
        const int n = cb * 256 + tid;
        const float* w = p.in[4] + (size_t)(ks * 64) * 6144 + n;
        for (int k = 0; k < 64; ++k) {
            const float wv = w[(size_t)k * 6144];
#pragma unroll
            for (int b = 0; b < 24; ++b) a[b] += sc[b * 64 + k] * wv;
        }
        float* mp = (float*)(ws + O_MODP) + (size_t)(ks * 24) * 6144 + n;
#pragma unroll
        for (int b = 0; b < 24; ++b) mp[(size_t)b * 6144] = a[b];
    }
    __syncthreads();
    {
        float* scr = (float*)(lds + wave * 8448);
        const int gw = bid * 4 + wave, NGW = G * 4;
        constexpr int I0 = 16 * 101, I1 = 4 * 24, I2 = 2 * 32, I3 = 8 * 32, I4 = 8 * 32, I5 = 16 * 32, I6 = 16 * 176, I7 = 44 * 32;
        constexpr int NI = I0 + I1 + I2 + I3 + I4 + I5 + I6 + I7;
        for (int it = gw; it < NI; it += NGW) {
            int q = it;
            if (q < I0) { transpose_item(p.in[7], 1024, IN_TOTAL, (bf16_t*)(ws + O_WIN), 1, nullptr, scr, q, lane); continue; } q -= I0;
            if (q < I1) { transpose_item(p.in[12], 256, 768, (bf16_t*)(ws + O_WUQ), 0, p.in[11], scr, q, lane); continue; } q -= I1;
            if (q < I2) { transpose_item(p.in[14], 128, 1024, (bf16_t*)(ws + O_WUKV), 2, p.in[13], scr, q, lane); continue; } q -= I2;
            if (q < I3) { transpose_item(p.in[17], 512, 1024, (bf16_t*)(ws + O_WOA), 0, nullptr, scr, q, lane); continue; } q -= I3;
            if (q < I4) { transpose_item(p.in[18], 512, 1024, (bf16_t*)(ws + O_WOB), 0, nullptr, scr, q, lane); continue; } q -= I4;
            if (q < I5) { transpose_item(p.in[19], 1024, 1024, (bf16_t*)(ws + O_WOUT), 0, nullptr, scr, q, lane); continue; } q -= I5;
            if (q < I6) { transpose_item(p.in[21], 1024, NUP, (bf16_t*)(ws + O_WUP), 3, nullptr, scr, q, lane); continue; } q -= I6;
            transpose_item(p.in[24], DFF, 1024, (bf16_t*)(ws + O_WDN), 0, nullptr, scr, q, lane);
        }
    }
    const int gt = bid * 256 + tid, NGT = G * 256;
    for (int i = gt; i < 4096 * 48; i += NGT) {
        const int pos = i / 48, j = i % 48;
        float inv;
        if (j < 32) inv = exp2f(-(float)(2 * j) * (1.f / 64.f) * 13.287712379549449f);
        else inv = exp2f(-(float)(2 * (j - 32)) * (1.f / 32.f) * 13.287712379549449f);
        const float ang = (float)pos * inv;
        float rev = ang * 0.15915494309189535f;
        rev -= floorf(rev);
        const float sn = __builtin_amdgcn_sinf(rev), cs = __builtin_amdgcn_cosf(rev);
        float2* dst = j < 32 ? (float2*)(ws + O_ROPEA) + pos * 32 + j : (float2*)(ws + O_ROPEB) + pos * 16 + (j - 32);
        *dst = make_float2(cs, sn);
    }
    for (int i = gt; i < 96 * 1024 / 8; i += NGT) *(u32x4*)((bf16_t*)(ws + O_WIN) + 1184 * 1024 + (size_t)i * 8) = (u32x4){0u, 0u, 0u, 0u};
    if (gt < 256) *(u32x4*)(ws + O_ZROW + gt * 16) = (u32x4){0u, 0u, 0u, 0u};
}

DI void phase0m(const Params& p) {
    const int tid_ = opaque_tid();
    const int gt = VBID * 256 + TID4, NGT = VGRID * 256;
    const float* mp = (const float*)(p.ws + O_MODP);
    float* mod = (float*)(p.ws + O_MOD);
    for (int i = gt; i < 24 * 6144; i += NGT) {
        float s = p.in[5][i % 6144];
#pragma unroll
        for (int ks = 0; ks < 16; ++ks) s += mp[(size_t)ks * 24 * 6144 + i];
        mod[i] = s;
    }
}

DI void norm_pass(const Params& p, bool second, bf16_t* dst) {
    const int tid_ = opaque_tid();
    const int lane = TID4 & 63, gw = VBID * 4 + (TID4 >> 6), NGW = VGRID * 4;
    const float* gwt = second ? p.in[20] : p.in[6];
    const float* mod = (const float*)(p.ws + O_MOD);
    f32x4 gv[4];
#pragma unroll
    for (int j = 0; j < 4; ++j) gv[j] = *((const f32x4*)gwt + 64 * j + lane);
    for (int t = gw; t < T; t += NGW) {
        const float* xr = second ? p.out + (size_t)t * D : xrow_ptr(p, t);
        const int b = t >> 12;
        const float* sh = mod + (size_t)b * 6144 + (second ? 3072 : 0);
        const float* sc = sh + 1024;
        f32x4 v[4]; float s = 0.f;
#pragma unroll
        for (int j = 0; j < 4; ++j) { v[j] = *((const f32x4*)xr + 64 * j + lane); s += (v[j].x * v[j].x + v[j].y * v[j].y) + (v[j].z * v[j].z + v[j].w * v[j].w); }
        const float rstd = rsqrtf(wave_sum(s) * (1.f / D) + EPS);
        u32x2* o = (u32x2*)(dst + (size_t)t * D) + lane;
#pragma unroll
        for (int j = 0; j < 4; ++j) {
            const f32x4 scv = *((const f32x4*)sc + 64 * j + lane), shv = *((const f32x4*)sh + 64 * j + lane);
            f32x4 y;
            y.x = v[j].x * rstd * gv[j].x * (1.f + scv.x) + shv.x; y.y = v[j].y * rstd * gv[j].y * (1.f + scv.y) + shv.y;
            y.z = v[j].z * rstd * gv[j].z * (1.f + scv.z) + shv.z; y.w = v[j].w * rstd * gv[j].w * (1.f + scv.w) + shv.w;
            o[64 * j] = (u32x2){pk2(y.x, y.y), pk2(y.z, y.w)};
        }
    }
}

DI void phase1(const Params& p, char* lds) {
    pg8::Gemm g{(const bf16_t*)(p.ws + O_H), (const bf16_t*)(p.ws + O_WIN), T, NIN, 1024};
    pg8::StaticOrder so; so.init(T, NIN, gridDim.x, blockIdx.x);
    EpiP1 E{(bf16_t*)(p.ws + O_ZS), (bf16_t*)((unsigned char*)p.out + OO_G)};
    pg8::gemm_phase<EpiP1, pg8::StaticOrder, false>((PG8_LAS unsigned char*)lds, g, so, E, nullptr);
}

template <int NCH>
DI float row_sumsq(const bf16_t* rowp, int g) {
    float s = 0.f;
#pragma unroll
    for (int c = 0; c < NCH; ++c) {
        const u32x4 v = *(const u32x4*)(rowp + (g * NCH + c) * 8);
#pragma unroll
        for (int e = 0; e < 4; ++e) { const float a = bflo(v[e]), b = bfhi(v[e]); s += a * a + b * b; }
    }
    return xor_reduce_g(s);
}

DI void phase2(const Params& p, char* lds) {
    const int tid_ = opaque_tid();
    unsigned char* ws = p.ws;
    const bf16_t* ZS = (const bf16_t*)(ws + O_ZS);
    const int tid = TID4, lane = tid & 63, wave = tid >> 6, r = lane & 15, g = lane >> 4;
    const float2* ropeA = (const float2*)(ws + O_ROPEA);
    const float2* ropeB = (const float2*)(ws + O_ROPEB);
    constexpr int NTL = T / 128;
    for (int it = VBID; it < NTL * 8; it += VGRID) {
        const int tile = it >> 3, sub = it & 7, t0 = tile * 128, b = t0 >> 12, s0 = t0 & (S - 1);
        {
            const int h = sub;
            f32x4 acc[2][6]; zero_acc(acc);
            gemm_mainloop<128, 96, 4, 1>(acc, ZS + (size_t)t0 * NZ + 768, NZ, (const bf16_t*)(ws + O_WUQ) + (size_t)h * 96 * 256, 256, 256, lds, tid);
            const float* gq = p.in[15];
            const float qs = 0.10206207261596577f * LOG2E;
            bf16_t* QB = (bf16_t*)(ws + O_QB) + ((size_t)(b * 8 + h) * S) * 96;
#pragma unroll
            for (int mt = 0; mt < 2; ++mt) {
                const int ml = wave * 32 + mt * 16 + r, sp = s0 + ml;
                const float rstd = rsqrtf(row_sumsq<8>(ZS + (size_t)(t0 + ml) * NZ + 768, g) * (1.f / 256.f) + EPS);
                float ss = 0.f;
#pragma unroll
                for (int nt = 0; nt < 6; ++nt) { acc[mt][nt] = acc[mt][nt] * rstd; const f32x4 a = acc[mt][nt]; ss += (a.x * a.x + a.y * a.y) + (a.z * a.z + a.w * a.w); }
                const float r2 = rsqrtf(xor_reduce_g(ss) * (1.f / 96.f) + EPS);
#pragma unroll
                for (int nt = 0; nt < 6; ++nt) {
                    const f32x4 gg = *(const f32x4*)(gq + nt * 16 + g * 4);
                    acc[mt][nt] = acc[mt][nt] * r2 * gg;
                }
#pragma unroll
                for (int j = 0; j < 4; ++j) {
                    const float2 cs = ropeB[sp * 16 + g * 4 + j];
                    const float x1 = acc[mt][4][j], x2 = acc[mt][5][j];
                    acc[mt][4][j] = x1 * cs.x - x2 * cs.y;
                    acc[mt][5][j] = x1 * cs.y + x2 * cs.x;
                }
                bf16_t* qrow = QB + (size_t)sp * 96 + g * 4;
#pragma unroll
                for (int nt = 0; nt < 6; ++nt) { const f32x4 a = acc[mt][nt] * qs; *(u32x2*)(qrow + nt * 16) = (u32x2){pk2(a.x, a.y), pk2(a.z, a.w)}; }
                __builtin_amdgcn_sched_barrier(0);
            }
        }
    }
    for (int it = VBID; it < NTL * 4; it += VGRID) {
        const int tile = it >> 2, hp = it & 3, t0 = tile * 128, b = t0 >> 12, s0 = t0 & (S - 1);
        {
            f32x4 acc[4][4]; zero_acc(acc);
            gemm_mainloop<128, 128, 2, 2>(acc, ZS + (size_t)t0 * NZ + 1024, NZ,
                                          (const bf16_t*)(ws + O_WUKV) + (size_t)(hp * 128) * 128, 128, 128, lds, tid);
            const int wm = wave >> 1, wn = wave & 1, h = hp * 2 + wn;
            {
                const float* gk = p.in[16];
                bf16_t* KB = (bf16_t*)(ws + O_KB) + ((size_t)(b * 8 + h) * S) * 96;
#pragma unroll
                for (int mt = 0; mt < 4; ++mt) {
                    const int ml = wm * 64 + mt * 16 + r, sp = s0 + ml;
                    const bf16_t* zrow = ZS + (size_t)(t0 + ml) * NZ;
                    const float rstd = rsqrtf(row_sumsq<4>(zrow + 1024, g) * (1.f / 128.f) + EPS);
                    const u32x2 k1 = *(const u32x2*)(zrow + 1152 + g * 4), k2 = *(const u32x2*)(zrow + 1168 + g * 4);
                    float x1[4] = {bflo(k1.x), bfhi(k1.x), bflo(k1.y), bfhi(k1.y)};
                    float x2[4] = {bflo(k2.x), bfhi(k2.x), bflo(k2.y), bfhi(k2.y)};
                    float ss = 0.f;
#pragma unroll
                    for (int j = 0; j < 4; ++j) ss += x1[j] * x1[j] + x2[j] * x2[j];
#pragma unroll
                    for (int nt = 0; nt < 4; ++nt) { acc[mt][nt] = acc[mt][nt] * rstd; const f32x4 a = acc[mt][nt]; ss += (a.x * a.x + a.y * a.y) + (a.z * a.z + a.w * a.w); }
                    const float r2 = rsqrtf(xor_reduce_g(ss) * (1.f / 96.f) + EPS);
                    bf16_t* krow = KB + (size_t)sp * 96 + g * 4;
#pragma unroll
                    for (int nt = 0; nt < 4; ++nt) {
                        const f32x4 gg = *(const f32x4*)(gk + nt * 16 + g * 4);
                        const f32x4 a = acc[mt][nt] * r2 * gg;
                        *(u32x2*)(krow + nt * 16) = (u32x2){pk2(a.x, a.y), pk2(a.z, a.w)};
                    }
                    const f32x4 g1 = *(const f32x4*)(gk + 64 + g * 4), g2 = *(const f32x4*)(gk + 80 + g * 4);
                    float o1[4], o2[4];
#pragma unroll
                    for (int j = 0; j < 4; ++j) {
                        const float2 cs = ropeB[sp * 16 + g * 4 + j];
                        const float y1 = x1[j] * r2 * g1[j], y2 = x2[j] * r2 * g2[j];
                        o1[j] = y1 * cs.x - y2 * cs.y; o2[j] = y1 * cs.y + y2 * cs.x;
                    }
                    *(u32x2*)(krow + 64) = (u32x2){pk2(o1[0], o1[1]), pk2(o1[2], o1[3])};
                    *(u32x2*)(krow + 80) = (u32x2){pk2(o2[0], o2[1]), pk2(o2[2], o2[3])};
                    __builtin_amdgcn_sched_barrier(0);
                }
            }
        }
    }
    for (int it = VBID; it < NTL * 4; it += VGRID) {
        const int tile = it >> 2, hp = it & 3, t0 = tile * 128, b = t0 >> 12, s0 = t0 & (S - 1);
        {
            f32x4 acc[4][4]; zero_acc(acc);
            gemm_mainloop<128, 128, 2, 2>(acc, ZS + (size_t)t0 * NZ + 1024, NZ,
                                          (const bf16_t*)(ws + O_WUKV) + (size_t)(512 + hp * 128) * 128, 128, 128, lds, tid);
            const int wm = wave >> 1, wn = wave & 1, h = hp * 2 + wn;
            {
                bf16_t* VT = (bf16_t*)(ws + O_VTB) + ((size_t)(b * 8 + h) * 64) * S;
#pragma unroll
                for (int mt = 0; mt < 4; ++mt) {
                    const int ml = wm * 64 + mt * 16 + r, sp = s0 + ml;
                    const float rstd = rsqrtf(row_sumsq<4>(ZS + (size_t)(t0 + ml) * NZ + 1024, g) * (1.f / 128.f) + EPS);
                    const int ps = perm32(sp);
#pragma unroll
                    for (int nt = 0; nt < 4; ++nt)
#pragma unroll
                        for (int j = 0; j < 4; ++j) VT[(size_t)(nt * 16 + g * 4 + j) * S + ps] = f2bf(acc[mt][nt][j] * rstd);
                    __builtin_amdgcn_sched_barrier(0);
                }
            }
        }
    }
    __syncthreads();
    for (int tile = VBID; tile < NTL; tile += VGRID) {
        const int t0 = tile * 128, b = t0 >> 12, s0 = t0 & (S - 1);
        {
            const float* gqa = p.in[8];
            const float* gka = p.in[9];
            const int half = lane >> 5, i = lane & 31;
            const float qs = 0.125f * LOG2E;
            const float gq1 = gqa[i], gq2 = gqa[32 + i], gk1 = gka[i], gk2 = gka[32 + i];
            for (int tt0 = wave * 4; tt0 < 128; tt0 += 16) {
                float x1[4][5], x2[4][5]; float2 cs[4];
#pragma unroll
                for (int u = 0; u < 4; ++u) {
                    const bf16_t* zrow = ZS + (size_t)(t0 + tt0 + u) * NZ;
                    cs[u] = ropeA[(s0 + tt0 + u) * 32 + i];
#pragma unroll
                    for (int q = 0; q < 5; ++q) { const int hd = 2 * q + half; x1[u][q] = bf2f(zrow[hd * 64 + i]); x2[u][q] = bf2f(zrow[hd * 64 + 32 + i]); }
                }
#pragma unroll
                for (int u = 0; u < 4; ++u) {
                    const int sp = s0 + tt0 + u;
#pragma unroll
                    for (int q = 0; q < 5; ++q) {
                        const int hd = 2 * q + half;
                        float ss = x1[u][q] * x1[u][q] + x2[u][q] * x2[u][q];
#pragma unroll
                        for (int o = 1; o < 32; o <<= 1) ss += __shfl_xor(ss, o);
                        const float rr = rsqrtf(ss * (1.f / 64.f) + EPS);
                        const bool isq = q < 4;
                        const float y1 = x1[u][q] * rr * (isq ? gq1 : gk1), y2 = x2[u][q] * rr * (isq ? gq2 : gk2);
                        float o1 = y1 * cs[u].x - y2 * cs[u].y, o2 = y1 * cs[u].y + y2 * cs[u].x;
                        bf16_t* dst;
                        if (isq) { o1 *= qs; o2 *= qs; dst = (bf16_t*)(ws + O_QA) + ((size_t)(b * 8 + hd) * S + sp) * 64; }
                        else dst = (bf16_t*)(ws + O_KA) + ((size_t)(b * 2 + (hd - 8)) * S + sp) * 64;
                        dst[i] = f2bf(o1); dst[32 + i] = f2bf(o2);
                    }
                }
            }
            __syncthreads();
            bf16_t* tl = (bf16_t*)lds;
            for (int idx = tid; idx < 128 * 16; idx += 256) {
                const int tt = idx >> 4, c = idx & 15;
                const u32x4 v = *(const u32x4*)(ZS + (size_t)(t0 + tt) * NZ + 640 + c * 8);
                u32x2* d2 = (u32x2*)(tl + tt * 132 + c * 8);
                d2[0] = (u32x2){v.x, v.y}; d2[1] = (u32x2){v.z, v.w};
            }
            __syncthreads();
            bf16_t* VT = (bf16_t*)(ws + O_VTA) + ((size_t)(b * 2) * 64) * S;
            for (int idx = tid; idx < 128 * 128; idx += 256) {
                const int pp = idx & 127, dd = idx >> 7;
                const int lo = pp & 31;
                const int tt = (pp & ~31) | (((lo >> 2) & 1) << 4) | ((lo >> 3) << 2) | (lo & 3);
                VT[(size_t)dd * S + s0 + pp] = tl[tt * 132 + dd];
            }
            __syncthreads();
        }
    }
}

template <int DQK, bool WIN>
DI void attn_item(const bf16_t* __restrict__ Qw, const bf16_t* __restrict__ Kb, const bf16_t* __restrict__ Vt, int key0, int ntiles, int q0,
                  float shift2, float sink_term, bf16_t* __restrict__ Ow, int ldo, char* lds, const int tid) {
    constexpr int KS = DQK / 32, CH = DQK / 8, KSTR = DQK * 2 + 32, NKL = (CH * 64 + 511) / 512, VSTR = 160, STAGE = 64 * 224 + 64 * VSTR;
    const int lane = tid & 63, r = lane & 15, g = lane >> 4;
    bf16x8 qf[2][KS];
#pragma unroll
    for (int qt = 0; qt < 2; ++qt)
#pragma unroll
        for (int ks = 0; ks < KS; ++ks) qf[qt][ks] = *(const bf16x8*)(Qw + (size_t)(qt * 16 + r) * DQK + ks * 32 + g * 8);
    f32x4 oacc[4][2];
#pragma unroll
    for (int i = 0; i < 4; ++i) { oacc[i][0] = (f32x4){0.f, 0.f, 0.f, 0.f}; oacc[i][1] = (f32x4){0.f, 0.f, 0.f, 0.f}; }
    float lsum[2] = {0.f, 0.f};
    u32x4 rk[NKL], rv;
    int krow[NKL], kc[NKL];
#pragma unroll
    for (int i = 0; i < NKL; ++i) { const int idx = tid + 512 * i; krow[i] = idx / CH; kc[i] = idx % CH; }
    const int vrow = tid >> 3, vc = tid & 7;
    auto gload = [&](int tile) {
        const int kb = key0 + tile * 64;
#pragma unroll
        for (int i = 0; i < NKL; ++i) if (tid + 512 * i < CH * 64) rk[i] = *(const u32x4*)(Kb + (size_t)(kb + krow[i]) * DQK + kc[i] * 8);
        rv = *(const u32x4*)(Vt + (size_t)vrow * S + kb + vc * 8);
    };
    auto lstore = [&](int st) {
        char* sK = lds + st * STAGE; char* sV = sK + 64 * 224;
#pragma unroll
        for (int i = 0; i < NKL; ++i) if (tid + 512 * i < CH * 64) *(u32x4*)(sK + krow[i] * KSTR + kc[i] * 16) = rk[i];
        *(u32x4*)(sV + vrow * VSTR + vc * 16) = rv;
    };
    const f32x4 sinit = (f32x4){-shift2, -shift2, -shift2, -shift2};
    __syncthreads();
    gload(0); lstore(0);
    __syncthreads();
    for (int tile = 0; tile < ntiles; ++tile) {
        const int cur = tile & 1;
        const bool more = tile + 1 < ntiles;
        if (more) gload(tile + 1);
        const char* sK = lds + cur * STAGE; const char* sV = sK + 64 * 224;
        f32x4 sacc[4][2];
#pragma unroll
        for (int kt = 0; kt < 4; ++kt) {
            sacc[kt][0] = sinit; sacc[kt][1] = sinit;
#pragma unroll
            for (int ks = 0; ks < KS; ++ks) {
                const bf16x8 kf = *(const bf16x8*)(sK + (kt * 16 + r) * KSTR + (ks * 4 + g) * 16);
                sacc[kt][0] = __builtin_amdgcn_mfma_f32_16x16x32_bf16(kf, qf[0][ks], sacc[kt][0], 0, 0, 0);
                sacc[kt][1] = __builtin_amdgcn_mfma_f32_16x16x32_bf16(kf, qf[1][ks], sacc[kt][1], 0, 0, 0);
            }
        }
        const int kbase = key0 + tile * 64 + g * 4;
#pragma unroll
        for (int kt = 0; kt < 4; ++kt)
#pragma unroll
            for (int qt = 0; qt < 2; ++qt)
#pragma unroll
                for (int j = 0; j < 4; ++j) {
                    float pv = fast_exp2(sacc[kt][qt][j]);
                    if (WIN) { const int dlt = (kbase + kt * 16 + j) - (q0 + qt * 16 + r); if (dlt > 128 || dlt < -128) pv = 0.f; }
                    sacc[kt][qt][j] = pv; lsum[qt] += pv;
                }
#pragma unroll
        for (int kk = 0; kk < 2; ++kk) {
            bf16x8 pb[2];
#pragma unroll
            for (int qt = 0; qt < 2; ++qt) {
                u32x4 u;
                u.x = pk2(sacc[2 * kk][qt][0], sacc[2 * kk][qt][1]); u.y = pk2(sacc[2 * kk][qt][2], sacc[2 * kk][qt][3]);
                u.z = pk2(sacc[2 * kk + 1][qt][0], sacc[2 * kk + 1][qt][1]); u.w = pk2(sacc[2 * kk + 1][qt][2], sacc[2 * kk + 1][qt][3]);
                pb[qt] = __builtin_bit_cast(bf16x8, u);
            }
#pragma unroll
            for (int dt = 0; dt < 4; ++dt) {
                const bf16x8 vf = *(const bf16x8*)(sV + (dt * 16 + r) * VSTR + (kk * 4 + g) * 16);
                oacc[dt][0] = __builtin_amdgcn_mfma_f32_16x16x32_bf16(vf, pb[0], oacc[dt][0], 0, 0, 0);
                oacc[dt][1] = __builtin_amdgcn_mfma_f32_16x16x32_bf16(vf, pb[1], oacc[dt][1], 0, 0, 0);
            }
        }
        if (more) lstore(cur ^ 1);
        __syncthreads();
    }
#pragma unroll
    for (int qt = 0; qt < 2; ++qt) {
        const float inv = fast_rcp(xor_reduce_g(lsum[qt]) + sink_term);
        bf16_t* orow = Ow + (size_t)(qt * 16 + r) * ldo + g * 4;
#pragma unroll
        for (int dt = 0; dt < 4; ++dt) { const f32x4 a = oacc[dt][qt] * inv; *(u32x2*)(orow + dt * 16) = (u32x2){pk2(a.x, a.y), pk2(a.z, a.w)}; }
    }
}

DI float max_abs(const float* v, int n) { float m = 0.f; for (int i = 0; i < n; ++i) m = fmaxf(m, fabsf(v[i])); return m; }

DI void phase3(const Params& p, char* lds) {
    unsigned char* ws = p.ws;
    const int tid = opaque_tid(), wave = tid >> 6;
    const float shiftB = 9.797958971132712f * max_abs(p.in[15], 96) * max_abs(p.in[16], 96) * LOG2E;
    const float shiftA = 8.f * max_abs(p.in[8], 64) * max_abs(p.in[9], 64) * LOG2E;
    bf16_t* OA = (bf16_t*)(p.ws + O_OA);
    bf16_t* OB = (bf16_t*)(p.ws + O_OB);
    constexpr int NB_ITEMS = 24 * 8 * 16, NA_ITEMS = 24 * 2 * 64;
    for (int L = blockIdx.x; L < NB_ITEMS; L += gridDim.x) {
        const int idx = (L & 7) * (NB_ITEMS / 8) + (L >> 3);
        const int bh = idx >> 4, qb = idx & 15, b = bh >> 3, h = bh & 7;
        const int q0 = qb * 256 + wave * 32;
        attn_item<96, false>((const bf16_t*)(ws + O_QB) + ((size_t)bh * S + q0) * 96, (const bf16_t*)(ws + O_KB) + (size_t)bh * S * 96,
                             (const bf16_t*)(ws + O_VTB) + (size_t)bh * 64 * S, 0, S / 64, q0, shiftB, 0.f,
                             OB + ((size_t)b * S + q0) * 512 + h * 64, 512, lds, tid);
    }
    for (int L = blockIdx.x; L < NA_ITEMS; L += gridDim.x) {
        const int idx = (L & 7) * (NA_ITEMS / 8) + (L >> 3);
        const int bk = idx >> 6, qb = idx & 63, b = bk >> 1, kvh = bk & 1;
        const int q0 = qb * 64 + (wave >> 2) * 32, hd = kvh * 4 + (wave & 3);
        int ks = qb * 64 - 128; if (ks < 0) ks = 0; if (ks > S - 320) ks = S - 320;
        const float sink_term = fast_exp2(p.in[10][hd] * LOG2E - shiftA);
        attn_item<64, true>((const bf16_t*)(ws + O_QA) + ((size_t)(b * 8 + hd) * S + q0) * 64, (const bf16_t*)(ws + O_KA) + (size_t)bk * S * 64,
                            (const bf16_t*)(ws + O_VTA) + (size_t)bk * 64 * S, ks, 5, q0, shiftA, sink_term,
                            OA + ((size_t)b * S + q0) * 512 + hd * 64, 512, lds, tid);
    }
}

DI void phase4(const Params& p, char* lds) {
    const bf16_t* Gt = (const bf16_t*)((unsigned char*)p.out + OO_G);
    bf16_t* MIX = (bf16_t*)(p.ws + O_ZS);
    pg8::StaticOrder so; so.init(T, 1024, gridDim.x, blockIdx.x);
    {
        pg8::Gemm g{(const bf16_t*)(p.ws + O_OA), (const bf16_t*)(p.ws + O_WOA), T, 1024, 512};
        EpiMix<false> E{Gt, MIX};
        pg8::gemm_phase<EpiMix<false>, pg8::StaticOrder, false>((PG8_LAS unsigned char*)lds, g, so, E, nullptr);
    }
    {
        pg8::Gemm g{(const bf16_t*)(p.ws + O_OB), (const bf16_t*)(p.ws + O_WOB), T, 1024, 512};
        EpiMix<true> E{Gt, MIX};
        pg8::gemm_phase<EpiMix<true>, pg8::StaticOrder, false>((PG8_LAS unsigned char*)lds, g, so, E, nullptr);
    }
}

DI void phase5(const Params& p, char* lds) {
    pg8::Gemm g{(const bf16_t*)(p.ws + O_ZS), (const bf16_t*)(p.ws + O_WOUT), T, 1024, 1024};
    pg8::StaticOrder so; so.init(T, 1024, gridDim.x, blockIdx.x);
    EpiRes<false> E{p.in[0], p.in[1], p.out, (const float*)(p.ws + O_MOD) + 2048};
    pg8::gemm_phase<EpiRes<false>, pg8::StaticOrder, false>((PG8_LAS unsigned char*)lds, g, so, E, nullptr);
}

DI void phase7(const Params& p, char* lds) {
    const bf16_t* H2 = (const bf16_t*)(p.ws + O_H);
    const bf16_t* ZR = (const bf16_t*)(p.ws + O_ZROW);
    bf16_t* ACT = (bf16_t*)(p.ws + O_ACT);
    const float* cw = p.in[22];
    const float* cb = p.in[23];
    constexpr int TPS = 33, nM = NBATCH * TPS, nN = DFF / 128, NTILES = nM * nN, ROWB = 528;
    const int tid = opaque_tid(), lane = tid & 63, wave = tid >> 6, wm = wave >> 2, wn = wave & 3, r = lane & 15, g = lane >> 4;
    const int lr = tid >> 3, lc = tid & 7, csrc = (lc ^ ((lr >> 1) & 7)) * 8;
    for (int L = blockIdx.x; L < NTILES; L += gridDim.x) {
        int pm, pn; tile_map(L, nN, NTILES, pm, pn);
        const int b = pm / TPS, j = pm % TPS, u0 = 126 * j - 1;
        const bf16_t* Ar[2];
#pragma unroll
        for (int i = 0; i < 2; ++i) {
            const int sr = u0 + lr + 64 * i;
            Ar[i] = ((unsigned)sr < (unsigned)S ? H2 + ((size_t)b * S + sr) * 1024 : ZR) + csrc;
        }
        f32x4 acc[4][4]; zero_acc(acc);
        gemm_mainloop_p<128, 256, 2, 4>(acc, Ar, (const bf16_t*)(p.ws + O_WUP) + (size_t)pn * 256 * 1024, 1024, 1024, lds, tid);
#pragma unroll
        for (int mt = 0; mt < 4; ++mt)
#pragma unroll
            for (int nt = 0; nt < 4; ++nt) {
                const f32x4 a = acc[mt][nt];
                *(u32x2*)(lds + (wm * 64 + mt * 16 + r) * ROWB + (wn * 64 + nt * 16 + g * 4) * 2) = (u32x2){pk2(a.x, a.y), pk2(a.z, a.w)};
            }
        __syncthreads();
        {
            const int cc = tid & 15, rr = tid >> 4;
            const int ca = pn * 128 + cc * 8, cg = DFF + ca;
            float wa[3][8], wg[3][8], ba[8], bg[8];
#pragma unroll
            for (int q = 0; q < 2; ++q) {
#pragma unroll
                for (int t = 0; t < 3; ++t) {
                    const f32x4 x = *(const f32x4*)(cw + t * NUP + ca + 4 * q), y = *(const f32x4*)(cw + t * NUP + cg + 4 * q);
#pragma unroll
                    for (int e = 0; e < 4; ++e) { wa[t][4 * q + e] = x[e]; wg[t][4 * q + e] = y[e]; }
                }
                const f32x4 x = *(const f32x4*)(cb + ca + 4 * q), y = *(const f32x4*)(cb + cg + 4 * q);
#pragma unroll
                for (int e = 0; e < 4; ++e) { ba[4 * q + e] = x[e]; bg[4 * q + e] = y[e]; }
            }
#pragma unroll
            for (int q = 0; q < 4; ++q) {
                const int o = rr + 32 * q, so = 126 * j + o;
                if (o < 126 && so < S) {
                    float a0[8], a1[8], a2[8], g0[8], g1[8], g2[8];
                    const char* e0 = lds + o * ROWB + cc * 16;
                    unpack8(*(const u32x4*)(e0), a0); unpack8(*(const u32x4*)(e0 + ROWB), a1); unpack8(*(const u32x4*)(e0 + 2 * ROWB), a2);
                    unpack8(*(const u32x4*)(e0 + 256), g0); unpack8(*(const u32x4*)(e0 + ROWB + 256), g1); unpack8(*(const u32x4*)(e0 + 2 * ROWB + 256), g2);
                    float av[8];
#pragma unroll
                    for (int e = 0; e < 8; ++e) {
                        const float ua = ba[e] + wa[0][e] * a0[e] + wa[1][e] * a1[e] + wa[2][e] * a2[e];
                        const float ug = bg[e] + wg[0][e] * g0[e] + wg[1][e] * g1[e] + wg[2][e] * g2[e];
                        av[e] = ug * sigmoidf_(ug) * ua;
                    }
                    u32x4 ov; ov.x = pk2(av[0], av[1]); ov.y = pk2(av[2], av[3]); ov.z = pk2(av[4], av[5]); ov.w = pk2(av[6], av[7]);
                    *(u32x4*)(ACT + ((size_t)b * S + so) * DFF + ca) = ov;
                }
            }
        }
        __syncthreads();
    }
}

DI void phase8(const Params& p, char* lds) {
    pg8::Gemm g{(const bf16_t*)(p.ws + O_ACT), (const bf16_t*)(p.ws + O_WDN), T, 1024, DFF};
    pg8::StaticOrder so; so.init(T, 1024, gridDim.x, blockIdx.x);
    EpiRes<true> E{p.in[0], p.in[1], p.out, (const float*)(p.ws + O_MOD) + 5120};
    pg8::gemm_phase<EpiRes<true>, pg8::StaticOrder, false>((PG8_LAS unsigned char*)lds, g, so, E, nullptr);
}

__global__ void __launch_bounds__(512) fwd_megakernel(Params p) {
    __shared__ __attribute__((aligned(16))) char lds[131072];
    cg::grid_group grid = cg::this_grid();
    char* lds4 = lds + __builtin_amdgcn_readfirstlane((int)(threadIdx.x >> 8)) * 65536;
    phase0(p, lds4);
    grid.sync();
    phase0m(p);
    grid.sync();
    norm_pass(p, false, (bf16_t*)(p.ws + O_H));
    grid.sync();
    phase1(p, lds);
    grid.sync();
    phase2(p, lds4);
    grid.sync();
    phase3(p, lds);
    grid.sync();
    phase4(p, lds);
    grid.sync();
    phase5(p, lds);
    grid.sync();
    norm_pass(p, true, (bf16_t*)(p.ws + O_H));
    grid.sync();
    phase7(p, lds);
    grid.sync();
    phase8(p, lds);
}

extern "C" void kernel_launch(void* const* d_in, const int* in_sizes, int n_in, void* d_out, int out_size, void* d_ws, size_t ws_size,
                              hipStream_t stream) {
    static int grid_blocks = 0;
    if (!grid_blocks) {
        int dev = 0, cus = 0, per_cu = 0;
        hipGetDevice(&dev);
        hipDeviceGetAttribute(&cus, hipDeviceAttributeMultiprocessorCount, dev);
        hipOccupancyMaxActiveBlocksPerMultiprocessor(&per_cu, fwd_megakernel, 512, 0);
        if (per_cu < 1) per_cu = 1;
        if (per_cu > 1) per_cu = 1;
        grid_blocks = cus * per_cu;
        if (n_in != 25 || ws_size < WS_NEED || out_size != T * D)
            fprintf(stderr, "kernel_launch: unexpected sizes n_in=%d ws=%zu out=%d\n", n_in, ws_size, out_size);
    }
    Params p{};
    for (int i = 0; i < 25; ++i) p.in[i] = (const float*)d_in[i];
    p.out = (float*)d_out;
    p.ws = (unsigned char*)d_ws;
    void* args[] = {&p};
    hipError_t e = hipLaunchCooperativeKernel((void*)fwd_megakernel, dim3(grid_blocks), dim3(512), args, 0, stream);
    if (e != hipSuccess) fprintf(stderr, "cooperative launch failed: %s (grid %d)\n", hipGetErrorString(e), grid_blocks);
}
```

```cpp
#include <hip/hip_runtime.h>
#include <hip/hip_cooperative_groups.h>
#include <cstdio>
#include <cstdint>
namespace cg = cooperative_groups;
#ifndef PM
#define PM 4095
#endif
#ifndef DUP
#define DUP 0
#define XSYNC 0
#endif

typedef unsigned short bf16_t;
typedef short bf16x8 __attribute__((ext_vector_type(8)));
typedef float f32x4 __attribute__((ext_vector_type(4)));
typedef unsigned u32x4 __attribute__((ext_vector_type(4)));
typedef unsigned u32x2 __attribute__((ext_vector_type(2)));
#define DI __device__ __forceinline__
__device__ __forceinline__ int opaque_tid() { int t = threadIdx.x; asm volatile("" : "+v"(t)); return t; }
#define TID4 (tid_ & 255)
#define VBID ((int)(blockIdx.x * 2 + (tid_ >> 8)))
#define VGRID ((int)(gridDim.x * 2))

constexpr int D = 1024, S = 4096, NBATCH = 24, T = NBATCH * S;
constexpr int T_PROMPT = 8 * S;
constexpr int IN_TOTAL = 3232, NZ = 1280  , NIN = NZ + 2048;
constexpr int DFF = 2816, NUP = 2 * DFF;
constexpr float EPS = 1e-6f;
constexpr float LOG2E = 1.4426950408889634f;
constexpr int NCHUNK = 4, TCH = T / NCHUNK;

constexpr size_t MiB = 1024ull * 1024ull;
constexpr size_t O_WIN = 0;
constexpr size_t O_WUQ = O_WIN + (size_t)NIN * 1024 * 2;
constexpr size_t O_WUKV = O_WUQ + 768ull * 256 * 2;
constexpr size_t O_WOA = O_WUKV + 1024ull * 128 * 2;
constexpr size_t O_WOB = O_WOA + 1024ull * 512 * 2;
constexpr size_t O_WOUT = O_WOB + 1024ull * 512 * 2;
constexpr size_t O_WUP = O_WOUT + 1024ull * 1024 * 2;
constexpr size_t O_WDN = O_WUP + (size_t)NUP * 1024 * 2;
constexpr size_t O_MODP = O_WDN + 1024ull * DFF * 2;
constexpr size_t O_MOD = O_MODP + 16ull * 24 * 6144 * 4;
constexpr size_t O_ROPEA = O_MOD + 24ull * 6144 * 4;
constexpr size_t O_ROPEB = O_ROPEA + 4096ull * 32 * 8;
constexpr size_t O_ZROW = O_ROPEB + 4096ull * 16 * 8;
constexpr size_t O_WB_END = O_ZROW + 4096;
static_assert(O_WB_END <= 48 * MiB, "weights region");
constexpr size_t O_ZS = 48 * MiB;
constexpr size_t O_QA = 288 * MiB;
constexpr size_t O_KA = O_QA + 96 * MiB;
constexpr size_t O_VTA = O_KA + 24 * MiB;
constexpr size_t O_QB = O_VTA + 24 * MiB;
constexpr size_t O_KB = O_QB + 144 * MiB;
constexpr size_t O_VTB = O_KB + 144 * MiB;
constexpr size_t O_H = 816 * MiB;
constexpr size_t O_UP = 288 * MiB;
constexpr size_t O_ACT = 288 * MiB;
constexpr size_t WS_NEED = 1008 * MiB;
static_assert(O_VTB + 96 * MiB <= O_H, "qkv region");
constexpr size_t OO_G = 0, O_OA = O_H, O_OB = O_H + 96 * MiB;

struct Params {
    const float* in[25];
    float* out;
    unsigned char* ws;
};

typedef __bf16 bf16x2_t __attribute__((ext_vector_type(2)));
typedef float f32x2_t __attribute__((ext_vector_type(2)));
DI unsigned pk2(float lo, float hi) { const f32x2_t v = {lo, hi}; return __builtin_bit_cast(unsigned, __builtin_convertvector(v, bf16x2_t)); }
DI float bflo(unsigned u) { return __uint_as_float(u << 16); }
DI float bfhi(unsigned u) { return __uint_as_float(u & 0xffff0000u); }
DI float bf2f(bf16_t v) { return __uint_as_float(((unsigned)v) << 16); }
DI bf16_t f2bf(float v) { return (bf16_t)(pk2(v, v) & 0xffffu); }
DI void unpack8(const u32x4 v, float (&f)[8]) {
    f[0] = bflo(v.x); f[1] = bfhi(v.x); f[2] = bflo(v.y); f[3] = bfhi(v.y); f[4] = bflo(v.z); f[5] = bfhi(v.z); f[6] = bflo(v.w); f[7] = bfhi(v.w);
}
DI float fast_rcp(float x) { return __builtin_amdgcn_rcpf(x); }
DI float fast_exp2(float x) { return __builtin_amdgcn_exp2f(x); }
DI float sigmoidf_(float v) { return fast_rcp(1.f + fast_exp2(-v * LOG2E)); }
DI float xor_reduce_g(float v) { v += __shfl_xor(v, 16); v += __shfl_xor(v, 32); return v; }
DI float wave_sum(float v) {
#pragma unroll
    for (int o = 1; o < 64; o <<= 1) v += __shfl_xor(v, o);
    return v;
}
DI int perm32(int s) { const int lo = s & 31; return (s & ~31) | (((lo >> 2) & 3) << 3) | ((lo >> 4) << 2) | (lo & 3); }
DI const float* xrow_ptr(const Params& p, int t) { return t < T_PROMPT ? p.in[0] + (size_t)t * D : p.in[1] + (size_t)(t - T_PROMPT) * D; }

DI void tile_map(int L, int nN, int ntiles, int& pm, int& pn) {
    const int xcd = L & 7, q = L >> 3;
    const int Lp = xcd * (ntiles >> 3) + q;
    const int grp = Lp / (8 * nN), rem = Lp % (8 * nN);
    pm = grp * 8 + (rem & 7); pn = rem >> 3;
}

#define LAS __attribute__((address_space(3)))
#define GAS __attribute__((address_space(1)))
template <int BM, int BN, int NWM, int NWN>
DI void gemm_mainloop_p(f32x4 (&acc)[BM / NWM / 16][BN / NWN / 16], const bf16_t* const (&Ar)[BM / (NWM * NWN * 8)],
                        const bf16_t* __restrict__ B, int ldb, int K, char* lds, const int tid) {
    constexpr int RPR = NWM * NWN * 8;
    constexpr int MT = BM / NWM / 16, NT = BN / NWN / 16, NA = BM / RPR, NB = BN / RPR, STAGE = (BM + BN) * 128, RB = RPR * 128;
    const int lane = tid & 63, wave = tid >> 6;
    const int wm = wave / NWN, wn = wave % NWN;
    const int r = lane & 15, g = lane >> 4;
    const int lr = tid >> 3, lc = tid & 7;
    const int csrc = (lc ^ ((lr >> 1) & 7)) * 8;
    const bf16_t* Bp = B + (size_t)lr * ldb + csrc;
    const int nk = K >> 6;
    auto issue = [&](int kt, int st) {
        char* d = lds + st * STAGE + tid * 16;
#pragma unroll
        for (int i = 0; i < NA; ++i)
            __builtin_amdgcn_global_load_lds((const GAS unsigned*)(Ar[i] + kt * 64), (LAS unsigned*)(d + i * RB), 16, 0, 0);
#pragma unroll
        for (int i = 0; i < NB; ++i)
            __builtin_amdgcn_global_load_lds((const GAS unsigned*)(Bp + (size_t)(RPR * i) * ldb + kt * 64), (LAS unsigned*)(d + BM * 128 + i * RB), 16, 0, 0);
    };
    issue(0, 0);
    __syncthreads();
    const int rsw = (r >> 1) & 7;
    for (int kt = 0; kt < nk; ++kt) {
        const int cur = kt & 1;
        if (kt + 1 < nk) issue(kt + 1, cur ^ 1);
        const char* sA = lds + cur * STAGE;
        const char* sB = sA + BM * 128;
#pragma unroll
        for (int ks = 0; ks < 2; ++ks) {
            bf16x8 wf[NT], xf[MT];
            const int co = ((ks * 4 + g) ^ rsw) * 16;
#pragma unroll
            for (int nt = 0; nt < NT; ++nt) wf[nt] = *(const bf16x8*)(sB + (wn * (NT * 16) + nt * 16 + r) * 128 + co);
#pragma unroll
            for (int mt = 0; mt < MT; ++mt) xf[mt] = *(const bf16x8*)(sA + (wm * (MT * 16) + mt * 16 + r) * 128 + co);
#pragma unroll
            for (int mt = 0; mt < MT; ++mt)
#pragma unroll
                for (int nt = 0; nt < NT; ++nt) acc[mt][nt] = __builtin_amdgcn_mfma_f32_16x16x32_bf16(wf[nt], xf[mt], acc[mt][nt], 0, 0, 0);
        }
        __syncthreads();
    }
}

template <int BM, int BN, int NWM, int NWN>
DI void gemm_mainloop(f32x4 (&acc)[BM / NWM / 16][BN / NWN / 16], const bf16_t* __restrict__ A, int lda,
                      const bf16_t* __restrict__ B, int ldb, int K, char* lds, const int tid) {
    constexpr int RPR = NWM * NWN * 8;
    const int lr = tid >> 3, lc = tid & 7;
    const bf16_t* Ar[BM / RPR];
#pragma unroll
    for (int i = 0; i < BM / RPR; ++i) Ar[i] = A + (size_t)(lr + RPR * i) * lda + (lc ^ ((lr >> 1) & 7)) * 8;
    gemm_mainloop_p<BM, BN, NWM, NWN>(acc, Ar, B, ldb, K, lds, tid);
}

template <int MT, int NT>
DI void zero_acc(f32x4 (&acc)[MT][NT]) {
#pragma unroll
    for (int i = 0; i < MT; ++i)
#pragma unroll
        for (int j = 0; j < NT; ++j) acc[i][j] = (f32x4){0.f, 0.f, 0.f, 0.f};
}

namespace pg8 {
#define PG8_LAS __attribute__((address_space(3)))
constexpr int BM = 256, BK = 64, HALF = 128, HTB = HALF * BK * 2, STAGE_BYTES = 8 * HTB, NXCD = 8, WGM = 8;
__host__ __device__ __forceinline__ int lds_byte(int r, int c) { const int st = (r >> 4) * 2 + (c >> 5), rr = r & 15, cc = c & 31, ob = rr * 64 + cc * 2; return st * 1024 + (ob ^ (((ob >> 9) & 1) << 5)); }
__host__ __device__ __forceinline__ void stage_rc(int b, int& R, int& C) { const int st = b / 1024, sb = b % 1024, swz = sb ^ (((sb >> 9) & 1) << 5); R = (st >> 1) * 16 + swz / 64; C = (st & 1) * 32 + (swz % 64) / 2; }
__host__ __device__ __forceinline__ int perm32(int rho) { const int n = rho >> 4, i = rho & 15; return 8 * (i >> 2) + 4 * n + (i & 3); }
struct Unit { int pm, pn; };
struct Gemm { const bf16_t* A; const bf16_t* Bt; int M, N, K; };
struct StaticOrder {
    int nM, nN, nwg, G, c;
    __host__ __device__ void init(int M, int N, int G_, int c_) { nM = M / BM; nN = N / BM; nwg = nM * nN; G = G_; c = c_; }
    __host__ __device__ bool next(int i, Unit& u) const {
        const long L = (long)i * G + c; if (L >= nwg) return false;
        int wgid = (int)L; { const int q = nwg / NXCD, r = nwg % NXCD, xcd = wgid % NXCD, off = wgid / NXCD; wgid = (xcd < r ? xcd * (q + 1) : r * (q + 1) + (xcd - r) * q) + off; }
        const int nig = WGM * nN, gid = wgid / nig, fm = gid * WGM, gsz = (nM - fm) < WGM ? (nM - fm) : WGM;
        u.pm = fm + ((wgid % nig) % gsz); u.pn = (wgid % nig) / gsz; return true;
    }
    __device__ __forceinline__ void a_ready(const Unit&) const {}
    __device__ __forceinline__ void done(const Unit&) const {}
};
template <class Epi, class Sched, bool STAMP = false>
__device__ __forceinline__ void gemm_phase(PG8_LAS unsigned char* lds, const Gemm g, const Sched& S, const Epi& E, unsigned long long* stamps) {
    const int tid = opaque_tid(), wid = __builtin_amdgcn_readfirstlane(tid >> 6), lane = tid & 63, wr = wid >> 2, wc = wid & 3, fr = lane & 15, fq = lane >> 4;
    const int K = g.K, nt = K / BK;
    int ts_lo = 0, ts_hi = 0, nts = 0; const unsigned long long rt_entry = STAMP ? (unsigned long long)wall_clock64() : 0ull;
#define PG8_STAMP() do { if (STAMP && wid == 0 && nts < 64) { const unsigned long long _c = (unsigned long long)clock64(); \
        ts_lo = (lane == nts) ? (int)(unsigned)_c : ts_lo; ts_hi = (lane == nts) ? (int)(unsigned)(_c >> 32) : ts_hi; ++nts; } } while (0)
    PG8_STAMP();
    unsigned voffA[2], voffB[2];
#pragma unroll
    for (int i = 0; i < 2; ++i) { int R, C; stage_rc(tid * 16 + i * 8192, R, C); const int Rb = Epi::PERM ? ((R & ~31) + perm32(R & 31)) : R;
        voffA[i] = (unsigned)(R * K + C) * 2u; voffB[i] = (unsigned)(Rb * K + C) * 2u; }
    const size_t kstep = (size_t)(BK * 2);
    const size_t hstep = (size_t)HALF * K * 2;
    const size_t tstep = 2 * hstep;
    const unsigned ldsw = (unsigned)wid * 1024u;
    const int aoff = lds_byte(wr * 64 + fr, fq * 8), boff = lds_byte(wc * 32 + fr, fq * 8);
#define PG8_SA(b, h) (((b) * 2 + (h)) * HTB)
#define PG8_SB(b, h) ((4 + (b) * 2 + (h)) * HTB)
#define PG8_STAGE(bufoff, gbase, voff) do { _Pragma("unroll") for (int _i = 0; _i < 2; ++_i) \
        __builtin_amdgcn_global_load_lds((const unsigned*)((const char*)(gbase) + (voff)[_i]), (PG8_LAS unsigned*)(lds + (bufoff) + ldsw + _i * 8192), 16, 0, 0); } while (0)
#define PG8_LDA(dst, b, h) do { _Pragma("unroll") for (int m = 0; m < 4; ++m) _Pragma("unroll") for (int k = 0; k < 2; ++k) dst[m][k] = *(const PG8_LAS bf16x8*)(lds + PG8_SA(b, h) + aoff + m * 2048 + k * 1024); } while (0)
#define PG8_LDB(dst, b, h) do { _Pragma("unroll") for (int n = 0; n < 2; ++n) _Pragma("unroll") for (int k = 0; k < 2; ++k) dst[n][k] = *(const PG8_LAS bf16x8*)(lds + PG8_SB(b, h) + boff + n * 2048 + k * 1024); } while (0)
#define PG8_MMA(ai, bj, At, Bt) do { __builtin_amdgcn_s_setprio(1); _Pragma("unroll") for (int m = 0; m < 4; ++m) _Pragma("unroll") for (int n = 0; n < 2; ++n) _Pragma("unroll") for (int k = 0; k < 2; ++k) \
        acc[ai][bj][m][n] = __builtin_amdgcn_mfma_f32_16x16x32_bf16(Bt[n][k], At[m][k], acc[ai][bj][m][n], 0, 0, 0); __builtin_amdgcn_s_setprio(0); } while (0)
#define PG8_WAIT_V(n) asm volatile("s_waitcnt vmcnt(" #n ")" ::: "memory")
#define PG8_WAIT_L(n) asm volatile("s_waitcnt lgkmcnt(" #n ")" ::: "memory")
#define PG8_BAR __builtin_amdgcn_s_barrier()
#define PG8_SCHED __builtin_amdgcn_sched_barrier(0)
    Unit cur, nxt; int ui = 0;
    if (!S.next(0, cur)) return;
    f32x4 acc[2][2][4][2];
#pragma unroll
    for (int a = 0; a < 2; ++a)
#pragma unroll
        for (int b = 0; b < 2; ++b)
#pragma unroll
            for (int m = 0; m < 4; ++m)
#pragma unroll
                for (int n = 0; n < 2; ++n) acc[a][b][m][n] = (f32x4){0.f, 0.f, 0.f, 0.f};
    bf16x8 At[4][2], B0[2][2], B1[2][2];
    const char* cA = (const char*)g.A + (size_t)cur.pm * tstep; const char* cB = (const char*)g.Bt + (size_t)cur.pn * tstep;
    S.a_ready(cur);
    PG8_STAGE(PG8_SB(0, 0), cB, voffB); PG8_STAGE(PG8_SA(0, 0), cA, voffA); PG8_STAGE(PG8_SB(0, 1), cB + hstep, voffB); PG8_STAGE(PG8_SA(0, 1), cA + hstep, voffA);
    if (wr == 1) PG8_BAR;
    PG8_WAIT_V(4); PG8_BAR;
    PG8_STAGE(PG8_SB(1, 0), cB + kstep, voffB); PG8_STAGE(PG8_SA(1, 0), cA + kstep, voffA); PG8_STAGE(PG8_SB(1, 1), cB + hstep + kstep, voffB);
    PG8_WAIT_V(6); PG8_BAR;
    PG8_STAMP();
    for (;;) {
        const bool has_next = S.next(ui + 1, nxt);
        const char* nA = has_next ? (const char*)g.A + (size_t)nxt.pm * tstep : cA; const char* nB = has_next ? (const char*)g.Bt + (size_t)nxt.pn * tstep : cB;
        for (int t = 0; t < nt; t += 2) {
            const bool last = (t == nt - 2);
            const char* a1 = cA + (size_t)(t + 1) * kstep;
            const char* a2 = last ? nA : cA + (size_t)(t + 2) * kstep; const char* b2 = last ? nB : cB + (size_t)(t + 2) * kstep;
            const char* a3 = a2 + kstep; const char* b3 = b2 + kstep;
            if (last && has_next) S.a_ready(nxt);
            PG8_LDB(B0, 0, 0); PG8_SCHED; PG8_LDA(At, 0, 0); PG8_STAGE(PG8_SA(1, 1), a1 + hstep, voffA);
            PG8_WAIT_L(8); PG8_BAR; PG8_WAIT_L(0); PG8_MMA(0, 0, At, B0); PG8_BAR; PG8_SCHED;
            PG8_LDB(B1, 0, 1); PG8_STAGE(PG8_SB(0, 0), b2, voffB);
            PG8_BAR; PG8_WAIT_L(0); PG8_MMA(0, 1, At, B1); PG8_BAR;
            PG8_LDA(At, 0, 1); PG8_STAGE(PG8_SA(0, 0), a2, voffA);
            PG8_BAR; PG8_WAIT_L(0); PG8_MMA(1, 0, At, B0); PG8_BAR; PG8_SCHED;
            PG8_STAGE(PG8_SB(0, 1), b2 + hstep, voffB);
            PG8_WAIT_V(6); PG8_BAR; PG8_MMA(1, 1, At, B1); PG8_BAR;
            PG8_LDB(B0, 1, 0); PG8_SCHED; PG8_LDA(At, 1, 0); PG8_STAGE(PG8_SA(0, 1), a2 + hstep, voffA);
            PG8_WAIT_L(8); PG8_BAR; PG8_WAIT_L(0); PG8_MMA(0, 0, At, B0); PG8_BAR; PG8_SCHED;
            PG8_LDB(B1, 1, 1); PG8_STAGE(PG8_SB(1, 0), b3, voffB);
            PG8_BAR; PG8_WAIT_L(0); PG8_MMA(0, 1, At, B1); PG8_BAR;
            PG8_LDA(At, 1, 1); PG8_STAGE(PG8_SA(1, 0), a3, voffA);
            PG8_BAR; PG8_WAIT_L(0); PG8_MMA(1, 0, At, B0); PG8_BAR; PG8_SCHED;
            PG8_STAGE(PG8_SB(1, 1), b3 + hstep, voffB);
            PG8_WAIT_V(6); PG8_BAR; PG8_MMA(1, 1, At, B1); PG8_BAR;
        }
        PG8_STAMP();
        if constexpr (!Epi::AFTER_DRAIN) { E(acc, cur, wr, wc, fr, fq); S.done(cur); }
        PG8_STAMP();
        if (!has_next) break;
#pragma unroll
        for (int a = 0; a < 2; ++a)
#pragma unroll
            for (int b = 0; b < 2; ++b)
#pragma unroll
                for (int m = 0; m < 4; ++m)
#pragma unroll
                    for (int n = 0; n < 2; ++n) acc[a][b][m][n] = (f32x4){0.f, 0.f, 0.f, 0.f};
        cur = nxt; cA = nA; cB = nB; ++ui;
    }
    PG8_WAIT_V(0);
    if (wr == 0) PG8_BAR;
    PG8_BAR;
    if constexpr (Epi::AFTER_DRAIN) { E.fused(acc, cur, wr, wc, fr, fq, lds, wid, lane); S.done(cur); }
    PG8_STAMP();
    if (STAMP && wid == 0) { stamps[lane] = lane < nts ? (((unsigned long long)(unsigned)ts_hi << 32) | (unsigned)ts_lo) : 0ull;
        if (lane == 62) stamps[62] = rt_entry; if (lane == 63) stamps[63] = (unsigned long long)wall_clock64(); }
#undef PG8_STAMP
#undef PG8_SA
#undef PG8_SB
#undef PG8_STAGE
#undef PG8_LDA
#undef PG8_LDB
#undef PG8_MMA
#undef PG8_WAIT_V
#undef PG8_WAIT_L
#undef PG8_BAR
#undef PG8_SCHED
}
}


struct EpiP1 {
    static constexpr bool PERM = true, AFTER_DRAIN = false;
    bf16_t* ZS; bf16_t* G;
    DI void operator()(const f32x4 (&acc)[2][2][4][2], const pg8::Unit& u, int wr, int wc, int fr, int fq) const {
        const int row0 = u.pm * 256 + wr * 64 + fr, colt = u.pn * 256 + wc * 32 + 8 * fq;
        const bool small = u.pn < NZ / 256;
#pragma unroll
        for (int ai = 0; ai < 2; ++ai)
#pragma unroll
            for (int m = 0; m < 4; ++m) {
                const size_t row = (size_t)(row0 + ai * 128 + m * 16);
#pragma unroll
                for (int bj = 0; bj < 2; ++bj) {
                    const int col = colt + bj * 128;
                    const f32x4 v0 = acc[ai][bj][m][0], v1 = acc[ai][bj][m][1];
                    u32x4 w;
                    if (small) { w.x = pk2(v0.x, v0.y); w.y = pk2(v0.z, v0.w); w.z = pk2(v1.x, v1.y); w.w = pk2(v1.z, v1.w); *(u32x4*)(ZS + row * NZ + col) = w; }
                    else { w.x = pk2(sigmoidf_(v0.x), sigmoidf_(v0.y)); w.y = pk2(sigmoidf_(v0.z), sigmoidf_(v0.w)); w.z = pk2(sigmoidf_(v1.x), sigmoidf_(v1.y)); w.w = pk2(sigmoidf_(v1.z), sigmoidf_(v1.w));
                           *(u32x4*)(G + row * 2048 + (col - NZ)) = w; }
                }
            }
    }
};
template <bool SECOND> struct EpiMix {
    static constexpr bool PERM = true, AFTER_DRAIN = false;
    const bf16_t* G; bf16_t* MIX;
    DI void operator()(const f32x4 (&acc)[2][2][4][2], const pg8::Unit& u, int wr, int wc, int fr, int fq) const {
        const int row0 = u.pm * 256 + wr * 64 + fr, colt = u.pn * 256 + wc * 32 + 8 * fq;
#pragma unroll
        for (int ai = 0; ai < 2; ++ai)
#pragma unroll
            for (int m = 0; m < 4; ++m) {
                const size_t row = (size_t)(row0 + ai * 128 + m * 16);
#pragma unroll
                for (int bj = 0; bj < 2; ++bj) {
                    const int col = colt + bj * 128;
                    float gv[8], o[8];
                    unpack8(*(const u32x4*)(G + row * 2048 + (SECOND ? 1024 : 0) + col), gv);
                    const f32x4 v0 = acc[ai][bj][m][0], v1 = acc[ai][bj][m][1];
                    if (SECOND) unpack8(*(const u32x4*)(MIX + row * 1024 + col), o);
                    else { for (int e = 0; e < 8; ++e) o[e] = 0.f; }
                    o[0] += gv[0] * v0.x; o[1] += gv[1] * v0.y; o[2] += gv[2] * v0.z; o[3] += gv[3] * v0.w;
                    o[4] += gv[4] * v1.x; o[5] += gv[5] * v1.y; o[6] += gv[6] * v1.z; o[7] += gv[7] * v1.w;
                    u32x4 w; w.x = pk2(o[0], o[1]); w.y = pk2(o[2], o[3]); w.z = pk2(o[4], o[5]); w.w = pk2(o[6], o[7]);
                    *(u32x4*)(MIX + row * 1024 + col) = w;
                }
            }
    }
};
template <bool INPLACE> struct EpiRes {
    static constexpr bool PERM = false, AFTER_DRAIN = false;
    const float* xp; const float* xs; float* out; const float* gate;
    DI void operator()(const f32x4 (&acc)[2][2][4][2], const pg8::Unit& u, int wr, int wc, int fr, int fq) const {
        const int row0 = u.pm * 256 + wr * 64 + fr, colt = u.pn * 256 + wc * 32 + 4 * fq;
        const float* gt = gate + (size_t)((u.pm * 256) >> 12) * 6144;
#pragma unroll
        for (int ai = 0; ai < 2; ++ai)
#pragma unroll
            for (int m = 0; m < 4; ++m) {
                const int row = row0 + ai * 128 + m * 16;
                float* orow = out + (size_t)row * D;
                const float* brow = INPLACE ? orow : (row < T_PROMPT ? xp + (size_t)row * D : xs + (size_t)(row - T_PROMPT) * D);
#pragma unroll
                for (int bj = 0; bj < 2; ++bj)
#pragma unroll
                    for (int n = 0; n < 2; ++n) {
                        const int col = colt + bj * 128 + n * 16;
                        const f32x4 xv = *(const f32x4*)(brow + col), gv = *(const f32x4*)(gt + col);
                        *(f32x4*)(orow + col) = xv + gv * acc[ai][bj][m][n];
                    }
            }
    }
};

DI void transpose_item(const float* __restrict__ W, int K, int N, bf16_t* __restrict__ WT, int mode, const float* __restrict__ scale,
                       float* scr, int item, int lane) {
    const int nblk = N >> 5, kb = item / nblk, nb = item % nblk, k0 = kb * 64, n0 = nb * 32;
#pragma unroll 8
    for (int i = 0; i < 32; ++i) {
        const int kk = 2 * i + (lane >> 5);
        float v = W[(size_t)(k0 + kk) * N + n0 + (lane & 31)];
        if (scale) v *= scale[k0 + kk];
        scr[kk * 33 + (lane & 31)] = v;
    }
    asm volatile("s_waitcnt lgkmcnt(0)" ::: "memory");
    const int c = lane & 7;
#pragma unroll
    for (int j = 0; j < 4; ++j) {
        const int nl = (lane >> 3) + 8 * j;
        const float* s = scr + (8 * c) * 33 + nl;
        u32x4 o;
        o.x = pk2(s[0 * 33], s[1 * 33]); o.y = pk2(s[2 * 33], s[3 * 33]); o.z = pk2(s[4 * 33], s[5 * 33]); o.w = pk2(s[6 * 33], s[7 * 33]);
        const int n = n0 + nl;
        int row;
        if (mode == 1) row = n < 1184 ? n : n + 96;
        else if (mode == 2) { const int h = n >> 7, jj = n & 127; row = jj < 64 ? h * 64 + jj : 512 + h * 64 + (jj - 64); }
        else if (mode == 3) { const int hf = n >= DFF ? 1 : 0, m2 = n - hf * DFF; row = (m2 >> 7) * 256 + hf * 128 + (m2 & 127); }
        else row = n;
        *(u32x4*)(WT + (size_t)row * K + k0 + 8 * c) = o;
    }
    asm volatile("s_waitcnt lgkmcnt(0)" ::: "memory");
}

DI void phase0(const Params& p, char* lds) {
    const int tid_ = opaque_tid();
    const int tid = TID4, bid = VBID, G = VGRID, lane = tid & 63, wave = tid >> 6;
    unsigned char* ws = p.ws;
    float* sc = (float*)lds;
    for (int it = bid; it < 384; it += G) {
        const int cb = it % 24, ks = it / 24;
        __syncthreads();
        for (int i = tid; i < 24 * 64; i += 256) {
            const int b = i >> 6, k = i & 63;
            const float* c = b < 8 ? p.in[2] + b * 1024 : p.in[3] + (b - 8) * 1024;
            const float v = c[ks * 64 + k];
            sc[i] = v * sigmoidf_(v);
        }
        __syncthreads();
        float a[24];
#pragma unroll
        for (int b = 0; b < 24; ++b) a[b] = 0.f;
        const int n = cb * 256 + tid;
        const float* w = p.in[4] + (size_t)(ks * 64) * 6144 + n;
        for (int k = 0; k < 64; ++k) {
            const float wv = w[(size_t)k * 6144];
#pragma unroll
            for (int b = 0; b < 24; ++b) a[b] += sc[b * 64 + k] * wv;
        }
        float* mp = (float*)(ws + O_MODP) + (size_t)(ks * 24) * 6144 + n;
#pragma unroll
        for (int b = 0; b < 24; ++b) mp[(size_t)b * 6144] = a[b];
    }
    __syncthreads();
    {
        float* scr = (float*)(lds + wave * 8448);
        const int gw = bid * 4 + wave, NGW = G * 4;
        constexpr int I0 = 16 * 101, I1 = 4 * 24, I2 = 2 * 32, I3 = 8 * 32, I4 = 8 * 32, I5 = 16 * 32, I6 = 16 * 176, I7 = 44 * 32;
        constexpr int NI = I0 + I1 + I2 + I3 + I4 + I5 + I6 + I7;
        for (int it = gw; it < NI; it += NGW) {
            int q = it;
            if (q < I0) { transpose_item(p.in[7], 1024, IN_TOTAL, (bf16_t*)(ws + O_WIN), 1, nullptr, scr, q, lane); continue; } q -= I0;
            if (q < I1) { transpose_item(p.in[12], 256, 768, (bf16_t*)(ws + O_WUQ), 0, p.in[11], scr, q, lane); continue; } q -= I1;
            if (q < I2) { transpose_item(p.in[14], 128, 1024, (bf16_t*)(ws + O_WUKV), 2, p.in[13], scr, q, lane); continue; } q -= I2;
            if (q < I3) { transpose_item(p.in[17], 512, 1024, (bf16_t*)(ws + O_WOA), 0, nullptr, scr, q, lane); continue; } q -= I3;
            if (q < I4) { transpose_item(p.in[18], 512, 1024, (bf16_t*)(ws + O_WOB), 0, nullptr, scr, q, lane); continue; } q -= I4;
            if (q < I5) { transpose_item(p.in[19], 1024, 1024, (bf16_t*)(ws + O_WOUT), 0, nullptr, scr, q, lane); continue; } q -= I5;
            if (q < I6) { transpose_item(p.in[21], 1024, NUP, (bf16_t*)(ws + O_WUP), 3, nullptr, scr, q, lane); continue; } q -= I6;
            transpose_item(p.in[24], DFF, 1024, (bf16_t*)(ws + O_WDN), 0, nullptr, scr, q, lane);
        }
    }
    const int gt = bid * 256 + tid, NGT = G * 256;
    for (int i = gt; i < 4096 * 48; i += NGT) {
        const int pos = i / 48, j = i % 48;
        float inv;
        if (j < 32) inv = exp2f(-(float)(2 * j) * (1.f / 64.f) * 13.287712379549449f);
        else inv = exp2f(-(float)(2 * (j - 32)) * (1.f / 32.f) * 13.287712379549449f);
        const float ang = (float)pos * inv;
        float rev = ang * 0.15915494309189535f;
        rev -= floorf(rev);
        const float sn = __builtin_amdgcn_sinf(rev), cs = __builtin_amdgcn_cosf(rev);
        float2* dst = j < 32 ? (float2*)(ws + O_ROPEA) + pos * 32 + j : (float2*)(ws + O_ROPEB) + pos * 16 + (j - 32);
        *dst = make_float2(cs, sn);
    }
    for (int i = gt; i < 96 * 1024 / 8; i += NGT) *(u32x4*)((bf16_t*)(ws + O_WIN) + 1184 * 1024 + (size_t)i * 8) = (u32x4){0u, 0u, 0u, 0u};
    if (gt < 256) *(u32x4*)(ws + O_ZROW + gt * 16) = (u32x4){0u, 0u, 0u, 0u};
}

DI void phase0m(const Params& p) {
    const int tid_ = opaque_tid();
    const int gt = VBID * 256 + TID4, NGT = VGRID * 256;
    const float* mp = (const float*)(p.ws + O_MODP);
    float* mod = (float*)(p.ws + O_MOD);
    for (int i = gt; i < 24 * 6144; i += NGT) {
        float s = p.in[5][i % 6144];
#pragma unroll
        for (int ks = 0; ks < 16; ++ks) s += mp[(size_t)ks * 24 * 6144 + i];
        mod[i] = s;
    }
}

DI void norm_pass(const Params& p, bool second, bf16_t* dst) {
    const int tid_ = opaque_tid();
    const int lane = TID4 & 63, gw = VBID * 4 + (TID4 >> 6), NGW = VGRID * 4;
    const float* gwt = second ? p.in[20] : p.in[6];
    const float* mod = (const float*)(p.ws + O_MOD);
    f32x4 gv[4];
#pragma unroll
    for (int j = 0; j < 4; ++j) gv[j] = *((const f32x4*)gwt + 64 * j + lane);
    for (int t = gw; t < T; t += NGW) {
        const float* xr = second ? p.out + (size_t)t * D : xrow_ptr(p, t);
        const int b = t >> 12;
        const float* sh = mod + (size_t)b * 6144 + (second ? 3072 : 0);
        const float* sc = sh + 1024;
        f32x4 v[4]; float s = 0.f;
#pragma unroll
        for (int j = 0; j < 4; ++j) { v[j] = *((const f32x4*)xr + 64 * j + lane); s += (v[j].x * v[j].x + v[j].y * v[j].y) + (v[j].z * v[j].z + v[j].w * v[j].w); }
        const float rstd = rsqrtf(wave_sum(s) * (1.f / D) + EPS);
        u32x2* o = (u32x2*)(dst + (size_t)t * D) + lane;
#pragma unroll
        for (int j = 0; j < 4; ++j) {
            const f32x4 scv = *((const f32x4*)sc + 64 * j + lane), shv = *((const f32x4*)sh + 64 * j + lane);
            f32x4 y;
            y.x = v[j].x * rstd * gv[j].x * (1.f + scv.x) + shv.x; y.y = v[j].y * rstd * gv[j].y * (1.f + scv.y) + shv.y;
            y.z = v[j].z * rstd * gv[j].z * (1.f + scv.z) + shv.z; y.w = v[j].w * rstd * gv[j].w * (1.f + scv.w) + shv.w;
            o[64 * j] = (u32x2){pk2(y.x, y.y), pk2(y.z, y.w)};
        }
    }
}

DI void phase1(const Params& p, char* lds) {
    pg8::Gemm g{(const bf16_t*)(p.ws + O_H), (const bf16_t*)(p.ws + O_WIN), T, NIN, 1024};
    pg8::StaticOrder so; so.init(T, NIN, gridDim.x, blockIdx.x);
    EpiP1 E{(bf16_t*)(p.ws + O_ZS), (bf16_t*)((unsigned char*)p.out + OO_G)};
    pg8::gemm_phase<EpiP1, pg8::StaticOrder, false>((PG8_LAS unsigned char*)lds, g, so, E, nullptr);
}

template <int NCH>
DI float row_sumsq(const bf16_t* rowp, int g) {
    float s = 0.f;
#pragma unroll
    for (int c = 0; c < NCH; ++c) {
        const u32x4 v = *(const u32x4*)(rowp + (g * NCH + c) * 8);
#pragma unroll
        for (int e = 0; e < 4; ++e) { const float a = bflo(v[e]), b = bfhi(v[e]); s += a * a + b * b; }
    }
    return xor_reduce_g(s);
}

DI void phase2(const Params& p, char* lds) {
    const int tid_ = opaque_tid();
    unsigned char* ws = p.ws;
    const bf16_t* ZS = (const bf16_t*)(ws + O_ZS);
    const int tid = TID4, lane = tid & 63, wave = tid >> 6, r = lane & 15, g = lane >> 4;
    const float2* ropeA = (const float2*)(ws + O_ROPEA);
    const float2* ropeB = (const float2*)(ws + O_ROPEB);
    constexpr int NTL = T / 128;
    for (int it = VBID; it < NTL * 8; it += VGRID) {
        const int tile = it >> 3, sub = it & 7, t0 = tile * 128, b = t0 >> 12, s0 = t0 & (S - 1);
        {
            const int h = sub;
            f32x4 acc[2][6]; zero_acc(acc);
            gemm_mainloop<128, 96, 4, 1>(acc, ZS + (size_t)t0 * NZ + 768, NZ, (const bf16_t*)(ws + O_WUQ) + (size_t)h * 96 * 256, 256, 256, lds, tid);
            const float* gq = p.in[15];
            const float qs = 0.10206207261596577f * LOG2E;
            bf16_t* QB = (bf16_t*)(ws + O_QB) + ((size_t)(b * 8 + h) * S) * 96;
#pragma unroll
            for (int mt = 0; mt < 2; ++mt) {
                const int ml = wave * 32 + mt * 16 + r, sp = s0 + ml;
                const float rstd = rsqrtf(row_sumsq<8>(ZS + (size_t)(t0 + ml) * NZ + 768, g) * (1.f / 256.f) + EPS);
                float ss = 0.f;
#pragma unroll
                for (int nt = 0; nt < 6; ++nt) { acc[mt][nt] = acc[mt][nt] * rstd; const f32x4 a = acc[mt][nt]; ss += (a.x * a.x + a.y * a.y) + (a.z * a.z + a.w * a.w); }
                const float r2 = rsqrtf(xor_reduce_g(ss) * (1.f / 96.f) + EPS);
#pragma unroll
                for (int nt = 0; nt < 6; ++nt) {
                    const f32x4 gg = *(const f32x4*)(gq + nt * 16 + g * 4);
                    acc[mt][nt] = acc[mt][nt] * r2 * gg;
                }
#pragma unroll
                for (int j = 0; j < 4; ++j) {
                    const float2 cs = ropeB[sp * 16 + g * 4 + j];
                    const float x1 = acc[mt][4][j], x2 = acc[mt][5][j];
                    acc[mt][4][j] = x1 * cs.x - x2 * cs.y;
                    acc[mt][5][j] = x1 * cs.y + x2 * cs.x;
                }
                bf16_t* qrow = QB + (size_t)sp * 96 + g * 4;
#pragma unroll
                for (int nt = 0; nt < 6; ++nt) { const f32x4 a = acc[mt][nt] * qs; *(u32x2*)(qrow + nt * 16) = (u32x2){pk2(a.x, a.y), pk2(a.z, a.w)}; }
                __builtin_amdgcn_sched_barrier(0);
            }
        }
    }
    for (int it = VBID; it < NTL * 4; it += VGRID) {
        const int tile = it >> 2, hp = it & 3, t0 = tile * 128, b = t0 >> 12, s0 = t0 & (S - 1);
        {
            f32x4 acc[4][4]; zero_acc(acc);
            gemm_mainloop<128, 128, 2, 2>(acc, ZS + (size_t)t0 * NZ + 1024, NZ,
                                          (const bf16_t*)(ws + O_WUKV) + (size_t)(hp * 128) * 128, 128, 128, lds, tid);
            const int wm = wave >> 1, wn = wave & 1, h = hp * 2 + wn;
            {
                const float* gk = p.in[16];
                bf16_t* KB = (bf16_t*)(ws + O_KB) + ((size_t)(b * 8 + h) * S) * 96;
#pragma unroll
                for (int mt = 0; mt < 4; ++mt) {
                    const int ml = wm * 64 + mt * 16 + r, sp = s0 + ml;
                    const bf16_t* zrow = ZS + (size_t)(t0 + ml) * NZ;
                    const float rstd = rsqrtf(row_sumsq<4>(zrow + 1024, g) * (1.f / 128.f) + EPS);
                    const u32x2 k1 = *(const u32x2*)(zrow + 1152 + g * 4), k2 = *(const u32x2*)(zrow + 1168 + g * 4);
                    float x1[4] = {bflo(k1.x), bfhi(k1.x), bflo(k1.y), bfhi(k1.y)};
                    float x2[4] = {bflo(k2.x), bfhi(k2.x), bflo(k2.y), bfhi(k2.y)};
                    float ss = 0.f;
#pragma unroll
                    for (int j = 0; j < 4; ++j) ss += x1[j] * x1[j] + x2[j] * x2[j];
#pragma unroll
                    for (int nt = 0; nt < 4; ++nt) { acc[mt][nt] = acc[mt][nt] * rstd; const f32x4 a = acc[mt][nt]; ss += (a.x * a.x + a.y * a.y) + (a.z * a.z + a.w * a.w); }
                    const float r2 = rsqrtf(xor_reduce_g(ss) * (1.f / 96.f) + EPS);
                    bf16_t* krow = KB + (size_t)sp * 96 + g * 4;
#pragma unroll
                    for (int nt = 0; nt < 4; ++nt) {
                        const f32x4 gg = *(const f32x4*)(gk + nt * 16 + g * 4);
                        const f32x4 a = acc[mt][nt] * r2 * gg;
                        *(u32x2*)(krow + nt * 16) = (u32x2){pk2(a.x, a.y), pk2(a.z, a.w)};
                    }
                    const f32x4 g1 = *(const f32x4*)(gk + 64 + g * 4), g2 = *(const f32x4*)(gk + 80 + g * 4);
                    float o1[4], o2[4];
#pragma unroll
                    for (int j = 0; j < 4; ++j) {
                        const float2 cs = ropeB[sp * 16 + g * 4 + j];
                        const float y1 = x1[j] * r2 * g1[j], y2 = x2[j] * r2 * g2[j];
                        o1[j] = y1 * cs.x - y2 * cs.y; o2[j] = y1 * cs.y + y2 * cs.x;
                    }
                    *(u32x2*)(krow + 64) = (u32x2){pk2(o1[0], o1[1]), pk2(o1[2], o1[3])};
                    *(u32x2*)(krow + 80) = (u32x2){pk2(o2[0], o2[1]), pk2(o2[2], o2[3])};
                    __builtin_amdgcn_sched_barrier(0);
                }
            }
        }
    }
    for (int it = VBID; it < NTL * 4; it += VGRID) {
        const int tile = it >> 2, hp = it & 3, t0 = tile * 128, b = t0 >> 12, s0 = t0 & (S - 1);
        {
            f32x4 acc[4][4]; zero_acc(acc);
            gemm_mainloop<128, 128, 2, 2>(acc, ZS + (size_t)t0 * NZ + 1024, NZ,
                                          (const bf16_t*)(ws + O_WUKV) + (size_t)(512 + hp * 128) * 128, 128, 128, lds, tid);
            const int wm = wave >> 1, wn = wave & 1, h = hp * 2 + wn;
            {
                bf16_t* VT = (bf16_t*)(ws + O_VTB) + ((size_t)(b * 8 + h) * 64) * S;
#pragma unroll
                for (int mt = 0; mt < 4; ++mt) {
                    const int ml = wm * 64 + mt * 16 + r, sp = s0 + ml;
                    const float rstd = rsqrtf(row_sumsq<4>(ZS + (size_t)(t0 + ml) * NZ + 1024, g) * (1.f / 128.f) + EPS);
                    const int ps = perm32(sp);
#pragma unroll
                    for (int nt = 0; nt < 4; ++nt)
#pragma unroll
                        for (int j = 0; j < 4; ++j) VT[(size_t)(nt * 16 + g * 4 + j) * S + ps] = f2bf(acc[mt][nt][j] * rstd);
                    __builtin_amdgcn_sched_barrier(0);
                }
            }
        }
    }
    __syncthreads();
    for (int tile = VBID; tile < NTL; tile += VGRID) {
        const int t0 = tile * 128, b = t0 >> 12, s0 = t0 & (S - 1);
        {
            const float* gqa = p.in[8];
            const float* gka = p.in[9];
            const int half = lane >> 5, i = lane & 31;
            const float qs = 0.125f * LOG2E;
            const float gq1 = gqa[i], gq2 = gqa[32 + i], gk1 = gka[i], gk2 = gka[32 + i];
            for (int tt0 = wave * 4; tt0 < 128; tt0 += 16) {
                float x1[4][5], x2[4][5]; float2 cs[4];
#pragma unroll
                for (int u = 0; u < 4; ++u) {
                    const bf16_t* zrow = ZS + (size_t)(t0 + tt0 + u) * NZ;
                    cs[u] = ropeA[(s0 + tt0 + u) * 32 + i];
#pragma unroll
                    for (int q = 0; q < 5; ++q) { const int hd = 2 * q + half; x1[u][q] = bf2f(zrow[hd * 64 + i]); x2[u][q] = bf2f(zrow[hd * 64 + 32 + i]); }
                }
#pragma unroll
                for (int u = 0; u < 4; ++u) {
                    const int sp = s0 + tt0 + u;
#pragma unroll
                    for (int q = 0; q < 5; ++q) {
                        const int hd = 2 * q + half;
                        float ss = x1[u][q] * x1[u][q] + x2[u][q] * x2[u][q];
#pragma unroll
                        for (int o = 1; o < 32; o <<= 1) ss += __shfl_xor(ss, o);
                        const float rr = rsqrtf(ss * (1.f / 64.f) + EPS);
                        const bool isq = q < 4;
                        const float y1 = x1[u][q] * rr * (isq ? gq1 : gk1), y2 = x2[u][q] * rr * (isq ? gq2 : gk2);
                        float o1 = y1 * cs[u].x - y2 * cs[u].y, o2 = y1 * cs[u].y + y2 * cs[u].x;
                        bf16_t* dst;
                        if (isq) { o1 *= qs; o2 *= qs; dst = (bf16_t*)(ws + O_QA) + ((size_t)(b * 8 + hd) * S + sp) * 64; }
                        else dst = (bf16_t*)(ws + O_KA) + ((size_t)(b * 2 + (hd - 8)) * S + sp) * 64;
                        dst[i] = f2bf(o1); dst[32 + i] = f2bf(o2);
                    }
                }
            }
            __syncthreads();
            bf16_t* tl = (bf16_t*)lds;
            for (int idx = tid; idx < 128 * 16; idx += 256) {
                const int tt = idx >> 4, c = idx & 15;
                const u32x4 v = *(const u32x4*)(ZS + (size_t)(t0 + tt) * NZ + 640 + c * 8);
                u32x2* d2 = (u32x2*)(tl + tt * 132 + c * 8);
                d2[0] = (u32x2){v.x, v.y}; d2[1] = (u32x2){v.z, v.w};
            }
            __syncthreads();
            bf16_t* VT = (bf16_t*)(ws + O_VTA) + ((size_t)(b * 2) * 64) * S;
            for (int idx = tid; idx < 128 * 128; idx += 256) {
                const int pp = idx & 127, dd = idx >> 7;
                const int lo = pp & 31;
                const int tt = (pp & ~31) | (((lo >> 2) & 1) << 4) | ((lo >> 3) << 2) | (lo & 3);
                VT[(size_t)dd * S + s0 + pp] = tl[tt * 132 + dd];
            }
            __syncthreads();
        }
    }
}

template <int DQK, bool WIN>
DI void attn_item(const bf16_t* __restrict__ Qw, const bf16_t* __restrict__ Kb, const bf16_t* __restrict__ Vt, int key0, int ntiles, int q0,
                  float shift2, float sink_term, bf16_t* __restrict__ Ow, int ldo, char* lds, const int tid) {
    constexpr int QT = 4, KS = DQK / 32, CH = DQK / 8, KROW = DQK * 2, KBYTES = 64 * KROW, NKI = KBYTES / 1024, STAGE = KBYTES + 8192;
    const int lane = tid & 63, r = lane & 15, g = lane >> 4, wave = __builtin_amdgcn_readfirstlane(tid >> 6);
    bf16x8 qf[QT][KS];
#pragma unroll
    for (int qt = 0; qt < QT; ++qt)
#pragma unroll
        for (int ks = 0; ks < KS; ++ks) qf[qt][ks] = *(const bf16x8*)(Qw + (size_t)(qt * 16 + r) * DQK + ks * 32 + g * 8);
    f32x4 oacc[4][QT];
    float lsum[QT];
#pragma unroll
    for (int qt = 0; qt < QT; ++qt) {
        lsum[qt] = 0.f;
#pragma unroll
        for (int i = 0; i < 4; ++i) oacc[i][qt] = (f32x4){0.f, 0.f, 0.f, 0.f};
    }
    int ksrc[2];
#pragma unroll
    for (int i = 0; i < 2; ++i) {
        const int pch = (wave + 8 * i) * 64 + lane, row = pch / CH, c = pch % CH;
        const int sc = (DQK == 96) ? ((c & ~3) | ((c & 3) ^ ((0x78 >> (2 * ((row >> 2) & 3))) & 3))) : (c ^ ((row >> 1) & 7));
        ksrc[i] = row * DQK + sc * 8;
    }
    const int vrow = tid >> 3, vsrc = ((tid & 7) ^ ((vrow >> 1) & 7)) * 8;
    const bf16_t* Vp = Vt + (size_t)vrow * S + vsrc;
    auto issue = [&](int tile, int st) {
        const int kb = key0 + tile * 64;
        char* d = lds + st * STAGE + tid * 16;
        __builtin_amdgcn_global_load_lds((const GAS unsigned*)(Kb + (size_t)kb * DQK + ksrc[0]), (LAS unsigned*)(d), 16, 0, 0);
        if (NKI > 8 && wave < NKI - 8)
            __builtin_amdgcn_global_load_lds((const GAS unsigned*)(Kb + (size_t)kb * DQK + ksrc[1]), (LAS unsigned*)(d + 8192), 16, 0, 0);
        __builtin_amdgcn_global_load_lds((const GAS unsigned*)(Vp + kb), (LAS unsigned*)(d + KBYTES), 16, 0, 0);
    };
    const int ksw = (DQK == 96) ? ((0x78 >> (2 * ((r >> 2) & 3))) & 3) : ((r >> 1) & 7);
    const int vsw = (r >> 1) & 7;
    const f32x4 sinit = (f32x4){-shift2, -shift2, -shift2, -shift2};
    __syncthreads();
    issue(0, 0);
    __syncthreads();
    for (int tile = 0; tile < ntiles; ++tile) {
        const int cur = tile & 1;
        if (tile + 1 < ntiles) issue(tile + 1, cur ^ 1);
        const char* sK = lds + cur * STAGE; const char* sV = sK + KBYTES;
#pragma unroll
        for (int kk = 0; kk < 2; ++kk) {
            f32x4 sacc[2][QT];
#pragma unroll
            for (int a = 0; a < 2; ++a) {
#pragma unroll
                for (int qt = 0; qt < QT; ++qt) sacc[a][qt] = sinit;
#pragma unroll
                for (int ks = 0; ks < KS; ++ks) {
                    const int kch = (DQK == 96) ? (ks * 4 + (g ^ ksw)) : ((ks * 4 + g) ^ ksw);
                    const bf16x8 kf = *(const bf16x8*)(sK + ((2 * kk + a) * 16 + r) * KROW + kch * 16);
#pragma unroll
                    for (int qt = 0; qt < QT; ++qt) sacc[a][qt] = __builtin_amdgcn_mfma_f32_16x16x32_bf16(kf, qf[qt][ks], sacc[a][qt], 0, 0, 0);
                }
            }
            const int kbase = key0 + tile * 64 + kk * 32 + g * 4;
            bf16x8 pb[QT];
#pragma unroll
            for (int qt = 0; qt < QT; ++qt) {
#pragma unroll
                for (int a = 0; a < 2; ++a)
#pragma unroll
                    for (int j = 0; j < 4; ++j) {
                        float pv = fast_exp2(sacc[a][qt][j]);
                        if (WIN) { const int dlt = (kbase + a * 16 + j) - (q0 + qt * 16 + r); if (dlt > 128 || dlt < -128) pv = 0.f; }
                        sacc[a][qt][j] = pv; lsum[qt] += pv;
                    }
                u32x4 u;
                u.x = pk2(sacc[0][qt][0], sacc[0][qt][1]); u.y = pk2(sacc[0][qt][2], sacc[0][qt][3]);
                u.z = pk2(sacc[1][qt][0], sacc[1][qt][1]); u.w = pk2(sacc[1][qt][2], sacc[1][qt][3]);
                pb[qt] = __builtin_bit_cast(bf16x8, u);
            }
#pragma unroll
            for (int dt = 0; dt < 4; ++dt) {
                const bf16x8 vf = *(const bf16x8*)(sV + (dt * 16 + r) * 128 + (((kk * 4 + g) ^ vsw) * 16));
#pragma unroll
                for (int qt = 0; qt < QT; ++qt) oacc[dt][qt] = __builtin_amdgcn_mfma_f32_16x16x32_bf16(vf, pb[qt], oacc[dt][qt], 0, 0, 0);
            }
            __builtin_amdgcn_sched_barrier(0);
        }
        __syncthreads();
    }
#pragma unroll
    for (int qt = 0; qt < QT; ++qt) {
        const float inv = fast_rcp(xor_reduce_g(lsum[qt]) + sink_term);
        bf16_t* orow = Ow + (size_t)(qt * 16 + r) * ldo + g * 4;
#pragma unroll
        for (int dt = 0; dt < 4; ++dt) { const f32x4 a = oacc[dt][qt] * inv; *(u32x2*)(orow + dt * 16) = (u32x2){pk2(a.x, a.y), pk2(a.z, a.w)}; }
    }
}

DI float max_abs(const float* v, int n) { float m = 0.f; for (int i = 0; i < n; ++i) m = fmaxf(m, fabsf(v[i])); return m; }

DI void phase3(const Params& p, char* lds) {
    unsigned char* ws = p.ws;
    const int tid = opaque_tid(), wave = tid >> 6;
    const float shiftB = 9.797958971132712f * max_abs(p.in[15], 96) * max_abs(p.in[16], 96) * LOG2E;
    const float shiftA = 8.f * max_abs(p.in[8], 64) * max_abs(p.in[9], 64) * LOG2E;
    bf16_t* OA = (bf16_t*)(p.ws + O_OA);
    bf16_t* OB = (bf16_t*)(p.ws + O_OB);
    constexpr int NB_ITEMS = 24 * 8 * 8, NA_ITEMS = 24 * 2 * 32;
    for (int L = blockIdx.x; L < NB_ITEMS; L += gridDim.x) {
        const int idx = (L & 7) * (NB_ITEMS / 8) + (L >> 3);
        const int bh = idx >> 3, qb = idx & 7, b = bh >> 3, h = bh & 7;
        const int q0 = qb * 512 + wave * 64;
        attn_item<96, false>((const bf16_t*)(ws + O_QB) + ((size_t)bh * S + q0) * 96, (const bf16_t*)(ws + O_KB) + (size_t)bh * S * 96,
                             (const bf16_t*)(ws + O_VTB) + (size_t)bh * 64 * S, 0, S / 64, q0, shiftB, 0.f,
                             OB + ((size_t)b * S + q0) * 512 + h * 64, 512, lds, tid);
    }
    for (int L = blockIdx.x; L < NA_ITEMS; L += gridDim.x) {
        const int idx = (L & 7) * (NA_ITEMS / 8) + (L >> 3);
        const int bk = idx >> 5, qb = idx & 31, b = bk >> 1, kvh = bk & 1;
        const int q0 = qb * 128 + (wave >> 2) * 64, hd = kvh * 4 + (wave & 3);
        int ks = qb * 128 - 128; if (ks < 0) ks = 0; if (ks > S - 384) ks = S - 384;
        const float sink_term = fast_exp2(p.in[10][hd] * LOG2E - shiftA);
        attn_item<64, true>((const bf16_t*)(ws + O_QA) + ((size_t)(b * 8 + hd) * S + q0) * 64, (const bf16_t*)(ws + O_KA) + (size_t)bk * S * 64,
                            (const bf16_t*)(ws + O_VTA) + (size_t)bk * 64 * S, ks, 6, q0, shiftA, sink_term,
                            OA + ((size_t)b * S + q0) * 512 + hd * 64, 512, lds, tid);
    }
}

DI void phase4(const Params& p, char* lds) {
    const bf16_t* Gt = (const bf16_t*)((unsigned char*)p.out + OO_G);
    bf16_t* MIX = (bf16_t*)(p.ws + O_ZS);
    pg8::StaticOrder so; so.init(T, 1024, gridDim.x, blockIdx.x);
    {
        pg8::Gemm g{(const bf16_t*)(p.ws + O_OA), (const bf16_t*)(p.ws + O_WOA), T, 1024, 512};
        EpiMix<false> E{Gt, MIX};
        pg8::gemm_phase<EpiMix<false>, pg8::StaticOrder, false>((PG8_LAS unsigned char*)lds, g, so, E, nullptr);
    }
    {
        pg8::Gemm g{(const bf16_t*)(p.ws + O_OB), (const bf16_t*)(p.ws + O_WOB), T, 1024, 512};
        EpiMix<true> E{Gt, MIX};
        pg8::gemm_phase<EpiMix<true>, pg8::StaticOrder, false>((PG8_LAS unsigned char*)lds, g, so, E, nullptr);
    }
}

DI void phase5(const Params& p, char* lds) {
    pg8::Gemm g{(const bf16_t*)(p.ws + O_ZS), (const bf16_t*)(p.ws + O_WOUT), T, 1024, 1024};
    pg8::StaticOrder so; so.init(T, 1024, gridDim.x, blockIdx.x);
    EpiRes<false> E{p.in[0], p.in[1], p.out, (const float*)(p.ws + O_MOD) + 2048};
    pg8::gemm_phase<EpiRes<false>, pg8::StaticOrder, false>((PG8_LAS unsigned char*)lds, g, so, E, nullptr);
}

DI void phase7(const Params& p, char* lds) {
    const bf16_t* H2 = (const bf16_t*)(p.ws + O_H);
    const bf16_t* ZR = (const bf16_t*)(p.ws + O_ZROW);
    bf16_t* ACT = (bf16_t*)(p.ws + O_ACT);
    const float* cw = p.in[22];
    const float* cb = p.in[23];
    constexpr int TPS = 33, nM = NBATCH * TPS, nN = DFF / 128, NTILES = nM * nN, ROWB = 528;
    const int tid = opaque_tid(), lane = tid & 63, wave = tid >> 6, wm = wave >> 2, wn = wave & 3, r = lane & 15, g = lane >> 4;
    const int lr = tid >> 3, lc = tid & 7, csrc = (lc ^ ((lr >> 1) & 7)) * 8;
    for (int L = blockIdx.x; L < NTILES; L += gridDim.x) {
        int pm, pn; tile_map(L, nN, NTILES, pm, pn);
        const int b = pm / TPS, j = pm % TPS, u0 = 126 * j - 1;
        const bf16_t* Ar[2];
#pragma unroll
        for (int i = 0; i < 2; ++i) {
            const int sr = u0 + lr + 64 * i;
            Ar[i] = ((unsigned)sr < (unsigned)S ? H2 + ((size_t)b * S + sr) * 1024 : ZR) + csrc;
        }
        f32x4 acc[4][4]; zero_acc(acc);
        gemm_mainloop_p<128, 256, 2, 4>(acc, Ar, (const bf16_t*)(p.ws + O_WUP) + (size_t)pn * 256 * 1024, 1024, 1024, lds, tid);
#pragma unroll
        for (int mt = 0; mt < 4; ++mt)
#pragma unroll
            for (int nt = 0; nt < 4; ++nt) {
                const f32x4 a = acc[mt][nt];
                *(u32x2*)(lds + (wm * 64 + mt * 16 + r) * ROWB + (wn * 64 + nt * 16 + g * 4) * 2) = (u32x2){pk2(a.x, a.y), pk2(a.z, a.w)};
            }
        __syncthreads();
        {
            const int cc = tid & 15, rr = tid >> 4;
            const int ca = pn * 128 + cc * 8, cg = DFF + ca;
            float wa[3][8], wg[3][8], ba[8], bg[8];
#pragma unroll
            for (int q = 0; q < 2; ++q) {
#pragma unroll
                for (int t = 0; t < 3; ++t) {
                    const f32x4 x = *(const f32x4*)(cw + t * NUP + ca + 4 * q), y = *(const f32x4*)(cw + t * NUP + cg + 4 * q);
#pragma unroll
                    for (int e = 0; e < 4; ++e) { wa[t][4 * q + e] = x[e]; wg[t][4 * q + e] = y[e]; }
                }
                const f32x4 x = *(const f32x4*)(cb + ca + 4 * q), y = *(const f32x4*)(cb + cg + 4 * q);
#pragma unroll
                for (int e = 0; e < 4; ++e) { ba[4 * q + e] = x[e]; bg[4 * q + e] = y[e]; }
            }
#pragma unroll
            for (int q = 0; q < 4; ++q) {
                const int o = rr + 32 * q, so = 126 * j + o;
                if (o < 126 && so < S) {
                    float a0[8], a1[8], a2[8], g0[8], g1[8], g2[8];
                    const char* e0 = lds + o * ROWB + cc * 16;
                    unpack8(*(const u32x4*)(e0), a0); unpack8(*(const u32x4*)(e0 + ROWB), a1); unpack8(*(const u32x4*)(e0 + 2 * ROWB), a2);
                    unpack8(*(const u32x4*)(e0 + 256), g0); unpack8(*(const u32x4*)(e0 + ROWB + 256), g1); unpack8(*(const u32x4*)(e0 + 2 * ROWB + 256), g2);
                    float av[8];
#pragma unroll
                    for (int e = 0; e < 8; ++e) {
                        const float ua = ba[e] + wa[0][e] * a0[e] + wa[1][e] * a1[e] + wa[2][e] * a2[e];
                        const float ug = bg[e] + wg[0][e] * g0[e] + wg[1][e] * g1[e] + wg[2][e] * g2[e];
                        av[e] = ug * sigmoidf_(ug) * ua;
                    }
                    u32x4 ov; ov.x = pk2(av[0], av[1]); ov.y = pk2(av[2], av[3]); ov.z = pk2(av[4], av[5]); ov.w = pk2(av[6], av[7]);
                    *(u32x4*)(ACT + ((size_t)b * S + so) * DFF + ca) = ov;
                }
            }
        }
        __syncthreads();
    }
}

DI void phase8(const Params& p, char* lds) {
    pg8::Gemm g{(const bf16_t*)(p.ws + O_ACT), (const bf16_t*)(p.ws + O_WDN), T, 1024, DFF};
    pg8::StaticOrder so; so.init(T, 1024, gridDim.x, blockIdx.x);
    EpiRes<true> E{p.in[0], p.in[1], p.out, (const float*)(p.ws + O_MOD) + 5120};
    pg8::gemm_phase<EpiRes<true>, pg8::StaticOrder, false>((PG8_LAS unsigned char*)lds, g, so, E, nullptr);
}

__global__ void __launch_bounds__(512) fwd_megakernel(Params p) {
    __shared__ __attribute__((aligned(16))) char lds[131072];
    cg::grid_group grid = cg::this_grid();
    char* lds4 = lds + __builtin_amdgcn_readfirstlane((int)(threadIdx.x >> 8)) * 65536;
    phase0(p, lds4);
    grid.sync();
    phase0m(p);
    grid.sync();
    norm_pass(p, false, (bf16_t*)(p.ws + O_H));
    grid.sync();
    phase1(p, lds);
    grid.sync();
    phase2(p, lds4);
    grid.sync();
    phase3(p, lds);
    grid.sync();
    phase4(p, lds);
    grid.sync();
    phase5(p, lds);
    grid.sync();
    norm_pass(p, true, (bf16_t*)(p.ws + O_H));
    grid.sync();
    phase7(p, lds);
    grid.sync();
    phase8(p, lds);
}

extern "C" void kernel_launch(void* const* d_in, const int* in_sizes, int n_in, void* d_out, int out_size, void* d_ws, size_t ws_size,
                              hipStream_t stream) {
    static int grid_blocks = 0;
    if (!grid_blocks) {
        int dev = 0, cus = 0, per_cu = 0;
        hipGetDevice(&dev);
        hipDeviceGetAttribute(&cus, hipDeviceAttributeMultiprocessorCount, dev);
        hipOccupancyMaxActiveBlocksPerMultiprocessor(&per_cu, fwd_megakernel, 512, 0);
        if (per_cu < 1) per_cu = 1;
        if (per_cu > 1) per_cu = 1;
        grid_blocks = cus * per_cu;
        if (n_in != 25 || ws_size < WS_NEED || out_size != T * D)
            fprintf(stderr, "kernel_launch: unexpected sizes n_in=%d ws=%zu out=%d\n", n_in, ws_size, out_size);
    }
    Params p{};
    for (int i = 0; i < 25; ++i) p.in[i] = (const float*)d_in[i];
    p.out = (float*)d_out;
    p.ws = (unsigned char*)d_ws;
    void* args[] = {&p};
    hipError_t e = hipLaunchCooperativeKernel((void*)fwd_megakernel, dim3(grid_blocks), dim3(512), args, 0, stream);
    if (e != hipSuccess) fprintf(stderr, "cooperative launch failed: %s (grid %d)\n", hipGetErrorString(e), grid_blocks);
}
```

```cpp
#include <hip/hip_runtime.h>
#include <hip/hip_cooperative_groups.h>
#include <cstdio>
#include <cstdint>
namespace cg = cooperative_groups;
#ifndef PM
#define PM 4095
#endif
#ifndef DUP
#define DUP 0
#define XSYNC 0
#endif

typedef unsigned short bf16_t;
typedef short bf16x8 __attribute__((ext_vector_type(8)));
typedef float f32x4 __attribute__((ext_vector_type(4)));
typedef unsigned u32x4 __attribute__((ext_vector_type(4)));
typedef unsigned u32x2 __attribute__((ext_vector_type(2)));
#define DI __device__ __forceinline__
__device__ __forceinline__ int opaque_tid() { int t = threadIdx.x; asm volatile("" : "+v"(t)); return t; }
#define TID4 (tid_ & 255)
#define VBID ((int)(blockIdx.x * 2 + (tid_ >> 8)))
#define VGRID ((int)(gridDim.x * 2))

constexpr int D = 1024, S = 4096, NBATCH = 24, T = NBATCH * S;
constexpr int T_PROMPT = 8 * S;
constexpr int IN_TOTAL = 3232, NZ = 1280  , NIN = NZ + 2048;
constexpr int DFF = 2816, NUP = 2 * DFF;
constexpr float EPS = 1e-6f;
constexpr float LOG2E = 1.4426950408889634f;
constexpr int NCHUNK = 4, TCH = T / NCHUNK;

constexpr size_t MiB = 1024ull * 1024ull;
constexpr size_t O_WIN = 0;
constexpr size_t O_WUQ = O_WIN + (size_t)NIN * 1024 * 2;
constexpr size_t O_WUKV = O_WUQ + 768ull * 256 * 2;
constexpr size_t O_WOA = O_WUKV + 1024ull * 128 * 2;
constexpr size_t O_WOB = O_WOA + 1024ull * 512 * 2;
constexpr size_t O_WOUT = O_WOB + 1024ull * 512 * 2;
constexpr size_t O_WUP = O_WOUT + 1024ull * 1024 * 2;
constexpr size_t O_WDN = O_WUP + (size_t)NUP * 1024 * 2;
constexpr size_t O_MODP = O_WDN + 1024ull * DFF * 2;
constexpr size_t O_MOD = O_MODP + 16ull * 24 * 6144 * 4;
constexpr size_t O_ROPEA = O_MOD + 24ull * 6144 * 4;
constexpr size_t O_ROPEB = O_ROPEA + 4096ull * 32 * 8;
constexpr size_t O_ZROW = O_ROPEB + 4096ull * 16 * 8;
constexpr size_t O_WB_END = O_ZROW + 4096;
static_assert(O_WB_END <= 48 * MiB, "weights region");
constexpr size_t O_ZS = 48 * MiB;
constexpr size_t O_QA = 288 * MiB;
constexpr size_t O_KA = O_QA + 96 * MiB;
constexpr size_t O_VTA = O_KA + 24 * MiB;
constexpr size_t O_QB = O_VTA + 24 * MiB;
constexpr size_t O_KB = O_QB + 144 * MiB;
constexpr size_t O_VTB = O_KB + 144 * MiB;
constexpr size_t O_H = 816 * MiB;
constexpr size_t O_UP = 288 * MiB;
constexpr int SEQP = S + 1, H2P_ROWS = 388 * 254 + 2;
constexpr size_t O_H2P = 48 * MiB;
constexpr size_t O_ACT = 288 * MiB;
constexpr size_t WS_NEED = 1008 * MiB;
static_assert(O_VTB + 96 * MiB <= O_H, "qkv region");
constexpr size_t OO_G = 0, O_OA = O_H, O_OB = O_H + 96 * MiB;

struct Params {
    const float* in[25];
    float* out;
    unsigned char* ws;
};

typedef __bf16 bf16x2_t __attribute__((ext_vector_type(2)));
typedef float f32x2_t __attribute__((ext_vector_type(2)));
DI unsigned pk2(float lo, float hi) { const f32x2_t v = {lo, hi}; return __builtin_bit_cast(unsigned, __builtin_convertvector(v, bf16x2_t)); }
DI float bflo(unsigned u) { return __uint_as_float(u << 16); }
DI float bfhi(unsigned u) { return __uint_as_float(u & 0xffff0000u); }
DI float bf2f(bf16_t v) { return __uint_as_float(((unsigned)v) << 16); }
DI bf16_t f2bf(float v) { return (bf16_t)(pk2(v, v) & 0xffffu); }
DI void unpack8(const u32x4 v, float (&f)[8]) {
    f[0] = bflo(v.x); f[1] = bfhi(v.x); f[2] = bflo(v.y); f[3] = bfhi(v.y); f[4] = bflo(v.z); f[5] = bfhi(v.z); f[6] = bflo(v.w); f[7] = bfhi(v.w);
}
DI float fast_rcp(float x) { return __builtin_amdgcn_rcpf(x); }
DI float fast_exp2(float x) { return __builtin_amdgcn_exp2f(x); }
DI float sigmoidf_(float v) { return fast_rcp(1.f + fast_exp2(-v * LOG2E)); }
DI float xor_reduce_g(float v) { v += __shfl_xor(v, 16); v += __shfl_xor(v, 32); return v; }
DI float wave_sum(float v) {
#pragma unroll
    for (int o = 1; o < 64; o <<= 1) v += __shfl_xor(v, o);
    return v;
}
DI int perm32(int s) { const int lo = s & 31; return (s & ~31) | (((lo >> 2) & 3) << 3) | ((lo >> 4) << 2) | (lo & 3); }
DI const float* xrow_ptr(const Params& p, int t) { return t < T_PROMPT ? p.in[0] + (size_t)t * D : p.in[1] + (size_t)(t - T_PROMPT) * D; }

DI void tile_map(int L, int nN, int ntiles, int& pm, int& pn) {
    const int xcd = L & 7, q = L >> 3;
    const int Lp = xcd * (ntiles >> 3) + q;
    const int grp = Lp / (8 * nN), rem = Lp % (8 * nN);
    pm = grp * 8 + (rem & 7); pn = rem >> 3;
}

#define LAS __attribute__((address_space(3)))
#define GAS __attribute__((address_space(1)))
template <int BM, int BN, int NWM, int NWN>
DI void gemm_mainloop_p(f32x4 (&acc)[BM / NWM / 16][BN / NWN / 16], const bf16_t* const (&Ar)[BM / (NWM * NWN * 8)],
                        const bf16_t* __restrict__ B, int ldb, int K, char* lds, const int tid) {
    constexpr int RPR = NWM * NWN * 8;
    constexpr int MT = BM / NWM / 16, NT = BN / NWN / 16, NA = BM / RPR, NB = BN / RPR, STAGE = (BM + BN) * 128, RB = RPR * 128;
    const int lane = tid & 63, wave = tid >> 6;
    const int wm = wave / NWN, wn = wave % NWN;
    const int r = lane & 15, g = lane >> 4;
    const int lr = tid >> 3, lc = tid & 7;
    const int csrc = (lc ^ ((lr >> 1) & 7)) * 8;
    const bf16_t* Bp = B + (size_t)lr * ldb + csrc;
    const int nk = K >> 6;
    auto issue = [&](int kt, int st) {
        char* d = lds + st * STAGE + tid * 16;
#pragma unroll
        for (int i = 0; i < NA; ++i)
            __builtin_amdgcn_global_load_lds((const GAS unsigned*)(Ar[i] + kt * 64), (LAS unsigned*)(d + i * RB), 16, 0, 0);
#pragma unroll
        for (int i = 0; i < NB; ++i)
            __builtin_amdgcn_global_load_lds((const GAS unsigned*)(Bp + (size_t)(RPR * i) * ldb + kt * 64), (LAS unsigned*)(d + BM * 128 + i * RB), 16, 0, 0);
    };
    issue(0, 0);
    __syncthreads();
    const int rsw = (r >> 1) & 7;
    for (int kt = 0; kt < nk; ++kt) {
        const int cur = kt & 1;
        if (kt + 1 < nk) issue(kt + 1, cur ^ 1);
        const char* sA = lds + cur * STAGE;
        const char* sB = sA + BM * 128;
#pragma unroll
        for (int ks = 0; ks < 2; ++ks) {
            bf16x8 wf[NT], xf[MT];
            const int co = ((ks * 4 + g) ^ rsw) * 16;
#pragma unroll
            for (int nt = 0; nt < NT; ++nt) wf[nt] = *(const bf16x8*)(sB + (wn * (NT * 16) + nt * 16 + r) * 128 + co);
#pragma unroll
            for (int mt = 0; mt < MT; ++mt) xf[mt] = *(const bf16x8*)(sA + (wm * (MT * 16) + mt * 16 + r) * 128 + co);
#pragma unroll
            for (int mt = 0; mt < MT; ++mt)
#pragma unroll
                for (int nt = 0; nt < NT; ++nt) acc[mt][nt] = __builtin_amdgcn_mfma_f32_16x16x32_bf16(wf[nt], xf[mt], acc[mt][nt], 0, 0, 0);
        }
        __syncthreads();
    }
}

template <int BM, int BN, int NWM, int NWN>
DI void gemm_mainloop(f32x4 (&acc)[BM / NWM / 16][BN / NWN / 16], const bf16_t* __restrict__ A, int lda,
                      const bf16_t* __restrict__ B, int ldb, int K, char* lds, const int tid) {
    constexpr int RPR = NWM * NWN * 8;
    const int lr = tid >> 3, lc = tid & 7;
    const bf16_t* Ar[BM / RPR];
#pragma unroll
    for (int i = 0; i < BM / RPR; ++i) Ar[i] = A + (size_t)(lr + RPR * i) * lda + (lc ^ ((lr >> 1) & 7)) * 8;
    gemm_mainloop_p<BM, BN, NWM, NWN>(acc, Ar, B, ldb, K, lds, tid);
}

template <int MT, int NT>
DI void zero_acc(f32x4 (&acc)[MT][NT]) {
#pragma unroll
    for (int i = 0; i < MT; ++i)
#pragma unroll
        for (int j = 0; j < NT; ++j) acc[i][j] = (f32x4){0.f, 0.f, 0.f, 0.f};
}

namespace pg8 {
#define PG8_LAS __attribute__((address_space(3)))
constexpr int BM = 256, BK = 64, HALF = 128, HTB = HALF * BK * 2, STAGE_BYTES = 8 * HTB, NXCD = 8, WGM = 8;
__host__ __device__ __forceinline__ int lds_byte(int r, int c) { const int st = (r >> 4) * 2 + (c >> 5), rr = r & 15, cc = c & 31, ob = rr * 64 + cc * 2; return st * 1024 + (ob ^ (((ob >> 9) & 1) << 5)); }
__host__ __device__ __forceinline__ void stage_rc(int b, int& R, int& C) { const int st = b / 1024, sb = b % 1024, swz = sb ^ (((sb >> 9) & 1) << 5); R = (st >> 1) * 16 + swz / 64; C = (st & 1) * 32 + (swz % 64) / 2; }
__host__ __device__ __forceinline__ int perm32(int rho) { const int n = rho >> 4, i = rho & 15; return 8 * (i >> 2) + 4 * n + (i & 3); }
struct Unit { int pm, pn; };
struct Gemm { const bf16_t* A; const bf16_t* Bt; int M, N, K; int a_rows = 256; };
struct StaticOrder {
    int nM, nN, nwg, G, c;
    __host__ __device__ void init(int M, int N, int G_, int c_) { nM = M / BM; nN = N / BM; nwg = nM * nN; G = G_; c = c_; }
    __host__ __device__ bool next(int i, Unit& u) const {
        const long L = (long)i * G + c; if (L >= nwg) return false;
        int wgid = (int)L; { const int q = nwg / NXCD, r = nwg % NXCD, xcd = wgid % NXCD, off = wgid / NXCD; wgid = (xcd < r ? xcd * (q + 1) : r * (q + 1) + (xcd - r) * q) + off; }
        const int nig = WGM * nN, gid = wgid / nig, fm = gid * WGM, gsz = (nM - fm) < WGM ? (nM - fm) : WGM;
        u.pm = fm + ((wgid % nig) % gsz); u.pn = (wgid % nig) / gsz; return true;
    }
    __device__ __forceinline__ void a_ready(const Unit&) const {}
    __device__ __forceinline__ void done(const Unit&) const {}
};
template <class Epi, class Sched, bool STAMP = false>
__device__ __forceinline__ void gemm_phase(PG8_LAS unsigned char* lds, const Gemm g, const Sched& S, const Epi& E, unsigned long long* stamps) {
    const int tid = opaque_tid(), wid = __builtin_amdgcn_readfirstlane(tid >> 6), lane = tid & 63, wr = wid >> 2, wc = wid & 3, fr = lane & 15, fq = lane >> 4;
    const int K = g.K, nt = K / BK;
    int ts_lo = 0, ts_hi = 0, nts = 0; const unsigned long long rt_entry = STAMP ? (unsigned long long)wall_clock64() : 0ull;
#define PG8_STAMP() do { if (STAMP && wid == 0 && nts < 64) { const unsigned long long _c = (unsigned long long)clock64(); \
        ts_lo = (lane == nts) ? (int)(unsigned)_c : ts_lo; ts_hi = (lane == nts) ? (int)(unsigned)(_c >> 32) : ts_hi; ++nts; } } while (0)
    PG8_STAMP();
    unsigned voffA[2], voffB[2];
#pragma unroll
    for (int i = 0; i < 2; ++i) { int R, C; stage_rc(tid * 16 + i * 8192, R, C); const int Rb = Epi::PERM ? ((R & ~31) + perm32(R & 31)) : R;
        voffA[i] = (unsigned)(R * K + C) * 2u; voffB[i] = (unsigned)(Rb * K + C) * 2u; }
    const size_t kstep = (size_t)(BK * 2);
    const size_t hstep = (size_t)HALF * K * 2;
    const size_t tstep = 2 * hstep;
    const size_t tstepA = (size_t)g.a_rows * K * 2;
    const unsigned ldsw = (unsigned)wid * 1024u;
    const int aoff = lds_byte(wr * 64 + fr, fq * 8), boff = lds_byte(wc * 32 + fr, fq * 8);
#define PG8_SA(b, h) (((b) * 2 + (h)) * HTB)
#define PG8_SB(b, h) ((4 + (b) * 2 + (h)) * HTB)
#define PG8_STAGE(bufoff, gbase, voff) do { _Pragma("unroll") for (int _i = 0; _i < 2; ++_i) \
        __builtin_amdgcn_global_load_lds((const unsigned*)((const char*)(gbase) + (voff)[_i]), (PG8_LAS unsigned*)(lds + (bufoff) + ldsw + _i * 8192), 16, 0, 0); } while (0)
#define PG8_LDA(dst, b, h) do { _Pragma("unroll") for (int m = 0; m < 4; ++m) _Pragma("unroll") for (int k = 0; k < 2; ++k) dst[m][k] = *(const PG8_LAS bf16x8*)(lds + PG8_SA(b, h) + aoff + m * 2048 + k * 1024); } while (0)
#define PG8_LDB(dst, b, h) do { _Pragma("unroll") for (int n = 0; n < 2; ++n) _Pragma("unroll") for (int k = 0; k < 2; ++k) dst[n][k] = *(const PG8_LAS bf16x8*)(lds + PG8_SB(b, h) + boff + n * 2048 + k * 1024); } while (0)
#define PG8_MMA(ai, bj, At, Bt) do { __builtin_amdgcn_s_setprio(1); _Pragma("unroll") for (int m = 0; m < 4; ++m) _Pragma("unroll") for (int n = 0; n < 2; ++n) _Pragma("unroll") for (int k = 0; k < 2; ++k) \
        acc[ai][bj][m][n] = __builtin_amdgcn_mfma_f32_16x16x32_bf16(Bt[n][k], At[m][k], acc[ai][bj][m][n], 0, 0, 0); __builtin_amdgcn_s_setprio(0); } while (0)
#define PG8_WAIT_V(n) asm volatile("s_waitcnt vmcnt(" #n ")" ::: "memory")
#define PG8_WAIT_L(n) asm volatile("s_waitcnt lgkmcnt(" #n ")" ::: "memory")
#define PG8_BAR __builtin_amdgcn_s_barrier()
#define PG8_SCHED __builtin_amdgcn_sched_barrier(0)
    Unit cur, nxt; int ui = 0;
    if (!S.next(0, cur)) return;
    f32x4 acc[2][2][4][2];
#pragma unroll
    for (int a = 0; a < 2; ++a)
#pragma unroll
        for (int b = 0; b < 2; ++b)
#pragma unroll
            for (int m = 0; m < 4; ++m)
#pragma unroll
                for (int n = 0; n < 2; ++n) acc[a][b][m][n] = (f32x4){0.f, 0.f, 0.f, 0.f};
    bf16x8 At[4][2], B0[2][2], B1[2][2];
    const char* cA = (const char*)g.A + (size_t)cur.pm * tstepA; const char* cB = (const char*)g.Bt + (size_t)cur.pn * tstep;
    S.a_ready(cur);
    PG8_STAGE(PG8_SB(0, 0), cB, voffB); PG8_STAGE(PG8_SA(0, 0), cA, voffA); PG8_STAGE(PG8_SB(0, 1), cB + hstep, voffB); PG8_STAGE(PG8_SA(0, 1), cA + hstep, voffA);
    if (wr == 1) PG8_BAR;
    PG8_WAIT_V(4); PG8_BAR;
    PG8_STAGE(PG8_SB(1, 0), cB + kstep, voffB); PG8_STAGE(PG8_SA(1, 0), cA + kstep, voffA); PG8_STAGE(PG8_SB(1, 1), cB + hstep + kstep, voffB);
    PG8_WAIT_V(6); PG8_BAR;
    PG8_STAMP();
    for (;;) {
        const bool has_next = S.next(ui + 1, nxt);
        const char* nA = has_next ? (const char*)g.A + (size_t)nxt.pm * tstepA : cA; const char* nB = has_next ? (const char*)g.Bt + (size_t)nxt.pn * tstep : cB;
        for (int t = 0; t < nt; t += 2) {
            const bool last = (t == nt - 2);
            const char* a1 = cA + (size_t)(t + 1) * kstep;
            const char* a2 = last ? nA : cA + (size_t)(t + 2) * kstep; const char* b2 = last ? nB : cB + (size_t)(t + 2) * kstep;
            const char* a3 = a2 + kstep; const char* b3 = b2 + kstep;
            if (last && has_next) S.a_ready(nxt);
            PG8_LDB(B0, 0, 0); PG8_SCHED; PG8_LDA(At, 0, 0); PG8_STAGE(PG8_SA(1, 1), a1 + hstep, voffA);
            PG8_WAIT_L(8); PG8_BAR; PG8_WAIT_L(0); PG8_MMA(0, 0, At, B0); PG8_BAR; PG8_SCHED;
            PG8_LDB(B1, 0, 1); PG8_STAGE(PG8_SB(0, 0), b2, voffB);
            PG8_BAR; PG8_WAIT_L(0); PG8_MMA(0, 1, At, B1); PG8_BAR;
            PG8_LDA(At, 0, 1); PG8_STAGE(PG8_SA(0, 0), a2, voffA);
            PG8_BAR; PG8_WAIT_L(0); PG8_MMA(1, 0, At, B0); PG8_BAR; PG8_SCHED;
            PG8_STAGE(PG8_SB(0, 1), b2 + hstep, voffB);
            PG8_WAIT_V(6); PG8_BAR; PG8_MMA(1, 1, At, B1); PG8_BAR;
            PG8_LDB(B0, 1, 0); PG8_SCHED; PG8_LDA(At, 1, 0); PG8_STAGE(PG8_SA(0, 1), a2 + hstep, voffA);
            PG8_WAIT_L(8); PG8_BAR; PG8_WAIT_L(0); PG8_MMA(0, 0, At, B0); PG8_BAR; PG8_SCHED;
            PG8_LDB(B1, 1, 1); PG8_STAGE(PG8_SB(1, 0), b3, voffB);
            PG8_BAR; PG8_WAIT_L(0); PG8_MMA(0, 1, At, B1); PG8_BAR;
            PG8_LDA(At, 1, 1); PG8_STAGE(PG8_SA(1, 0), a3, voffA);
            PG8_BAR; PG8_WAIT_L(0); PG8_MMA(1, 0, At, B0); PG8_BAR; PG8_SCHED;
            PG8_STAGE(PG8_SB(1, 1), b3 + hstep, voffB);
            PG8_WAIT_V(6); PG8_BAR; PG8_MMA(1, 1, At, B1); PG8_BAR;
        }
        PG8_STAMP();
        if constexpr (!Epi::AFTER_DRAIN) { E(acc, cur, wr, wc, fr, fq); S.done(cur); }
        PG8_STAMP();
        if (!has_next) break;
#pragma unroll
        for (int a = 0; a < 2; ++a)
#pragma unroll
            for (int b = 0; b < 2; ++b)
#pragma unroll
                for (int m = 0; m < 4; ++m)
#pragma unroll
                    for (int n = 0; n < 2; ++n) acc[a][b][m][n] = (f32x4){0.f, 0.f, 0.f, 0.f};
        cur = nxt; cA = nA; cB = nB; ++ui;
    }
    PG8_WAIT_V(0);
    if (wr == 0) PG8_BAR;
    PG8_BAR;
    if constexpr (Epi::AFTER_DRAIN) { E.fused(acc, cur, wr, wc, fr, fq, lds, wid, lane); S.done(cur); }
    PG8_STAMP();
    if (STAMP && wid == 0) { stamps[lane] = lane < nts ? (((unsigned long long)(unsigned)ts_hi << 32) | (unsigned)ts_lo) : 0ull;
        if (lane == 62) stamps[62] = rt_entry; if (lane == 63) stamps[63] = (unsigned long long)wall_clock64(); }
#undef PG8_STAMP
#undef PG8_SA
#undef PG8_SB
#undef PG8_STAGE
#undef PG8_LDA
#undef PG8_LDB
#undef PG8_MMA
#undef PG8_WAIT_V
#undef PG8_WAIT_L
#undef PG8_BAR
#undef PG8_SCHED
}
}


struct EpiP1 {
    static constexpr bool PERM = true, AFTER_DRAIN = false;
    bf16_t* ZS; bf16_t* G;
    DI void operator()(const f32x4 (&acc)[2][2][4][2], const pg8::Unit& u, int wr, int wc, int fr, int fq) const {
        const int row0 = u.pm * 256 + wr * 64 + fr, colt = u.pn * 256 + wc * 32 + 8 * fq;
        const bool small = u.pn < NZ / 256;
#pragma unroll
        for (int ai = 0; ai < 2; ++ai)
#pragma unroll
            for (int m = 0; m < 4; ++m) {
                const size_t row = (size_t)(row0 + ai * 128 + m * 16);
#pragma unroll
                for (int bj = 0; bj < 2; ++bj) {
                    const int col = colt + bj * 128;
                    const f32x4 v0 = acc[ai][bj][m][0], v1 = acc[ai][bj][m][1];
                    u32x4 w;
                    if (small) { w.x = pk2(v0.x, v0.y); w.y = pk2(v0.z, v0.w); w.z = pk2(v1.x, v1.y); w.w = pk2(v1.z, v1.w); *(u32x4*)(ZS + row * NZ + col) = w; }
                    else { w.x = pk2(sigmoidf_(v0.x), sigmoidf_(v0.y)); w.y = pk2(sigmoidf_(v0.z), sigmoidf_(v0.w)); w.z = pk2(sigmoidf_(v1.x), sigmoidf_(v1.y)); w.w = pk2(sigmoidf_(v1.z), sigmoidf_(v1.w));
                           *(u32x4*)(G + row * 2048 + (col - NZ)) = w; }
                }
            }
    }
};
template <bool SECOND> struct EpiMix {
    static constexpr bool PERM = true, AFTER_DRAIN = false;
    const bf16_t* G; bf16_t* MIX;
    DI void operator()(const f32x4 (&acc)[2][2][4][2], const pg8::Unit& u, int wr, int wc, int fr, int fq) const {
        const int row0 = u.pm * 256 + wr * 64 + fr, colt = u.pn * 256 + wc * 32 + 8 * fq;
#pragma unroll
        for (int ai = 0; ai < 2; ++ai)
#pragma unroll
            for (int m = 0; m < 4; ++m) {
                const size_t row = (size_t)(row0 + ai * 128 + m * 16);
#pragma unroll
                for (int bj = 0; bj < 2; ++bj) {
                    const int col = colt + bj * 128;
                    float gv[8], o[8];
                    unpack8(*(const u32x4*)(G + row * 2048 + (SECOND ? 1024 : 0) + col), gv);
                    const f32x4 v0 = acc[ai][bj][m][0], v1 = acc[ai][bj][m][1];
                    if (SECOND) unpack8(*(const u32x4*)(MIX + row * 1024 + col), o);
                    else { for (int e = 0; e < 8; ++e) o[e] = 0.f; }
                    o[0] += gv[0] * v0.x; o[1] += gv[1] * v0.y; o[2] += gv[2] * v0.z; o[3] += gv[3] * v0.w;
                    o[4] += gv[4] * v1.x; o[5] += gv[5] * v1.y; o[6] += gv[6] * v1.z; o[7] += gv[7] * v1.w;
                    u32x4 w; w.x = pk2(o[0], o[1]); w.y = pk2(o[2], o[3]); w.z = pk2(o[4], o[5]); w.w = pk2(o[6], o[7]);
                    *(u32x4*)(MIX + row * 1024 + col) = w;
                }
            }
    }
};
template <bool INPLACE> struct EpiRes {
    static constexpr bool PERM = false, AFTER_DRAIN = false;
    const float* xp; const float* xs; float* out; const float* gate;
    DI void operator()(const f32x4 (&acc)[2][2][4][2], const pg8::Unit& u, int wr, int wc, int fr, int fq) const {
        const int row0 = u.pm * 256 + wr * 64 + fr, colt = u.pn * 256 + wc * 32 + 4 * fq;
        const float* gt = gate + (size_t)((u.pm * 256) >> 12) * 6144;
#pragma unroll
        for (int ai = 0; ai < 2; ++ai)
#pragma unroll
            for (int m = 0; m < 4; ++m) {
                const int row = row0 + ai * 128 + m * 16;
                float* orow = out + (size_t)row * D;
                const float* brow = INPLACE ? orow : (row < T_PROMPT ? xp + (size_t)row * D : xs + (size_t)(row - T_PROMPT) * D);
#pragma unroll
                for (int bj = 0; bj < 2; ++bj)
#pragma unroll
                    for (int n = 0; n < 2; ++n) {
                        const int col = colt + bj * 128 + n * 16;
                        const f32x4 xv = *(const f32x4*)(brow + col), gv = *(const f32x4*)(gt + col);
                        *(f32x4*)(orow + col) = xv + gv * acc[ai][bj][m][n];
                    }
            }
    }
};

DI void transpose_item(const float* __restrict__ W, int K, int N, bf16_t* __restrict__ WT, int mode, const float* __restrict__ scale,
                       float* scr, int item, int lane) {
    const int nblk = N >> 5, kb = item / nblk, nb = item % nblk, k0 = kb * 64, n0 = nb * 32;
#pragma unroll 8
    for (int i = 0; i < 32; ++i) {
        const int kk = 2 * i + (lane >> 5);
        float v = W[(size_t)(k0 + kk) * N + n0 + (lane & 31)];
        if (scale) v *= scale[k0 + kk];
        scr[kk * 33 + (lane & 31)] = v;
    }
    asm volatile("s_waitcnt lgkmcnt(0)" ::: "memory");
    const int c = lane & 7;
#pragma unroll
    for (int j = 0; j < 4; ++j) {
        const int nl = (lane >> 3) + 8 * j;
        const float* s = scr + (8 * c) * 33 + nl;
        u32x4 o;
        o.x = pk2(s[0 * 33], s[1 * 33]); o.y = pk2(s[2 * 33], s[3 * 33]); o.z = pk2(s[4 * 33], s[5 * 33]); o.w = pk2(s[6 * 33], s[7 * 33]);
        const int n = n0 + nl;
        int row;
        if (mode == 1) row = n < 1184 ? n : n + 96;
        else if (mode == 2) { const int h = n >> 7, jj = n & 127; row = jj < 64 ? h * 64 + jj : 512 + h * 64 + (jj - 64); }
        else if (mode == 3) { const int hf = n >= DFF ? 1 : 0, m2 = n - hf * DFF; row = (m2 >> 7) * 256 + hf * 128 + (m2 & 127); }
        else row = n;
        *(u32x4*)(WT + (size_t)row * K + k0 + 8 * c) = o;
    }
    asm volatile("s_waitcnt lgkmcnt(0)" ::: "memory");
}

DI void phase0(const Params& p, char* lds) {
    const int tid_ = opaque_tid();
    const int tid = TID4, bid = VBID, G = VGRID, lane = tid & 63, wave = tid >> 6;
    unsigned char* ws = p.ws;
    float* sc = (float*)lds;
    for (int it = bid; it < 384; it += G) {
        const int cb = it % 24, ks = it / 24;
        __syncthreads();
        for (int i = tid; i < 24 * 64; i += 256) {
            const int b = i >> 6, k = i & 63;
            const float* c = b < 8 ? p.in[2] + b * 1024 : p.in[3] + (b - 8) * 1024;
            const float v = c[ks * 64 + k];
            sc[i] = v * sigmoidf_(v);
        }
        __syncthreads();
        float a[24];
#pragma unroll
        for (int b = 0; b < 24; ++b) a[b] = 0.f;
        const int n = cb * 256 + tid;
        const float* w = p.in[4] + (size_t)(ks * 64) * 6144 + n;
        for (int k = 0; k < 64; ++k) {
            const float wv = w[(size_t)k * 6144];
#pragma unroll
            for (int b = 0; b < 24; ++b) a[b] += sc[b * 64 + k] * wv;
        }
        float* mp = (float*)(ws + O_MODP) + (size_t)(ks * 24) * 6144 + n;
#pragma unroll
        for (int b = 0; b < 24; ++b) mp[(size_t)b * 6144] = a[b];
    }
    __syncthreads();
    {
        float* scr = (float*)(lds + wave * 8448);
        const int gw = bid * 4 + wave, NGW = G * 4;
        constexpr int I0 = 16 * 101, I1 = 4 * 24, I2 = 2 * 32, I3 = 8 * 32, I4 = 8 * 32, I5 = 16 * 32, I6 = 16 * 176, I7 = 44 * 32;
        constexpr int NI = I0 + I1 + I2 + I3 + I4 + I5 + I6 + I7;
        for (int it = gw; it < NI; it += NGW) {
            int q = it;
            if (q < I0) { transpose_item(p.in[7], 1024, IN_TOTAL, (bf16_t*)(ws + O_WIN), 1, nullptr, scr, q, lane); continue; } q -= I0;
            if (q < I1) { transpose_item(p.in[12], 256, 768, (bf16_t*)(ws + O_WUQ), 0, p.in[11], scr, q, lane); continue; } q -= I1;
            if (q < I2) { transpose_item(p.in[14], 128, 1024, (bf16_t*)(ws + O_WUKV), 2, p.in[13], scr, q, lane); continue; } q -= I2;
            if (q < I3) { transpose_item(p.in[17], 512, 1024, (bf16_t*)(ws + O_WOA), 0, nullptr, scr, q, lane); continue; } q -= I3;
            if (q < I4) { transpose_item(p.in[18], 512, 1024, (bf16_t*)(ws + O_WOB), 0, nullptr, scr, q, lane); continue; } q -= I4;
            if (q < I5) { transpose_item(p.in[19], 1024, 1024, (bf16_t*)(ws + O_WOUT), 0, nullptr, scr, q, lane); continue; } q -= I5;
            if (q < I6) { transpose_item(p.in[21], 1024, NUP, (bf16_t*)(ws + O_WUP), 3, nullptr, scr, q, lane); continue; } q -= I6;
            transpose_item(p.in[24], DFF, 1024, (bf16_t*)(ws + O_WDN), 0, nullptr, scr, q, lane);
        }
    }
    const int gt = bid * 256 + tid, NGT = G * 256;
    for (int i = gt; i < 4096 * 48; i += NGT) {
        const int pos = i / 48, j = i % 48;
        float inv;
        if (j < 32) inv = exp2f(-(float)(2 * j) * (1.f / 64.f) * 13.287712379549449f);
        else inv = exp2f(-(float)(2 * (j - 32)) * (1.f / 32.f) * 13.287712379549449f);
        const float ang = (float)pos * inv;
        float rev = ang * 0.15915494309189535f;
        rev -= floorf(rev);
        const float sn = __builtin_amdgcn_sinf(rev), cs = __builtin_amdgcn_cosf(rev);
        float2* dst = j < 32 ? (float2*)(ws + O_ROPEA) + pos * 32 + j : (float2*)(ws + O_ROPEB) + pos * 16 + (j - 32);
        *dst = make_float2(cs, sn);
    }
    for (int i = gt; i < 96 * 1024 / 8; i += NGT) *(u32x4*)((bf16_t*)(ws + O_WIN) + 1184 * 1024 + (size_t)i * 8) = (u32x4){0u, 0u, 0u, 0u};
    if (gt < 256) *(u32x4*)(ws + O_ZROW + gt * 16) = (u32x4){0u, 0u, 0u, 0u};
}

DI void phase0m(const Params& p) {
    const int tid_ = opaque_tid();
    const int gt = VBID * 256 + TID4, NGT = VGRID * 256;
    const float* mp = (const float*)(p.ws + O_MODP);
    float* mod = (float*)(p.ws + O_MOD);
    for (int i = gt; i < 24 * 6144; i += NGT) {
        float s = p.in[5][i % 6144];
#pragma unroll
        for (int ks = 0; ks < 16; ++ks) s += mp[(size_t)ks * 24 * 6144 + i];
        mod[i] = s;
    }
}

DI void norm_pass(const Params& p, bool second, bf16_t* dst) {
    const int tid_ = opaque_tid();
    const int lane = TID4 & 63, gw = VBID * 4 + (TID4 >> 6), NGW = VGRID * 4;
    const float* gwt = second ? p.in[20] : p.in[6];
    const float* mod = (const float*)(p.ws + O_MOD);
    f32x4 gv[4];
#pragma unroll
    for (int j = 0; j < 4; ++j) gv[j] = *((const f32x4*)gwt + 64 * j + lane);
    for (int t = gw; t < T; t += NGW) {
        const float* xr = second ? p.out + (size_t)t * D : xrow_ptr(p, t);
        const int b = t >> 12;
        const float* sh = mod + (size_t)b * 6144 + (second ? 3072 : 0);
        const float* sc = sh + 1024;
        f32x4 v[4]; float s = 0.f;
#pragma unroll
        for (int j = 0; j < 4; ++j) { v[j] = *((const f32x4*)xr + 64 * j + lane); s += (v[j].x * v[j].x + v[j].y * v[j].y) + (v[j].z * v[j].z + v[j].w * v[j].w); }
        const float rstd = rsqrtf(wave_sum(s) * (1.f / D) + EPS);
        u32x2* o = (u32x2*)(dst + (size_t)(second ? t + b + 1 : t) * D) + lane;
#pragma unroll
        for (int j = 0; j < 4; ++j) {
            const f32x4 scv = *((const f32x4*)sc + 64 * j + lane), shv = *((const f32x4*)sh + 64 * j + lane);
            f32x4 y;
            y.x = v[j].x * rstd * gv[j].x * (1.f + scv.x) + shv.x; y.y = v[j].y * rstd * gv[j].y * (1.f + scv.y) + shv.y;
            y.z = v[j].z * rstd * gv[j].z * (1.f + scv.z) + shv.z; y.w = v[j].w * rstd * gv[j].w * (1.f + scv.w) + shv.w;
            o[64 * j] = (u32x2){pk2(y.x, y.y), pk2(y.z, y.w)};
        }
    }
    if (second) {
        constexpr int NZR = 25 + (H2P_ROWS - (NBATCH * SEQP + 1));
        for (int z = gw; z < NZR; z += NGW) {
            const int pr = z < 25 ? z * SEQP : NBATCH * SEQP + 1 + (z - 25);
            u32x2* o = (u32x2*)(dst + (size_t)pr * D) + lane;
#pragma unroll
            for (int j = 0; j < 4; ++j) o[64 * j] = (u32x2){0u, 0u};
        }
    }
}

DI void phase1(const Params& p, char* lds) {
    pg8::Gemm g{(const bf16_t*)(p.ws + O_H), (const bf16_t*)(p.ws + O_WIN), T, NIN, 1024};
    pg8::StaticOrder so; so.init(T, NIN, gridDim.x, blockIdx.x);
    EpiP1 E{(bf16_t*)(p.ws + O_ZS), (bf16_t*)((unsigned char*)p.out + OO_G)};
    pg8::gemm_phase<EpiP1, pg8::StaticOrder, false>((PG8_LAS unsigned char*)lds, g, so, E, nullptr);
}

template <int NCH>
DI float row_sumsq(const bf16_t* rowp, int g) {
    float s = 0.f;
#pragma unroll
    for (int c = 0; c < NCH; ++c) {
        const u32x4 v = *(const u32x4*)(rowp + (g * NCH + c) * 8);
#pragma unroll
        for (int e = 0; e < 4; ++e) { const float a = bflo(v[e]), b = bfhi(v[e]); s += a * a + b * b; }
    }
    return xor_reduce_g(s);
}

DI void phase2(const Params& p, char* lds) {
    const int tid_ = opaque_tid();
    unsigned char* ws = p.ws;
    const bf16_t* ZS = (const bf16_t*)(ws + O_ZS);
    const int tid = TID4, lane = tid & 63, wave = tid >> 6, r = lane & 15, g = lane >> 4;
    const float2* ropeA = (const float2*)(ws + O_ROPEA);
    const float2* ropeB = (const float2*)(ws + O_ROPEB);
    constexpr int NTL = T / 128;
    for (int it = VBID; it < NTL * 8; it += VGRID) {
        const int tile = it >> 3, sub = it & 7, t0 = tile * 128, b = t0 >> 12, s0 = t0 & (S - 1);
        {
            const int h = sub;
            f32x4 acc[2][6]; zero_acc(acc);
            gemm_mainloop<128, 96, 4, 1>(acc, ZS + (size_t)t0 * NZ + 768, NZ, (const bf16_t*)(ws + O_WUQ) + (size_t)h * 96 * 256, 256, 256, lds, tid);
            const float* gq = p.in[15];
            const float qs = 0.10206207261596577f * LOG2E;
            bf16_t* QB = (bf16_t*)(ws + O_QB) + ((size_t)(b * 8 + h) * S) * 96;
#pragma unroll
            for (int mt = 0; mt < 2; ++mt) {
                const int ml = wave * 32 + mt * 16 + r, sp = s0 + ml;
                const float rstd = rsqrtf(row_sumsq<8>(ZS + (size_t)(t0 + ml) * NZ + 768, g) * (1.f / 256.f) + EPS);
                float ss = 0.f;
#pragma unroll
                for (int nt = 0; nt < 6; ++nt) { acc[mt][nt] = acc[mt][nt] * rstd; const f32x4 a = acc[mt][nt]; ss += (a.x * a.x + a.y * a.y) + (a.z * a.z + a.w * a.w); }
                const float r2 = rsqrtf(xor_reduce_g(ss) * (1.f / 96.f) + EPS);
#pragma unroll
                for (int nt = 0; nt < 6; ++nt) {
                    const f32x4 gg = *(const f32x4*)(gq + nt * 16 + g * 4);
                    acc[mt][nt] = acc[mt][nt] * r2 * gg;
                }
#pragma unroll
                for (int j = 0; j < 4; ++j) {
                    const float2 cs = ropeB[sp * 16 + g * 4 + j];
                    const float x1 = acc[mt][4][j], x2 = acc[mt][5][j];
                    acc[mt][4][j] = x1 * cs.x - x2 * cs.y;
                    acc[mt][5][j] = x1 * cs.y + x2 * cs.x;
                }
                bf16_t* qrow = QB + (size_t)sp * 96 + g * 4;
#pragma unroll
                for (int nt = 0; nt < 6; ++nt) { const f32x4 a = acc[mt][nt] * qs; *(u32x2*)(qrow + nt * 16) = (u32x2){pk2(a.x, a.y), pk2(a.z, a.w)}; }
                __builtin_amdgcn_sched_barrier(0);
            }
        }
    }
    for (int it = VBID; it < NTL * 4; it += VGRID) {
        const int tile = it >> 2, hp = it & 3, t0 = tile * 128, b = t0 >> 12, s0 = t0 & (S - 1);
        {
            f32x4 acc[4][4]; zero_acc(acc);
            gemm_mainloop<128, 128, 2, 2>(acc, ZS + (size_t)t0 * NZ + 1024, NZ,
                                          (const bf16_t*)(ws + O_WUKV) + (size_t)(hp * 128) * 128, 128, 128, lds, tid);
            const int wm = wave >> 1, wn = wave & 1, h = hp * 2 + wn;
            {
                const float* gk = p.in[16];
                bf16_t* KB = (bf16_t*)(ws + O_KB) + ((size_t)(b * 8 + h) * S) * 96;
#pragma unroll
                for (int mt = 0; mt < 4; ++mt) {
                    const int ml = wm * 64 + mt * 16 + r, sp = s0 + ml;
                    const bf16_t* zrow = ZS + (size_t)(t0 + ml) * NZ;
                    const float rstd = rsqrtf(row_sumsq<4>(zrow + 1024, g) * (1.f / 128.f) + EPS);
                    const u32x2 k1 = *(const u32x2*)(zrow + 1152 + g * 4), k2 = *(const u32x2*)(zrow + 1168 + g * 4);
                    float x1[4] = {bflo(k1.x), bfhi(k1.x), bflo(k1.y), bfhi(k1.y)};
                    float x2[4] = {bflo(k2.x), bfhi(k2.x), bflo(k2.y), bfhi(k2.y)};
                    float ss = 0.f;
#pragma unroll
                    for (int j = 0; j < 4; ++j) ss += x1[j] * x1[j] + x2[j] * x2[j];
#pragma unroll
                    for (int nt = 0; nt < 4; ++nt) { acc[mt][nt] = acc[mt][nt] * rstd; const f32x4 a = acc[mt][nt]; ss += (a.x * a.x + a.y * a.y) + (a.z * a.z + a.w * a.w); }
                    const float r2 = rsqrtf(xor_reduce_g(ss) * (1.f / 96.f) + EPS);
                    bf16_t* krow = KB + (size_t)sp * 96 + g * 4;
#pragma unroll
                    for (int nt = 0; nt < 4; ++nt) {
                        const f32x4 gg = *(const f32x4*)(gk + nt * 16 + g * 4);
                        const f32x4 a = acc[mt][nt] * r2 * gg;
                        *(u32x2*)(krow + nt * 16) = (u32x2){pk2(a.x, a.y), pk2(a.z, a.w)};
                    }
                    const f32x4 g1 = *(const f32x4*)(gk + 64 + g * 4), g2 = *(const f32x4*)(gk + 80 + g * 4);
                    float o1[4], o2[4];
#pragma unroll
                    for (int j = 0; j < 4; ++j) {
                        const float2 cs = ropeB[sp * 16 + g * 4 + j];
                        const float y1 = x1[j] * r2 * g1[j], y2 = x2[j] * r2 * g2[j];
                        o1[j] = y1 * cs.x - y2 * cs.y; o2[j] = y1 * cs.y + y2 * cs.x;
                    }
                    *(u32x2*)(krow + 64) = (u32x2){pk2(o1[0], o1[1]), pk2(o1[2], o1[3])};
                    *(u32x2*)(krow + 80) = (u32x2){pk2(o2[0], o2[1]), pk2(o2[2], o2[3])};
                    __builtin_amdgcn_sched_barrier(0);
                }
            }
        }
    }
    for (int it = VBID; it < NTL * 4; it += VGRID) {
        const int tile = it >> 2, hp = it & 3, t0 = tile * 128, b = t0 >> 12, s0 = t0 & (S - 1);
        {
            f32x4 acc[4][4]; zero_acc(acc);
            gemm_mainloop<128, 128, 2, 2>(acc, ZS + (size_t)t0 * NZ + 1024, NZ,
                                          (const bf16_t*)(ws + O_WUKV) + (size_t)(512 + hp * 128) * 128, 128, 128, lds, tid);
            const int wm = wave >> 1, wn = wave & 1, h = hp * 2 + wn;
            {
                bf16_t* VT = (bf16_t*)(ws + O_VTB) + ((size_t)(b * 8 + h) * 64) * S;
#pragma unroll
                for (int mt = 0; mt < 4; ++mt) {
                    const int ml = wm * 64 + mt * 16 + r, sp = s0 + ml;
                    const float rstd = rsqrtf(row_sumsq<4>(ZS + (size_t)(t0 + ml) * NZ + 1024, g) * (1.f / 128.f) + EPS);
                    const int ps = perm32(sp);
#pragma unroll
                    for (int nt = 0; nt < 4; ++nt)
#pragma unroll
                        for (int j = 0; j < 4; ++j) VT[(size_t)(nt * 16 + g * 4 + j) * S + ps] = f2bf(acc[mt][nt][j] * rstd);
                    __builtin_amdgcn_sched_barrier(0);
                }
            }
        }
    }
    __syncthreads();
    for (int tile = VBID; tile < NTL; tile += VGRID) {
        const int t0 = tile * 128, b = t0 >> 12, s0 = t0 & (S - 1);
        {
            const float* gqa = p.in[8];
            const float* gka = p.in[9];
            const int half = lane >> 5, i = lane & 31;
            const float qs = 0.125f * LOG2E;
            const float gq1 = gqa[i], gq2 = gqa[32 + i], gk1 = gka[i], gk2 = gka[32 + i];
            for (int tt0 = wave * 4; tt0 < 128; tt0 += 16) {
                float x1[4][5], x2[4][5]; float2 cs[4];
#pragma unroll
                for (int u = 0; u < 4; ++u) {
                    const bf16_t* zrow = ZS + (size_t)(t0 + tt0 + u) * NZ;
                    cs[u] = ropeA[(s0 + tt0 + u) * 32 + i];
#pragma unroll
                    for (int q = 0; q < 5; ++q) { const int hd = 2 * q + half; x1[u][q] = bf2f(zrow[hd * 64 + i]); x2[u][q] = bf2f(zrow[hd * 64 + 32 + i]); }
                }
#pragma unroll
                for (int u = 0; u < 4; ++u) {
                    const int sp = s0 + tt0 + u;
#pragma unroll
                    for (int q = 0; q < 5; ++q) {
                        const int hd = 2 * q + half;
                        float ss = x1[u][q] * x1[u][q] + x2[u][q] * x2[u][q];
#pragma unroll
                        for (int o = 1; o < 32; o <<= 1) ss += __shfl_xor(ss, o);
                        const float rr = rsqrtf(ss * (1.f / 64.f) + EPS);
                        const bool isq = q < 4;
                        const float y1 = x1[u][q] * rr * (isq ? gq1 : gk1), y2 = x2[u][q] * rr * (isq ? gq2 : gk2);
                        float o1 = y1 * cs[u].x - y2 * cs[u].y, o2 = y1 * cs[u].y + y2 * cs[u].x;
                        bf16_t* dst;
                        if (isq) { o1 *= qs; o2 *= qs; dst = (bf16_t*)(ws + O_QA) + ((size_t)(b * 8 + hd) * S + sp) * 64; }
                        else dst = (bf16_t*)(ws + O_KA) + ((size_t)(b * 2 + (hd - 8)) * S + sp) * 64;
                        dst[i] = f2bf(o1); dst[32 + i] = f2bf(o2);
                    }
                }
            }
            __syncthreads();
            bf16_t* tl = (bf16_t*)lds;
            for (int idx = tid; idx < 128 * 16; idx += 256) {
                const int tt = idx >> 4, c = idx & 15;
                const u32x4 v = *(const u32x4*)(ZS + (size_t)(t0 + tt) * NZ + 640 + c * 8);
                u32x2* d2 = (u32x2*)(tl + tt * 132 + c * 8);
                d2[0] = (u32x2){v.x, v.y}; d2[1] = (u32x2){v.z, v.w};
            }
            __syncthreads();
            bf16_t* VT = (bf16_t*)(ws + O_VTA) + ((size_t)(b * 2) * 64) * S;
            for (int idx = tid; idx < 128 * 128; idx += 256) {
                const int pp = idx & 127, dd = idx >> 7;
                const int lo = pp & 31;
                const int tt = (pp & ~31) | (((lo >> 2) & 1) << 4) | ((lo >> 3) << 2) | (lo & 3);
                VT[(size_t)dd * S + s0 + pp] = tl[tt * 132 + dd];
            }
            __syncthreads();
        }
    }
}

template <int DQK, bool WIN>
DI void attn_item(const bf16_t* __restrict__ Qw, const bf16_t* __restrict__ Kb, const bf16_t* __restrict__ Vt, int key0, int ntiles, int q0,
                  float shift2, float sink_term, bf16_t* __restrict__ Ow, int ldo, char* lds, const int tid) {
    constexpr int QT = 4, KS = DQK / 32, CH = DQK / 8, KROW = DQK * 2, KBYTES = 64 * KROW, NKI = KBYTES / 1024, STAGE = KBYTES + 8192;
    const int lane = tid & 63, r = lane & 15, g = lane >> 4, wave = __builtin_amdgcn_readfirstlane(tid >> 6);
    bf16x8 qf[QT][KS];
#pragma unroll
    for (int qt = 0; qt < QT; ++qt)
#pragma unroll
        for (int ks = 0; ks < KS; ++ks) qf[qt][ks] = *(const bf16x8*)(Qw + (size_t)(qt * 16 + r) * DQK + ks * 32 + g * 8);
    f32x4 oacc[4][QT];
    float lsum[QT];
#pragma unroll
    for (int qt = 0; qt < QT; ++qt) {
        lsum[qt] = 0.f;
#pragma unroll
        for (int i = 0; i < 4; ++i) oacc[i][qt] = (f32x4){0.f, 0.f, 0.f, 0.f};
    }
    int ksrc[2];
#pragma unroll
    for (int i = 0; i < 2; ++i) {
        const int pch = (wave + 8 * i) * 64 + lane, row = pch / CH, c = pch % CH;
        const int sc = (DQK == 96) ? ((c & ~3) | ((c & 3) ^ ((0x78 >> (2 * ((row >> 2) & 3))) & 3))) : (c ^ ((row >> 1) & 7));
        ksrc[i] = row * DQK + sc * 8;
    }
    const int vrow = tid >> 3, vsrc = ((tid & 7) ^ ((vrow >> 1) & 7)) * 8;
    const bf16_t* Vp = Vt + (size_t)vrow * S + vsrc;
    auto issue = [&](int tile, int st) {
        const int kb = key0 + tile * 64;
        char* d = lds + st * STAGE + tid * 16;
        __builtin_amdgcn_global_load_lds((const GAS unsigned*)(Kb + (size_t)kb * DQK + ksrc[0]), (LAS unsigned*)(d), 16, 0, 0);
        if (NKI > 8 && wave < NKI - 8)
            __builtin_amdgcn_global_load_lds((const GAS unsigned*)(Kb + (size_t)kb * DQK + ksrc[1]), (LAS unsigned*)(d + 8192), 16, 0, 0);
        __builtin_amdgcn_global_load_lds((const GAS unsigned*)(Vp + kb), (LAS unsigned*)(d + KBYTES), 16, 0, 0);
    };
    const int ksw = (DQK == 96) ? ((0x78 >> (2 * ((r >> 2) & 3))) & 3) : ((r >> 1) & 7);
    const int vsw = (r >> 1) & 7;
    const f32x4 sinit = (f32x4){-shift2, -shift2, -shift2, -shift2};
    __syncthreads();
    issue(0, 0);
    __syncthreads();
    for (int tile = 0; tile < ntiles; ++tile) {
        const int cur = tile & 1;
        if (tile + 1 < ntiles) issue(tile + 1, cur ^ 1);
        const char* sK = lds + cur * STAGE; const char* sV = sK + KBYTES;
#pragma unroll
        for (int kk = 0; kk < 2; ++kk) {
            f32x4 sacc[2][QT];
#pragma unroll
            for (int a = 0; a < 2; ++a) {
#pragma unroll
                for (int qt = 0; qt < QT; ++qt) sacc[a][qt] = sinit;
#pragma unroll
                for (int ks = 0; ks < KS; ++ks) {
                    const int kch = (DQK == 96) ? (ks * 4 + (g ^ ksw)) : ((ks * 4 + g) ^ ksw);
                    const bf16x8 kf = *(const bf16x8*)(sK + ((2 * kk + a) * 16 + r) * KROW + kch * 16);
#pragma unroll
                    for (int qt = 0; qt < QT; ++qt) sacc[a][qt] = __builtin_amdgcn_mfma_f32_16x16x32_bf16(kf, qf[qt][ks], sacc[a][qt], 0, 0, 0);
                }
            }
            const int kbase = key0 + tile * 64 + kk * 32 + g * 4;
            bf16x8 pb[QT];
#pragma unroll
            for (int qt = 0; qt < QT; ++qt) {
#pragma unroll
                for (int a = 0; a < 2; ++a)
#pragma unroll
                    for (int j = 0; j < 4; ++j) {
                        float pv = fast_exp2(sacc[a][qt][j]);
                        if (WIN) { const int dlt = (kbase + a * 16 + j) - (q0 + qt * 16 + r); if (dlt > 128 || dlt < -128) pv = 0.f; }
                        sacc[a][qt][j] = pv; lsum[qt] += pv;
                    }
                u32x4 u;
                u.x = pk2(sacc[0][qt][0], sacc[0][qt][1]); u.y = pk2(sacc[0][qt][2], sacc[0][qt][3]);
                u.z = pk2(sacc[1][qt][0], sacc[1][qt][1]); u.w = pk2(sacc[1][qt][2], sacc[1][qt][3]);
                pb[qt] = __builtin_bit_cast(bf16x8, u);
            }
#pragma unroll
            for (int dt = 0; dt < 4; ++dt) {
                const bf16x8 vf = *(const bf16x8*)(sV + (dt * 16 + r) * 128 + (((kk * 4 + g) ^ vsw) * 16));
#pragma unroll
                for (int qt = 0; qt < QT; ++qt) oacc[dt][qt] = __builtin_amdgcn_mfma_f32_16x16x32_bf16(vf, pb[qt], oacc[dt][qt], 0, 0, 0);
            }
            __builtin_amdgcn_sched_barrier(0);
        }
        __syncthreads();
    }
#pragma unroll
    for (int qt = 0; qt < QT; ++qt) {
        const float inv = fast_rcp(xor_reduce_g(lsum[qt]) + sink_term);
        bf16_t* orow = Ow + (size_t)(qt * 16 + r) * ldo + g * 4;
#pragma unroll
        for (int dt = 0; dt < 4; ++dt) { const f32x4 a = oacc[dt][qt] * inv; *(u32x2*)(orow + dt * 16) = (u32x2){pk2(a.x, a.y), pk2(a.z, a.w)}; }
    }
}

DI float max_abs(const float* v, int n) { float m = 0.f; for (int i = 0; i < n; ++i) m = fmaxf(m, fabsf(v[i])); return m; }

DI void phase3(const Params& p, char* lds) {
    unsigned char* ws = p.ws;
    const int tid = opaque_tid(), wave = tid >> 6;
    const float shiftB = 9.797958971132712f * max_abs(p.in[15], 96) * max_abs(p.in[16], 96) * LOG2E;
    const float shiftA = 8.f * max_abs(p.in[8], 64) * max_abs(p.in[9], 64) * LOG2E;
    bf16_t* OA = (bf16_t*)(p.ws + O_OA);
    bf16_t* OB = (bf16_t*)(p.ws + O_OB);
    constexpr int NB_ITEMS = 24 * 8 * 8, NA_ITEMS = 24 * 2 * 32;
    for (int L = blockIdx.x; L < NB_ITEMS; L += gridDim.x) {
        const int idx = (L & 7) * (NB_ITEMS / 8) + (L >> 3);
        const int bh = idx >> 3, qb = idx & 7, b = bh >> 3, h = bh & 7;
        const int q0 = qb * 512 + wave * 64;
        attn_item<96, false>((const bf16_t*)(ws + O_QB) + ((size_t)bh * S + q0) * 96, (const bf16_t*)(ws + O_KB) + (size_t)bh * S * 96,
                             (const bf16_t*)(ws + O_VTB) + (size_t)bh * 64 * S, 0, S / 64, q0, shiftB, 0.f,
                             OB + ((size_t)b * S + q0) * 512 + h * 64, 512, lds, tid);
    }
    for (int L = blockIdx.x; L < NA_ITEMS; L += gridDim.x) {
        const int idx = (L & 7) * (NA_ITEMS / 8) + (L >> 3);
        const int bk = idx >> 5, qb = idx & 31, b = bk >> 1, kvh = bk & 1;
        const int q0 = qb * 128 + (wave >> 2) * 64, hd = kvh * 4 + (wave & 3);
        int ks = qb * 128 - 128; if (ks < 0) ks = 0; if (ks > S - 384) ks = S - 384;
        const float sink_term = fast_exp2(p.in[10][hd] * LOG2E - shiftA);
        attn_item<64, true>((const bf16_t*)(ws + O_QA) + ((size_t)(b * 8 + hd) * S + q0) * 64, (const bf16_t*)(ws + O_KA) + (size_t)bk * S * 64,
                            (const bf16_t*)(ws + O_VTA) + (size_t)bk * 64 * S, ks, 6, q0, shiftA, sink_term,
                            OA + ((size_t)b * S + q0) * 512 + hd * 64, 512, lds, tid);
    }
}

DI void phase4(const Params& p, char* lds) {
    const bf16_t* Gt = (const bf16_t*)((unsigned char*)p.out + OO_G);
    bf16_t* MIX = (bf16_t*)(p.ws + O_ZS);
    pg8::StaticOrder so; so.init(T, 1024, gridDim.x, blockIdx.x);
    {
        pg8::Gemm g{(const bf16_t*)(p.ws + O_OA), (const bf16_t*)(p.ws + O_WOA), T, 1024, 512};
        EpiMix<false> E{Gt, MIX};
        pg8::gemm_phase<EpiMix<false>, pg8::StaticOrder, false>((PG8_LAS unsigned char*)lds, g, so, E, nullptr);
    }
    {
        pg8::Gemm g{(const bf16_t*)(p.ws + O_OB), (const bf16_t*)(p.ws + O_WOB), T, 1024, 512};
        EpiMix<true> E{Gt, MIX};
        pg8::gemm_phase<EpiMix<true>, pg8::StaticOrder, false>((PG8_LAS unsigned char*)lds, g, so, E, nullptr);
    }
}

DI void phase5(const Params& p, char* lds) {
    pg8::Gemm g{(const bf16_t*)(p.ws + O_ZS), (const bf16_t*)(p.ws + O_WOUT), T, 1024, 1024};
    pg8::StaticOrder so; so.init(T, 1024, gridDim.x, blockIdx.x);
    EpiRes<false> E{p.in[0], p.in[1], p.out, (const float*)(p.ws + O_MOD) + 2048};
    pg8::gemm_phase<EpiRes<false>, pg8::StaticOrder, false>((PG8_LAS unsigned char*)lds, g, so, E, nullptr);
}

struct OneUnit {
    pg8::Unit u;
    DI bool next(int i, pg8::Unit& o) const { if (i) return false; o = u; return true; }
    DI void a_ready(const pg8::Unit&) const {}
    DI void done(const pg8::Unit&) const {}
};
struct EpiConv {
    static constexpr bool PERM = true, AFTER_DRAIN = true;
    bf16_t* ACT; const float* cw; const float* cb;
    DI void operator()(const f32x4 (&)[2][2][4][2], const pg8::Unit&, int, int, int, int) const {}
    DI void fused(const f32x4 (&acc)[2][2][4][2], const pg8::Unit& u, int wr, int wc, int fr, int fq, PG8_LAS unsigned char* lds, int wid, int lane) const {
#pragma unroll
        for (int ai = 0; ai < 2; ++ai)
#pragma unroll
            for (int m = 0; m < 4; ++m) {
                const int row = ai * 128 + wr * 64 + m * 16 + fr;
#pragma unroll
                for (int bj = 0; bj < 2; ++bj) {
                    const int ch = bj * 16 + wc * 4 + fq;
                    const f32x4 v0 = acc[ai][bj][m][0], v1 = acc[ai][bj][m][1];
                    u32x4 w; w.x = pk2(v0.x, v0.y); w.y = pk2(v0.z, v0.w); w.z = pk2(v1.x, v1.y); w.w = pk2(v1.z, v1.w);
                    *(PG8_LAS u32x4*)(lds + row * 512 + ((ch ^ (row & 31)) * 16)) = w;
                }
            }
        __syncthreads();
        {
            const int tid = wid * 64 + lane, cc = tid & 15, rr = tid >> 4;
            const int ca = u.pn * 128 + cc * 8, cg = DFF + ca;
            float wa[3][8], wg[3][8], ba[8], bg[8];
#pragma unroll
            for (int q = 0; q < 2; ++q) {
#pragma unroll
                for (int t = 0; t < 3; ++t) {
                    const f32x4 x = *(const f32x4*)(cw + t * NUP + ca + 4 * q), y = *(const f32x4*)(cw + t * NUP + cg + 4 * q);
#pragma unroll
                    for (int e = 0; e < 4; ++e) { wa[t][4 * q + e] = x[e]; wg[t][4 * q + e] = y[e]; }
                }
                const f32x4 x = *(const f32x4*)(cb + ca + 4 * q), y = *(const f32x4*)(cb + cg + 4 * q);
#pragma unroll
                for (int e = 0; e < 4; ++e) { ba[4 * q + e] = x[e]; bg[4 * q + e] = y[e]; }
            }
#pragma unroll 2
            for (int q = 0; q < 8; ++q) {
                const int e1 = rr + 32 * q;
                const int pr1 = u.pm * 254 + e1 - 1;
                const int b = pr1 / SEQP, s = pr1 - b * SEQP;
                if (e1 >= 1 && e1 <= 254 && s < S && b < NBATCH) {
                    float a0[8], a1[8], a2[8], g0[8], g1[8], g2[8];
                    const int r0 = e1 - 1, r1 = e1, r2 = e1 + 1;
                    unpack8(*(const PG8_LAS u32x4*)(lds + r0 * 512 + ((cc ^ (r0 & 31)) * 16)), a0);
                    unpack8(*(const PG8_LAS u32x4*)(lds + r1 * 512 + ((cc ^ (r1 & 31)) * 16)), a1);
                    unpack8(*(const PG8_LAS u32x4*)(lds + r2 * 512 + ((cc ^ (r2 & 31)) * 16)), a2);
                    unpack8(*(const PG8_LAS u32x4*)(lds + r0 * 512 + (((16 + cc) ^ (r0 & 31)) * 16)), g0);
                    unpack8(*(const PG8_LAS u32x4*)(lds + r1 * 512 + (((16 + cc) ^ (r1 & 31)) * 16)), g1);
                    unpack8(*(const PG8_LAS u32x4*)(lds + r2 * 512 + (((16 + cc) ^ (r2 & 31)) * 16)), g2);
                    float av[8];
#pragma unroll
                    for (int e = 0; e < 8; ++e) {
                        const float ua = ba[e] + wa[0][e] * a0[e] + wa[1][e] * a1[e] + wa[2][e] * a2[e];
                        const float ug = bg[e] + wg[0][e] * g0[e] + wg[1][e] * g1[e] + wg[2][e] * g2[e];
                        av[e] = ug * sigmoidf_(ug) * ua;
                    }
                    u32x4 ov; ov.x = pk2(av[0], av[1]); ov.y = pk2(av[2], av[3]); ov.z = pk2(av[4], av[5]); ov.w = pk2(av[6], av[7]);
                    *(u32x4*)(ACT + ((size_t)b * S + s) * DFF + ca) = ov;
                }
            }
        }
        __syncthreads();
    }
};

DI void phase7(const Params& p, char* lds) {
    pg8::Gemm g{(const bf16_t*)(p.ws + O_H2P), (const bf16_t*)(p.ws + O_WUP), 388 * 256, NUP, 1024, 254};
    pg8::StaticOrder so; so.init(388 * 256, NUP, gridDim.x, blockIdx.x);
    EpiConv E{(bf16_t*)(p.ws + O_ACT), p.in[22], p.in[23]};
    for (int i = 0;; ++i) {
        OneUnit one;
        if (!so.next(i, one.u)) break;
        pg8::gemm_phase<EpiConv, OneUnit, false>((PG8_LAS unsigned char*)lds, g, one, E, nullptr);
    }
}

DI void phase8(const Params& p, char* lds) {
    pg8::Gemm g{(const bf16_t*)(p.ws + O_ACT), (const bf16_t*)(p.ws + O_WDN), T, 1024, DFF};
    pg8::StaticOrder so; so.init(T, 1024, gridDim.x, blockIdx.x);
    EpiRes<true> E{p.in[0], p.in[1], p.out, (const float*)(p.ws + O_MOD) + 5120};
    pg8::gemm_phase<EpiRes<true>, pg8::StaticOrder, false>((PG8_LAS unsigned char*)lds, g, so, E, nullptr);
}

__global__ void __launch_bounds__(512) fwd_megakernel(Params p) {
    __shared__ __attribute__((aligned(16))) char lds[131072];
    cg::grid_group grid = cg::this_grid();
    char* lds4 = lds + __builtin_amdgcn_readfirstlane((int)(threadIdx.x >> 8)) * 65536;
    phase0(p, lds4);
    grid.sync();
    phase0m(p);
    grid.sync();
    norm_pass(p, false, (bf16_t*)(p.ws + O_H));
    grid.sync();
    phase1(p, lds);
    grid.sync();
    phase2(p, lds4);
    grid.sync();
    phase3(p, lds);
    grid.sync();
    phase4(p, lds);
    grid.sync();
    phase5(p, lds);
    grid.sync();
    norm_pass(p, true, (bf16_t*)(p.ws + O_H2P));
    grid.sync();
    phase7(p, lds);
    grid.sync();
    phase8(p, lds);
}

extern "C" void kernel_launch(void* const* d_in, const int* in_sizes, int n_in, void* d_out, int out_size, void* d_ws, size_t ws_size,
                              hipStream_t stream) {
    static int grid_blocks = 0;
    if (!grid_blocks) {
        int dev = 0, cus = 0, per_cu = 0;
        hipGetDevice(&dev);
        hipDeviceGetAttribute(&cus, hipDeviceAttributeMultiprocessorCount, dev);
        hipOccupancyMaxActiveBlocksPerMultiprocessor(&per_cu, fwd_megakernel, 512, 0);
        if (per_cu < 1) per_cu = 1;
        if (per_cu > 1) per_cu = 1;
        grid_blocks = cus * per_cu;
        if (n_in != 25 || ws_size < WS_NEED || out_size != T * D)
            fprintf(stderr, "kernel_launch: unexpected sizes n_in=%d ws=%zu out=%d\n", n_in, ws_size, out_size);
    }
    Params p{};
    for (int i = 0; i < 25; ++i) p.in[i] = (const float*)d_in[i];
    p.out = (float*)d_out;
    p.ws = (unsigned char*)d_ws;
    void* args[] = {&p};
    hipError_t e = hipLaunchCooperativeKernel((void*)fwd_megakernel, dim3(grid_blocks), dim3(512), args, 0, stream);
    if (e != hipSuccess) fprintf(stderr, "cooperative launch failed: %s (grid %d)\n", hipGetErrorString(e), grid_blocks);
}
```

```cpp
#include <hip/hip_runtime.h>
#include <hip/hip_cooperative_groups.h>
#include <cstdio>
#include <cstdint>
namespace cg = cooperative_groups;
#ifndef PM
#define PM 4095
#endif
#ifndef DUP
#define DUP 0
#define XSYNC 0
#endif

typedef unsigned short bf16_t;
typedef short bf16x8 __attribute__((ext_vector_type(8)));
typedef float f32x4 __attribute__((ext_vector_type(4)));
typedef unsigned u32x4 __attribute__((ext_vector_type(4)));
typedef unsigned u32x2 __attribute__((ext_vector_type(2)));
#define DI __device__ __forceinline__
__device__ __forceinline__ int opaque_tid() { int t = threadIdx.x; asm volatile("" : "+v"(t)); return t; }
#define TID4 (tid_ & 255)
#define VBID ((int)(blockIdx.x * 2 + (tid_ >> 8)))
#define VGRID ((int)(gridDim.x * 2))

constexpr int D = 1024, S = 4096, NBATCH = 24, T = NBATCH * S;
constexpr int T_PROMPT = 8 * S;
constexpr int IN_TOTAL = 3232, NZ = 1280  , NIN = NZ + 2048;
constexpr int DFF = 2816, NUP = 2 * DFF;
constexpr float EPS = 1e-6f;
constexpr float LOG2E = 1.4426950408889634f;
constexpr int NCHUNK = 4, TCH = T / NCHUNK;

constexpr size_t MiB = 1024ull * 1024ull;
constexpr size_t O_WIN = 0;
constexpr size_t O_WUQ = O_WIN + (size_t)NIN * 1024 * 2;
constexpr size_t O_WUKV = O_WUQ + 768ull * 256 * 2;
constexpr size_t O_WOA = O_WUKV + 1024ull * 128 * 2;
constexpr size_t O_WOB = O_WOA + 1024ull * 512 * 2;
constexpr size_t O_WOUT = O_WOB + 1024ull * 512 * 2;
constexpr size_t O_WUP = O_WOUT + 1024ull * 1024 * 2;
constexpr size_t O_WDN = O_WUP + (size_t)NUP * 1024 * 2;
constexpr size_t O_MODP = O_WDN + 1024ull * DFF * 2;
constexpr size_t O_MOD = O_MODP + 16ull * 24 * 6144 * 4;
constexpr size_t O_ROPEA = O_MOD + 24ull * 6144 * 4;
constexpr size_t O_ROPEB = O_ROPEA + 4096ull * 32 * 8;
constexpr size_t O_ZROW = O_ROPEB + 4096ull * 16 * 8;
constexpr size_t O_WB_END = O_ZROW + 4096;
static_assert(O_WB_END <= 48 * MiB, "weights region");
constexpr size_t O_ZS = 48 * MiB;
constexpr size_t O_QA = 288 * MiB;
constexpr size_t O_KA = O_QA + 96 * MiB;
constexpr size_t O_VTA = O_KA + 24 * MiB;
constexpr size_t O_QB = O_VTA + 24 * MiB;
constexpr size_t O_KB = O_QB + 144 * MiB;
constexpr size_t O_VTB = O_KB + 144 * MiB;
constexpr size_t O_H = 816 * MiB;
constexpr size_t O_UP = 288 * MiB;
constexpr int SEQP = S + 1, H2P_ROWS = 388 * 254 + 2;
constexpr size_t O_H2P = 48 * MiB;
constexpr size_t O_ACT = 288 * MiB;
constexpr size_t WS_NEED = 1008 * MiB;
static_assert(O_VTB + 96 * MiB <= O_H, "qkv region");
constexpr size_t OO_G = 0, O_OA = O_H, O_OB = O_H + 96 * MiB;

struct Params {
    const float* in[25];
    float* out;
    unsigned char* ws;
};

typedef __bf16 bf16x2_t __attribute__((ext_vector_type(2)));
typedef float f32x2_t __attribute__((ext_vector_type(2)));
DI unsigned pk2(float lo, float hi) { const f32x2_t v = {lo, hi}; return __builtin_bit_cast(unsigned, __builtin_convertvector(v, bf16x2_t)); }
DI float bflo(unsigned u) { return __uint_as_float(u << 16); }
DI float bfhi(unsigned u) { return __uint_as_float(u & 0xffff0000u); }
DI float bf2f(bf16_t v) { return __uint_as_float(((unsigned)v) << 16); }
DI bf16_t f2bf(float v) { return (bf16_t)(pk2(v, v) & 0xffffu); }
DI void unpack8(const u32x4 v, float (&f)[8]) {
    f[0] = bflo(v.x); f[1] = bfhi(v.x); f[2] = bflo(v.y); f[3] = bfhi(v.y); f[4] = bflo(v.z); f[5] = bfhi(v.z); f[6] = bflo(v.w); f[7] = bfhi(v.w);
}
DI float fast_rcp(float x) { return __builtin_amdgcn_rcpf(x); }
DI float fast_exp2(float x) { return __builtin_amdgcn_exp2f(x); }
DI float sigmoidf_(float v) { return fast_rcp(1.f + fast_exp2(-v * LOG2E)); }
DI float xor_reduce_g(float v) { v += __shfl_xor(v, 16); v += __shfl_xor(v, 32); return v; }
DI float wave_sum(float v) {
#pragma unroll
    for (int o = 1; o < 64; o <<= 1) v += __shfl_xor(v, o);
    return v;
}
DI int perm32(int s) { const int lo = s & 31; return (s & ~31) | (((lo >> 2) & 3) << 3) | ((lo >> 4) << 2) | (lo & 3); }
DI const float* xrow_ptr(const Params& p, int t) { return t < T_PROMPT ? p.in[0] + (size_t)t * D : p.in[1] + (size_t)(t - T_PROMPT) * D; }

DI void tile_map(int L, int nN, int ntiles, int& pm, int& pn) {
    const int xcd = L & 7, q = L >> 3;
    const int Lp = xcd * (ntiles >> 3) + q;
    const int grp = Lp / (8 * nN), rem = Lp % (8 * nN);
    pm = grp * 8 + (rem & 7); pn = rem >> 3;
}

#define LAS __attribute__((address_space(3)))
#define GAS __attribute__((address_space(1)))
template <int BM, int BN, int NWM, int NWN>
DI void gemm_mainloop_p(f32x4 (&acc)[BM / NWM / 16][BN / NWN / 16], const bf16_t* const (&Ar)[BM / (NWM * NWN * 8)],
                        const bf16_t* __restrict__ B, int ldb, int K, char* lds, const int tid) {
    constexpr int RPR = NWM * NWN * 8;
    constexpr int MT = BM / NWM / 16, NT = BN / NWN / 16, NA = BM / RPR, NB = BN / RPR, STAGE = (BM + BN) * 128, RB = RPR * 128;
    const int lane = tid & 63, wave = tid >> 6;
    const int wm = wave / NWN, wn = wave % NWN;
    const int r = lane & 15, g = lane >> 4;
    const int lr = tid >> 3, lc = tid & 7;
    const int csrc = (lc ^ ((lr >> 1) & 7)) * 8;
    const bf16_t* Bp = B + (size_t)lr * ldb + csrc;
    const int nk = K >> 6;
    auto issue = [&](int kt, int st) {
        char* d = lds + st * STAGE + tid * 16;
#pragma unroll
        for (int i = 0; i < NA; ++i)
            __builtin_amdgcn_global_load_lds((const GAS unsigned*)(Ar[i] + kt * 64), (LAS unsigned*)(d + i * RB), 16, 0, 0);
#pragma unroll
        for (int i = 0; i < NB; ++i)
            __builtin_amdgcn_global_load_lds((const GAS unsigned*)(Bp + (size_t)(RPR * i) * ldb + kt * 64), (LAS unsigned*)(d + BM * 128 + i * RB), 16, 0, 0);
    };
    issue(0, 0);
    __syncthreads();
    const int rsw = (r >> 1) & 7;
    for (int kt = 0; kt < nk; ++kt) {
        const int cur = kt & 1;
        if (kt + 1 < nk) issue(kt + 1, cur ^ 1);
        const char* sA = lds + cur * STAGE;
        const char* sB = sA + BM * 128;
#pragma unroll
        for (int ks = 0; ks < 2; ++ks) {
            bf16x8 wf[NT], xf[MT];
            const int co = ((ks * 4 + g) ^ rsw) * 16;
#pragma unroll
            for (int nt = 0; nt < NT; ++nt) wf[nt] = *(const bf16x8*)(sB + (wn * (NT * 16) + nt * 16 + r) * 128 + co);
#pragma unroll
            for (int mt = 0; mt < MT; ++mt) xf[mt] = *(const bf16x8*)(sA + (wm * (MT * 16) + mt * 16 + r) * 128 + co);
#pragma unroll
            for (int mt = 0; mt < MT; ++mt)
#pragma unroll
                for (int nt = 0; nt < NT; ++nt) acc[mt][nt] = __builtin_amdgcn_mfma_f32_16x16x32_bf16(wf[nt], xf[mt], acc[mt][nt], 0, 0, 0);
        }
        __syncthreads();
    }
}

template <int BM, int BN, int NWM, int NWN>
DI void gemm_mainloop(f32x4 (&acc)[BM / NWM / 16][BN / NWN / 16], const bf16_t* __restrict__ A, int lda,
                      const bf16_t* __restrict__ B, int ldb, int K, char* lds, const int tid) {
    constexpr int RPR = NWM * NWN * 8;
    const int lr = tid >> 3, lc = tid & 7;
    const bf16_t* Ar[BM / RPR];
#pragma unroll
    for (int i = 0; i < BM / RPR; ++i) Ar[i] = A + (size_t)(lr + RPR * i) * lda + (lc ^ ((lr >> 1) & 7)) * 8;
    gemm_mainloop_p<BM, BN, NWM, NWN>(acc, Ar, B, ldb, K, lds, tid);
}

template <int MT, int NT>
DI void zero_acc(f32x4 (&acc)[MT][NT]) {
#pragma unroll
    for (int i = 0; i < MT; ++i)
#pragma unroll
        for (int j = 0; j < NT; ++j) acc[i][j] = (f32x4){0.f, 0.f, 0.f, 0.f};
}

namespace pg8 {
#define PG8_LAS __attribute__((address_space(3)))
constexpr int BM = 256, BK = 64, HALF = 128, HTB = HALF * BK * 2, STAGE_BYTES = 8 * HTB, NXCD = 8, WGM = 8;
__host__ __device__ __forceinline__ int lds_byte(int r, int c) { const int st = (r >> 4) * 2 + (c >> 5), rr = r & 15, cc = c & 31, ob = rr * 64 + cc * 2; return st * 1024 + (ob ^ (((ob >> 9) & 1) << 5)); }
__host__ __device__ __forceinline__ void stage_rc(int b, int& R, int& C) { const int st = b / 1024, sb = b % 1024, swz = sb ^ (((sb >> 9) & 1) << 5); R = (st >> 1) * 16 + swz / 64; C = (st & 1) * 32 + (swz % 64) / 2; }
__host__ __device__ __forceinline__ int perm32(int rho) { const int n = rho >> 4, i = rho & 15; return 8 * (i >> 2) + 4 * n + (i & 3); }
struct Unit { int pm, pn; };
struct Gemm { const bf16_t* A; const bf16_t* Bt; int M, N, K; int a_rows = 256; };
struct StaticOrder {
    int nM, nN, nwg, G, c;
    __host__ __device__ void init(int M, int N, int G_, int c_) { nM = M / BM; nN = N / BM; nwg = nM * nN; G = G_; c = c_; }
    __host__ __device__ bool next(int i, Unit& u) const {
        const long L = (long)i * G + c; if (L >= nwg) return false;
        int wgid = (int)L; { const int q = nwg / NXCD, r = nwg % NXCD, xcd = wgid % NXCD, off = wgid / NXCD; wgid = (xcd < r ? xcd * (q + 1) : r * (q + 1) + (xcd - r) * q) + off; }
        const int nig = WGM * nN, gid = wgid / nig, fm = gid * WGM, gsz = (nM - fm) < WGM ? (nM - fm) : WGM;
        u.pm = fm + ((wgid % nig) % gsz); u.pn = (wgid % nig) / gsz; return true;
    }
    __device__ __forceinline__ void a_ready(const Unit&) const {}
    __device__ __forceinline__ void done(const Unit&) const {}
};
template <class Epi, class Sched, bool STAMP = false>
__device__ __forceinline__ void gemm_phase(PG8_LAS unsigned char* lds, const Gemm g, const Sched& S, const Epi& E, unsigned long long* stamps) {
    const int tid = opaque_tid(), wid = __builtin_amdgcn_readfirstlane(tid >> 6), lane = tid & 63, wr = wid >> 2, wc = wid & 3, fr = lane & 15, fq = lane >> 4;
    const int K = g.K, nt = K / BK;
    int ts_lo = 0, ts_hi = 0, nts = 0; const unsigned long long rt_entry = STAMP ? (unsigned long long)wall_clock64() : 0ull;
#define PG8_STAMP() do { if (STAMP && wid == 0 && nts < 64) { const unsigned long long _c = (unsigned long long)clock64(); \
        ts_lo = (lane == nts) ? (int)(unsigned)_c : ts_lo; ts_hi = (lane == nts) ? (int)(unsigned)(_c >> 32) : ts_hi; ++nts; } } while (0)
    PG8_STAMP();
    unsigned voffA[2], voffB[2];
#pragma unroll
    for (int i = 0; i < 2; ++i) { int R, C; stage_rc(tid * 16 + i * 8192, R, C); const int Rb = Epi::PERM ? ((R & ~31) + perm32(R & 31)) : R;
        voffA[i] = (unsigned)(R * K + C) * 2u; voffB[i] = (unsigned)(Rb * K + C) * 2u; }
    const size_t kstep = (size_t)(BK * 2);
    const size_t hstep = (size_t)HALF * K * 2;
    const size_t tstep = 2 * hstep;
    const size_t tstepA = (size_t)g.a_rows * K * 2;
    const unsigned ldsw = (unsigned)wid * 1024u;
    const int aoff = lds_byte(wr * 64 + fr, fq * 8), boff = lds_byte(wc * 32 + fr, fq * 8);
#define PG8_SA(b, h) (((b) * 2 + (h)) * HTB)
#define PG8_SB(b, h) ((4 + (b) * 2 + (h)) * HTB)
#define PG8_STAGE(bufoff, gbase, voff) do { _Pragma("unroll") for (int _i = 0; _i < 2; ++_i) \
        __builtin_amdgcn_global_load_lds((const unsigned*)((const char*)(gbase) + (voff)[_i]), (PG8_LAS unsigned*)(lds + (bufoff) + ldsw + _i * 8192), 16, 0, 0); } while (0)
#define PG8_LDA(dst, b, h) do { _Pragma("unroll") for (int m = 0; m < 4; ++m) _Pragma("unroll") for (int k = 0; k < 2; ++k) dst[m][k] = *(const PG8_LAS bf16x8*)(lds + PG8_SA(b, h) + aoff + m * 2048 + k * 1024); } while (0)
#define PG8_LDB(dst, b, h) do { _Pragma("unroll") for (int n = 0; n < 2; ++n) _Pragma("unroll") for (int k = 0; k < 2; ++k) dst[n][k] = *(const PG8_LAS bf16x8*)(lds + PG8_SB(b, h) + boff + n * 2048 + k * 1024); } while (0)
#define PG8_MMA(ai, bj, At, Bt) do { __builtin_amdgcn_s_setprio(1); _Pragma("unroll") for (int m = 0; m < 4; ++m) _Pragma("unroll") for (int n = 0; n < 2; ++n) _Pragma("unroll") for (int k = 0; k < 2; ++k) \
        acc[ai][bj][m][n] = __builtin_amdgcn_mfma_f32_16x16x32_bf16(Bt[n][k], At[m][k], acc[ai][bj][m][n], 0, 0, 0); __builtin_amdgcn_s_setprio(0); } while (0)
#define PG8_WAIT_V(n) asm volatile("s_waitcnt vmcnt(" #n ")" ::: "memory")
#define PG8_WAIT_L(n) asm volatile("s_waitcnt lgkmcnt(" #n ")" ::: "memory")
#define PG8_BAR __builtin_amdgcn_s_barrier()
#define PG8_SCHED __builtin_amdgcn_sched_barrier(0)
    Unit cur, nxt; int ui = 0;
    if (!S.next(0, cur)) return;
    f32x4 acc[2][2][4][2];
#pragma unroll
    for (int a = 0; a < 2; ++a)
#pragma unroll
        for (int b = 0; b < 2; ++b)
#pragma unroll
            for (int m = 0; m < 4; ++m)
#pragma unroll
                for (int n = 0; n < 2; ++n) acc[a][b][m][n] = (f32x4){0.f, 0.f, 0.f, 0.f};
    bf16x8 At[4][2], B0[2][2], B1[2][2];
    const char* cA = (const char*)g.A + (size_t)cur.pm * tstepA; const char* cB = (const char*)g.Bt + (size_t)cur.pn * tstep;
    S.a_ready(cur);
    PG8_STAGE(PG8_SB(0, 0), cB, voffB); PG8_STAGE(PG8_SA(0, 0), cA, voffA); PG8_STAGE(PG8_SB(0, 1), cB + hstep, voffB); PG8_STAGE(PG8_SA(0, 1), cA + hstep, voffA);
    if (wr == 1) PG8_BAR;
    PG8_WAIT_V(4); PG8_BAR;
    PG8_STAGE(PG8_SB(1, 0), cB + kstep, voffB); PG8_STAGE(PG8_SA(1, 0), cA + kstep, voffA); PG8_STAGE(PG8_SB(1, 1), cB + hstep + kstep, voffB);
    PG8_WAIT_V(6); PG8_BAR;
    PG8_STAMP();
    for (;;) {
        const bool has_next = S.next(ui + 1, nxt);
        const char* nA = has_next ? (const char*)g.A + (size_t)nxt.pm * tstepA : cA; const char* nB = has_next ? (const char*)g.Bt + (size_t)nxt.pn * tstep : cB;
        for (int t = 0; t < nt; t += 2) {
            const bool last = (t == nt - 2);
            const char* a1 = cA + (size_t)(t + 1) * kstep;
            const char* a2 = last ? nA : cA + (size_t)(t + 2) * kstep; const char* b2 = last ? nB : cB + (size_t)(t + 2) * kstep;
            const char* a3 = a2 + kstep; const char* b3 = b2 + kstep;
            if (last && has_next) S.a_ready(nxt);
            PG8_LDB(B0, 0, 0); PG8_SCHED; PG8_LDA(At, 0, 0); PG8_STAGE(PG8_SA(1, 1), a1 + hstep, voffA);
            PG8_WAIT_L(8); PG8_BAR; PG8_WAIT_L(0); PG8_MMA(0, 0, At, B0); PG8_BAR; PG8_SCHED;
            PG8_LDB(B1, 0, 1); PG8_STAGE(PG8_SB(0, 0), b2, voffB);
            PG8_BAR; PG8_WAIT_L(0); PG8_MMA(0, 1, At, B1); PG8_BAR;
            PG8_LDA(At, 0, 1); PG8_STAGE(PG8_SA(0, 0), a2, voffA);
            PG8_BAR; PG8_WAIT_L(0); PG8_MMA(1, 0, At, B0); PG8_BAR; PG8_SCHED;
            PG8_STAGE(PG8_SB(0, 1), b2 + hstep, voffB);
            PG8_WAIT_V(6); PG8_BAR; PG8_MMA(1, 1, At, B1); PG8_BAR;
            PG8_LDB(B0, 1, 0); PG8_SCHED; PG8_LDA(At, 1, 0); PG8_STAGE(PG8_SA(0, 1), a2 + hstep, voffA);
            PG8_WAIT_L(8); PG8_BAR; PG8_WAIT_L(0); PG8_MMA(0, 0, At, B0); PG8_BAR; PG8_SCHED;
            PG8_LDB(B1, 1, 1); PG8_STAGE(PG8_SB(1, 0), b3, voffB);
            PG8_BAR; PG8_WAIT_L(0); PG8_MMA(0, 1, At, B1); PG8_BAR;
            PG8_LDA(At, 1, 1); PG8_STAGE(PG8_SA(1, 0), a3, voffA);
            PG8_BAR; PG8_WAIT_L(0); PG8_MMA(1, 0, At, B0); PG8_BAR; PG8_SCHED;
            PG8_STAGE(PG8_SB(1, 1), b3 + hstep, voffB);
            PG8_WAIT_V(6); PG8_BAR; PG8_MMA(1, 1, At, B1); PG8_BAR;
        }
        PG8_STAMP();
        if constexpr (!Epi::AFTER_DRAIN) { E(acc, cur, wr, wc, fr, fq); S.done(cur); }
        PG8_STAMP();
        if (!has_next) break;
#pragma unroll
        for (int a = 0; a < 2; ++a)
#pragma unroll
            for (int b = 0; b < 2; ++b)
#pragma unroll
                for (int m = 0; m < 4; ++m)
#pragma unroll
                    for (int n = 0; n < 2; ++n) acc[a][b][m][n] = (f32x4){0.f, 0.f, 0.f, 0.f};
        cur = nxt; cA = nA; cB = nB; ++ui;
    }
    PG8_WAIT_V(0);
    if (wr == 0) PG8_BAR;
    PG8_BAR;
    if constexpr (Epi::AFTER_DRAIN) { E.fused(acc, cur, wr, wc, fr, fq, lds, wid, lane); S.done(cur); }
    PG8_STAMP();
    if (STAMP && wid == 0) { stamps[lane] = lane < nts ? (((unsigned long long)(unsigned)ts_hi << 32) | (unsigned)ts_lo) : 0ull;
        if (lane == 62) stamps[62] = rt_entry; if (lane == 63) stamps[63] = (unsigned long long)wall_clock64(); }
#undef PG8_STAMP
#undef PG8_SA
#undef PG8_SB
#undef PG8_STAGE
#undef PG8_LDA
#undef PG8_LDB
#undef PG8_MMA
#undef PG8_WAIT_V
#undef PG8_WAIT_L
#undef PG8_BAR
#undef PG8_SCHED
}
}


struct EpiP1 {
    static constexpr bool PERM = true, AFTER_DRAIN = false;
    bf16_t* ZS; bf16_t* G;
    DI void operator()(const f32x4 (&acc)[2][2][4][2], const pg8::Unit& u, int wr, int wc, int fr, int fq) const {
        const int row0 = u.pm * 256 + wr * 64 + fr, colt = u.pn * 256 + wc * 32 + 8 * fq;
        const bool small = u.pn < NZ / 256;
#pragma unroll
        for (int ai = 0; ai < 2; ++ai)
#pragma unroll
            for (int m = 0; m < 4; ++m) {
                const size_t row = (size_t)(row0 + ai * 128 + m * 16);
#pragma unroll
                for (int bj = 0; bj < 2; ++bj) {
                    const int col = colt + bj * 128;
                    const f32x4 v0 = acc[ai][bj][m][0], v1 = acc[ai][bj][m][1];
                    u32x4 w;
                    if (small) { w.x = pk2(v0.x, v0.y); w.y = pk2(v0.z, v0.w); w.z = pk2(v1.x, v1.y); w.w = pk2(v1.z, v1.w); *(u32x4*)(ZS + row * NZ + col) = w; }
                    else { w.x = pk2(sigmoidf_(v0.x), sigmoidf_(v0.y)); w.y = pk2(sigmoidf_(v0.z), sigmoidf_(v0.w)); w.z = pk2(sigmoidf_(v1.x), sigmoidf_(v1.y)); w.w = pk2(sigmoidf_(v1.z), sigmoidf_(v1.w));
                           *(u32x4*)(G + row * 2048 + (col - NZ)) = w; }
                }
            }
    }
};
template <bool SECOND> struct EpiMix {
    static constexpr bool PERM = true, AFTER_DRAIN = false;
    const bf16_t* G; bf16_t* MIX;
    DI void operator()(const f32x4 (&acc)[2][2][4][2], const pg8::Unit& u, int wr, int wc, int fr, int fq) const {
        const int row0 = u.pm * 256 + wr * 64 + fr, colt = u.pn * 256 + wc * 32 + 8 * fq;
#pragma unroll
        for (int ai = 0; ai < 2; ++ai)
#pragma unroll
            for (int m = 0; m < 4; ++m) {
                const size_t row = (size_t)(row0 + ai * 128 + m * 16);
#pragma unroll
                for (int bj = 0; bj < 2; ++bj) {
                    const int col = colt + bj * 128;
                    float gv[8], o[8];
                    unpack8(*(const u32x4*)(G + row * 2048 + (SECOND ? 1024 : 0) + col), gv);
                    const f32x4 v0 = acc[ai][bj][m][0], v1 = acc[ai][bj][m][1];
                    if (SECOND) unpack8(*(const u32x4*)(MIX + row * 1024 + col), o);
                    else { for (int e = 0; e < 8; ++e) o[e] = 0.f; }
                    o[0] += gv[0] * v0.x; o[1] += gv[1] * v0.y; o[2] += gv[2] * v0.z; o[3] += gv[3] * v0.w;
                    o[4] += gv[4] * v1.x; o[5] += gv[5] * v1.y; o[6] += gv[6] * v1.z; o[7] += gv[7] * v1.w;
                    u32x4 w; w.x = pk2(o[0], o[1]); w.y = pk2(o[2], o[3]); w.z = pk2(o[4], o[5]); w.w = pk2(o[6], o[7]);
                    *(u32x4*)(MIX + row * 1024 + col) = w;
                }
            }
    }
};
template <bool INPLACE> struct EpiRes {
    static constexpr bool PERM = false, AFTER_DRAIN = false;
    const float* xp; const float* xs; float* out; const float* gate;
    DI void operator()(const f32x4 (&acc)[2][2][4][2], const pg8::Unit& u, int wr, int wc, int fr, int fq) const {
        const int row0 = u.pm * 256 + wr * 64 + fr, colt = u.pn * 256 + wc * 32 + 4 * fq;
        const float* gt = gate + (size_t)((u.pm * 256) >> 12) * 6144;
#pragma unroll
        for (int ai = 0; ai < 2; ++ai)
#pragma unroll
            for (int m = 0; m < 4; ++m) {
                const int row = row0 + ai * 128 + m * 16;
                float* orow = out + (size_t)row * D;
                const float* brow = INPLACE ? orow : (row < T_PROMPT ? xp + (size_t)row * D : xs + (size_t)(row - T_PROMPT) * D);
#pragma unroll
                for (int bj = 0; bj < 2; ++bj)
#pragma unroll
                    for (int n = 0; n < 2; ++n) {
                        const int col = colt + bj * 128 + n * 16;
                        const f32x4 xv = *(const f32x4*)(brow + col), gv = *(const f32x4*)(gt + col);
                        *(f32x4*)(orow + col) = xv + gv * acc[ai][bj][m][n];
                    }
            }
    }
};

DI void transpose_item(const float* __restrict__ W, int K, int N, bf16_t* __restrict__ WT, int mode, const float* __restrict__ scale,
                       float* scr, int item, int lane) {
    const int nblk = N >> 5, kb = item / nblk, nb = item % nblk, k0 = kb * 64, n0 = nb * 32;
#pragma unroll 8
    for (int i = 0; i < 32; ++i) {
        const int kk = 2 * i + (lane >> 5);
        float v = W[(size_t)(k0 + kk) * N + n0 + (lane & 31)];
        if (scale) v *= scale[k0 + kk];
        scr[kk * 33 + (lane & 31)] = v;
    }
    asm volatile("s_waitcnt lgkmcnt(0)" ::: "memory");
    const int c = lane & 7;
#pragma unroll
    for (int j = 0; j < 4; ++j) {
        const int nl = (lane >> 3) + 8 * j;
        const float* s = scr + (8 * c) * 33 + nl;
        u32x4 o;
        o.x = pk2(s[0 * 33], s[1 * 33]); o.y = pk2(s[2 * 33], s[3 * 33]); o.z = pk2(s[4 * 33], s[5 * 33]); o.w = pk2(s[6 * 33], s[7 * 33]);
        const int n = n0 + nl;
        int row;
        if (mode == 1) row = n < 1184 ? n : n + 96;
        else if (mode == 2) { const int h = n >> 7, jj = n & 127; row = jj < 64 ? h * 64 + jj : 512 + h * 64 + (jj - 64); }
        else if (mode == 3) { const int hf = n >= DFF ? 1 : 0, m2 = n - hf * DFF; row = (m2 >> 7) * 256 + hf * 128 + (m2 & 127); }
        else row = n;
        *(u32x4*)(WT + (size_t)row * K + k0 + 8 * c) = o;
    }
    asm volatile("s_waitcnt lgkmcnt(0)" ::: "memory");
}

DI void phase0(const Params& p, char* lds) {
    const int tid_ = opaque_tid();
    const int tid = TID4, bid = VBID, G = VGRID, lane = tid & 63, wave = tid >> 6;
    unsigned char* ws = p.ws;
    float* sc = (float*)lds;
    for (int it = bid; it < 384; it += G) {
        const int cb = it % 24, ks = it / 24;
        __syncthreads();
        for (int i = tid; i < 24 * 64; i += 256) {
            const int b = i >> 6, k = i & 63;
            const float* c = b < 8 ? p.in[2] + b * 1024 : p.in[3] + (b - 8) * 1024;
            const float v = c[ks * 64 + k];
            sc[i] = v * sigmoidf_(v);
        }
        __syncthreads();
        float a[24];
#pragma unroll
        for (int b = 0; b < 24; ++b) a[b] = 0.f;
        const int n = cb * 256 + tid;
        const float* w = p.in[4] + (size_t)(ks * 64) * 6144 + n;
        for (int k = 0; k < 64; ++k) {
            const float wv = w[(size_t)k * 6144];
#pragma unroll
            for (int b = 0; b < 24; ++b) a[b] += sc[b * 64 + k] * wv;
        }
        float* mp = (float*)(ws + O_MODP) + (size_t)(ks * 24) * 6144 + n;
#pragma unroll
        for (int b = 0; b < 24; ++b) mp[(size_t)b * 6144] = a[b];
    }
    __syncthreads();
    {
        float* scr = (float*)(lds + wave * 8448);
        const int gw = bid * 4 + wave, NGW = G * 4;
        constexpr int I0 = 16 * 101, I1 = 4 * 24, I2 = 2 * 32, I3 = 8 * 32, I4 = 8 * 32, I5 = 16 * 32, I6 = 16 * 176, I7 = 44 * 32;
        constexpr int NI = I0 + I1 + I2 + I3 + I4 + I5 + I6 + I7;
        for (int it = gw; it < NI; it += NGW) {
            int q = it;
            if (q < I0) { transpose_item(p.in[7], 1024, IN_TOTAL, (bf16_t*)(ws + O_WIN), 1, nullptr, scr, q, lane); continue; } q -= I0;
            if (q < I1) { transpose_item(p.in[12], 256, 768, (bf16_t*)(ws + O_WUQ), 0, p.in[11], scr, q, lane); continue; } q -= I1;
            if (q < I2) { transpose_item(p.in[14], 128, 1024, (bf16_t*)(ws + O_WUKV), 2, p.in[13], scr, q, lane); continue; } q -= I2;
            if (q < I3) { transpose_item(p.in[17], 512, 1024, (bf16_t*)(ws + O_WOA), 0, nullptr, scr, q, lane); continue; } q -= I3;
            if (q < I4) { transpose_item(p.in[18], 512, 1024, (bf16_t*)(ws + O_WOB), 0, nullptr, scr, q, lane); continue; } q -= I4;
            if (q < I5) { transpose_item(p.in[19], 1024, 1024, (bf16_t*)(ws + O_WOUT), 0, nullptr, scr, q, lane); continue; } q -= I5;
            if (q < I6) { transpose_item(p.in[21], 1024, NUP, (bf16_t*)(ws + O_WUP), 3, nullptr, scr, q, lane); continue; } q -= I6;
            transpose_item(p.in[24], DFF, 1024, (bf16_t*)(ws + O_WDN), 0, nullptr, scr, q, lane);
        }
    }
    const int gt = bid * 256 + tid, NGT = G * 256;
    for (int i = gt; i < 4096 * 48; i += NGT) {
        const int pos = i / 48, j = i % 48;
        float inv;
        if (j < 32) inv = exp2f(-(float)(2 * j) * (1.f / 64.f) * 13.287712379549449f);
        else inv = exp2f(-(float)(2 * (j - 32)) * (1.f / 32.f) * 13.287712379549449f);
        const float ang = (float)pos * inv;
        float rev = ang * 0.15915494309189535f;
        rev -= floorf(rev);
        const float sn = __builtin_amdgcn_sinf(rev), cs = __builtin_amdgcn_cosf(rev);
        float2* dst = j < 32 ? (float2*)(ws + O_ROPEA) + pos * 32 + j : (float2*)(ws + O_ROPEB) + pos * 16 + (j - 32);
        *dst = make_float2(cs, sn);
    }
    for (int i = gt; i < 96 * 1024 / 8; i += NGT) *(u32x4*)((bf16_t*)(ws + O_WIN) + 1184 * 1024 + (size_t)i * 8) = (u32x4){0u, 0u, 0u, 0u};
    if (gt < 256) *(u32x4*)(ws + O_ZROW + gt * 16) = (u32x4){0u, 0u, 0u, 0u};
}

DI void phase0m(const Params& p) {
    const int tid_ = opaque_tid();
    const int gt = VBID * 256 + TID4, NGT = VGRID * 256;
    const float* mp = (const float*)(p.ws + O_MODP);
    float* mod = (float*)(p.ws + O_MOD);
    for (int i = gt; i < 24 * 6144; i += NGT) {
        float s = p.in[5][i % 6144];
#pragma unroll
        for (int ks = 0; ks < 16; ++ks) s += mp[(size_t)ks * 24 * 6144 + i];
        mod[i] = s;
    }
}

DI void norm_pass(const Params& p, bool second, bf16_t* dst) {
    const int tid_ = opaque_tid();
    const int lane = TID4 & 63, gw = VBID * 4 + (TID4 >> 6), NGW = VGRID * 4;
    const float* gwt = second ? p.in[20] : p.in[6];
    const float* mod = (const float*)(p.ws + O_MOD);
    f32x4 gv[4];
#pragma unroll
    for (int j = 0; j < 4; ++j) gv[j] = *((const f32x4*)gwt + 64 * j + lane);
    for (int t0 = gw * 2; t0 < T; t0 += NGW * 2) {
        f32x4 v[2][4]; float s[2];
#pragma unroll
        for (int u = 0; u < 2; ++u) {
            const int t = t0 + u;
            const float* xr = second ? p.out + (size_t)t * D : xrow_ptr(p, t);
            s[u] = 0.f;
#pragma unroll
            for (int j = 0; j < 4; ++j) { v[u][j] = *((const f32x4*)xr + 64 * j + lane); s[u] += (v[u][j].x * v[u][j].x + v[u][j].y * v[u][j].y) + (v[u][j].z * v[u][j].z + v[u][j].w * v[u][j].w); }
        }
        const int b = t0 >> 12;
        const float* sh = mod + (size_t)b * 6144 + (second ? 3072 : 0);
        const float* sc = sh + 1024;
#pragma unroll
        for (int u = 0; u < 2; ++u) {
            const int t = t0 + u;
            const float rstd = rsqrtf(wave_sum(s[u]) * (1.f / D) + EPS);
            u32x2* o = (u32x2*)(dst + (size_t)(second ? t + b + 1 : t) * D) + lane;
#pragma unroll
            for (int j = 0; j < 4; ++j) {
                const f32x4 scv = *((const f32x4*)sc + 64 * j + lane), shv = *((const f32x4*)sh + 64 * j + lane);
                f32x4 y;
                y.x = v[u][j].x * rstd * gv[j].x * (1.f + scv.x) + shv.x; y.y = v[u][j].y * rstd * gv[j].y * (1.f + scv.y) + shv.y;
                y.z = v[u][j].z * rstd * gv[j].z * (1.f + scv.z) + shv.z; y.w = v[u][j].w * rstd * gv[j].w * (1.f + scv.w) + shv.w;
                o[64 * j] = (u32x2){pk2(y.x, y.y), pk2(y.z, y.w)};
            }
        }
    }
    if (second) {
        constexpr int NZR = 25 + (H2P_ROWS - (NBATCH * SEQP + 1));
        for (int z = gw; z < NZR; z += NGW) {
            const int pr = z < 25 ? z * SEQP : NBATCH * SEQP + 1 + (z - 25);
            u32x2* o = (u32x2*)(dst + (size_t)pr * D) + lane;
#pragma unroll
            for (int j = 0; j < 4; ++j) o[64 * j] = (u32x2){0u, 0u};
        }
    }
}

DI void phase1(const Params& p, char* lds) {
    pg8::Gemm g{(const bf16_t*)(p.ws + O_H), (const bf16_t*)(p.ws + O_WIN), T, NIN, 1024};
    pg8::StaticOrder so; so.init(T, NIN, gridDim.x, blockIdx.x);
    EpiP1 E{(bf16_t*)(p.ws + O_ZS), (bf16_t*)((unsigned char*)p.out + OO_G)};
    pg8::gemm_phase<EpiP1, pg8::StaticOrder, false>((PG8_LAS unsigned char*)lds, g, so, E, nullptr);
}

template <int NCH>
DI float row_sumsq(const bf16_t* rowp, int g) {
    float s = 0.f;
#pragma unroll
    for (int c = 0; c < NCH; ++c) {
        const u32x4 v = *(const u32x4*)(rowp + (g * NCH + c) * 8);
#pragma unroll
        for (int e = 0; e < 4; ++e) { const float a = bflo(v[e]), b = bfhi(v[e]); s += a * a + b * b; }
    }
    return xor_reduce_g(s);
}

DI void phase2(const Params& p, char* lds) {
    const int tid_ = opaque_tid();
    unsigned char* ws = p.ws;
    const bf16_t* ZS = (const bf16_t*)(ws + O_ZS);
    const int tid = TID4, lane = tid & 63, wave = tid >> 6, r = lane & 15, g = lane >> 4;
    const float2* ropeA = (const float2*)(ws + O_ROPEA);
    const float2* ropeB = (const float2*)(ws + O_ROPEB);
    constexpr int NTL = T / 128;
    for (int it = VBID; it < NTL * 8; it += VGRID) {
        const int tile = it >> 3, sub = it & 7, t0 = tile * 128, b = t0 >> 12, s0 = t0 & (S - 1);
        {
            const int h = sub;
            f32x4 acc[2][6]; zero_acc(acc);
            gemm_mainloop<128, 96, 4, 1>(acc, ZS + (size_t)t0 * NZ + 768, NZ, (const bf16_t*)(ws + O_WUQ) + (size_t)h * 96 * 256, 256, 256, lds, tid);
            const float* gq = p.in[15];
            const float qs = 0.10206207261596577f * LOG2E;
            bf16_t* QB = (bf16_t*)(ws + O_QB) + ((size_t)(b * 8 + h) * S) * 96;
#pragma unroll
            for (int mt = 0; mt < 2; ++mt) {
                const int ml = wave * 32 + mt * 16 + r, sp = s0 + ml;
                const float rstd = rsqrtf(row_sumsq<8>(ZS + (size_t)(t0 + ml) * NZ + 768, g) * (1.f / 256.f) + EPS);
                float ss = 0.f;
#pragma unroll
                for (int nt = 0; nt < 6; ++nt) { acc[mt][nt] = acc[mt][nt] * rstd; const f32x4 a = acc[mt][nt]; ss += (a.x * a.x + a.y * a.y) + (a.z * a.z + a.w * a.w); }
                const float r2 = rsqrtf(xor_reduce_g(ss) * (1.f / 96.f) + EPS);
#pragma unroll
                for (int nt = 0; nt < 6; ++nt) {
                    const f32x4 gg = *(const f32x4*)(gq + nt * 16 + g * 4);
                    acc[mt][nt] = acc[mt][nt] * r2 * gg;
                }
#pragma unroll
                for (int j = 0; j < 4; ++j) {
                    const float2 cs = ropeB[sp * 16 + g * 4 + j];
                    const float x1 = acc[mt][4][j], x2 = acc[mt][5][j];
                    acc[mt][4][j] = x1 * cs.x - x2 * cs.y;
                    acc[mt][5][j] = x1 * cs.y + x2 * cs.x;
                }
                bf16_t* qrow = QB + (size_t)sp * 96 + g * 4;
#pragma unroll
                for (int nt = 0; nt < 6; ++nt) { const f32x4 a = acc[mt][nt] * qs; *(u32x2*)(qrow + nt * 16) = (u32x2){pk2(a.x, a.y), pk2(a.z, a.w)}; }
                __builtin_amdgcn_sched_barrier(0);
            }
        }
    }
    for (int it = VBID; it < NTL * 4; it += VGRID) {
        const int tile = it >> 2, hp = it & 3, t0 = tile * 128, b = t0 >> 12, s0 = t0 & (S - 1);
        {
            f32x4 acc[4][4]; zero_acc(acc);
            gemm_mainloop<128, 128, 2, 2>(acc, ZS + (size_t)t0 * NZ + 1024, NZ,
                                          (const bf16_t*)(ws + O_WUKV) + (size_t)(hp * 128) * 128, 128, 128, lds, tid);
            const int wm = wave >> 1, wn = wave & 1, h = hp * 2 + wn;
            {
                const float* gk = p.in[16];
                bf16_t* KB = (bf16_t*)(ws + O_KB) + ((size_t)(b * 8 + h) * S) * 96;
#pragma unroll
                for (int mt = 0; mt < 4; ++mt) {
                    const int ml = wm * 64 + mt * 16 + r, sp = s0 + ml;
                    const bf16_t* zrow = ZS + (size_t)(t0 + ml) * NZ;
                    const float rstd = rsqrtf(row_sumsq<4>(zrow + 1024, g) * (1.f / 128.f) + EPS);
                    const u32x2 k1 = *(const u32x2*)(zrow + 1152 + g * 4), k2 = *(const u32x2*)(zrow + 1168 + g * 4);
                    float x1[4] = {bflo(k1.x), bfhi(k1.x), bflo(k1.y), bfhi(k1.y)};
                    float x2[4] = {bflo(k2.x), bfhi(k2.x), bflo(k2.y), bfhi(k2.y)};
                    float ss = 0.f;
#pragma unroll
                    for (int j = 0; j < 4; ++j) ss += x1[j] * x1[j] + x2[j] * x2[j];
#pragma unroll
                    for (int nt = 0; nt < 4; ++nt) { acc[mt][nt] = acc[mt][nt] * rstd; const f32x4 a = acc[mt][nt]; ss += (a.x * a.x + a.y * a.y) + (a.z * a.z + a.w * a.w); }
                    const float r2 = rsqrtf(xor_reduce_g(ss) * (1.f / 96.f) + EPS);
                    bf16_t* krow = KB + (size_t)sp * 96 + g * 4;
#pragma unroll
                    for (int nt = 0; nt < 4; ++nt) {
                        const f32x4 gg = *(const f32x4*)(gk + nt * 16 + g * 4);
                        const f32x4 a = acc[mt][nt] * r2 * gg;
                        *(u32x2*)(krow + nt * 16) = (u32x2){pk2(a.x, a.y), pk2(a.z, a.w)};
                    }
                    const f32x4 g1 = *(const f32x4*)(gk + 64 + g * 4), g2 = *(const f32x4*)(gk + 80 + g * 4);
                    float o1[4], o2[4];
#pragma unroll
                    for (int j = 0; j < 4; ++j) {
                        const float2 cs = ropeB[sp * 16 + g * 4 + j];
                        const float y1 = x1[j] * r2 * g1[j], y2 = x2[j] * r2 * g2[j];
                        o1[j] = y1 * cs.x - y2 * cs.y; o2[j] = y1 * cs.y + y2 * cs.x;
                    }
                    *(u32x2*)(krow + 64) = (u32x2){pk2(o1[0], o1[1]), pk2(o1[2], o1[3])};
                    *(u32x2*)(krow + 80) = (u32x2){pk2(o2[0], o2[1]), pk2(o2[2], o2[3])};
                    __builtin_amdgcn_sched_barrier(0);
                }
            }
        }
    }
    for (int it = VBID; it < NTL * 4; it += VGRID) {
        const int tile = it >> 2, hp = it & 3, t0 = tile * 128, b = t0 >> 12, s0 = t0 & (S - 1);
        {
            f32x4 acc[4][4]; zero_acc(acc);
            gemm_mainloop<128, 128, 2, 2>(acc, ZS + (size_t)t0 * NZ + 1024, NZ,
                                          (const bf16_t*)(ws + O_WUKV) + (size_t)(512 + hp * 128) * 128, 128, 128, lds, tid);
            const int wm = wave >> 1, wn = wave & 1, h = hp * 2 + wn;
            {
                bf16_t* VT = (bf16_t*)(ws + O_VTB) + ((size_t)(b * 8 + h) * 64) * S;
#pragma unroll
                for (int mt = 0; mt < 4; ++mt) {
                    const int ml = wm * 64 + mt * 16 + r, sp = s0 + ml;
                    const float rstd = rsqrtf(row_sumsq<4>(ZS + (size_t)(t0 + ml) * NZ + 1024, g) * (1.f / 128.f) + EPS);
                    const int ps = perm32(sp);
#pragma unroll
                    for (int nt = 0; nt < 4; ++nt)
#pragma unroll
                        for (int j = 0; j < 4; ++j) VT[(size_t)(nt * 16 + g * 4 + j) * S + ps] = f2bf(acc[mt][nt][j] * rstd);
                    __builtin_amdgcn_sched_barrier(0);
                }
            }
        }
    }
    __syncthreads();
    for (int tile = VBID; tile < NTL * 2; tile += VGRID) {
        const int t0 = tile * 64, b = t0 >> 12, s0 = t0 & (S - 1);
        {
            const float* gqa = p.in[8];
            const float* gka = p.in[9];
            const int half = lane >> 5, i = lane & 31;
            const float qs = 0.125f * LOG2E;
            const float gq1 = gqa[i], gq2 = gqa[32 + i], gk1 = gka[i], gk2 = gka[32 + i];
            for (int tt0 = wave * 4; tt0 < 64; tt0 += 16) {
                float x1[4][5], x2[4][5]; float2 cs[4];
#pragma unroll
                for (int u = 0; u < 4; ++u) {
                    const bf16_t* zrow = ZS + (size_t)(t0 + tt0 + u) * NZ;
                    cs[u] = ropeA[(s0 + tt0 + u) * 32 + i];
#pragma unroll
                    for (int q = 0; q < 5; ++q) { const int hd = 2 * q + half; x1[u][q] = bf2f(zrow[hd * 64 + i]); x2[u][q] = bf2f(zrow[hd * 64 + 32 + i]); }
                }
#pragma unroll
                for (int u = 0; u < 4; ++u) {
                    const int sp = s0 + tt0 + u;
#pragma unroll
                    for (int q = 0; q < 5; ++q) {
                        const int hd = 2 * q + half;
                        float ss = x1[u][q] * x1[u][q] + x2[u][q] * x2[u][q];
#pragma unroll
                        for (int o = 1; o < 32; o <<= 1) ss += __shfl_xor(ss, o);
                        const float rr = rsqrtf(ss * (1.f / 64.f) + EPS);
                        const bool isq = q < 4;
                        const float y1 = x1[u][q] * rr * (isq ? gq1 : gk1), y2 = x2[u][q] * rr * (isq ? gq2 : gk2);
                        float o1 = y1 * cs[u].x - y2 * cs[u].y, o2 = y1 * cs[u].y + y2 * cs[u].x;
                        bf16_t* dst;
                        if (isq) { o1 *= qs; o2 *= qs; dst = (bf16_t*)(ws + O_QA) + ((size_t)(b * 8 + hd) * S + sp) * 64; }
                        else dst = (bf16_t*)(ws + O_KA) + ((size_t)(b * 2 + (hd - 8)) * S + sp) * 64;
                        dst[i] = f2bf(o1); dst[32 + i] = f2bf(o2);
                    }
                }
            }
            __syncthreads();
            bf16_t* tl = (bf16_t*)lds;
            for (int idx = tid; idx < 64 * 16; idx += 256) {
                const int tt = idx >> 4, c = idx & 15;
                const u32x4 v = *(const u32x4*)(ZS + (size_t)(t0 + tt) * NZ + 640 + c * 8);
                u32x2* d2 = (u32x2*)(tl + tt * 132 + c * 8);
                d2[0] = (u32x2){v.x, v.y}; d2[1] = (u32x2){v.z, v.w};
            }
            __syncthreads();
            bf16_t* VT = (bf16_t*)(ws + O_VTA) + ((size_t)(b * 2) * 64) * S;
            for (int idx = tid; idx < 64 * 128; idx += 256) {
                const int pp = idx & 63, dd = idx >> 6;
                const int lo = pp & 31;
                const int tt = (pp & ~31) | (((lo >> 2) & 1) << 4) | ((lo >> 3) << 2) | (lo & 3);
                VT[(size_t)dd * S + s0 + pp] = tl[tt * 132 + dd];
            }
            __syncthreads();
        }
    }
}

template <int DQK, bool WIN>
DI void attn_item(const bf16_t* __restrict__ Qw, const bf16_t* __restrict__ Kb, const bf16_t* __restrict__ Vt, int key0, int ntiles, int q0,
                  float shift2, float sink_term, bf16_t* __restrict__ Ow, int ldo, char* lds, const int tid) {
    constexpr int QT = 4, KS = DQK / 32, CH = DQK / 8, KROW = DQK * 2, KBYTES = 64 * KROW, NKI = KBYTES / 1024, STAGE = KBYTES + 8192;
    const int lane = tid & 63, r = lane & 15, g = lane >> 4, wave = __builtin_amdgcn_readfirstlane(tid >> 6);
    bf16x8 qf[QT][KS];
#pragma unroll
    for (int qt = 0; qt < QT; ++qt)
#pragma unroll
        for (int ks = 0; ks < KS; ++ks) qf[qt][ks] = *(const bf16x8*)(Qw + (size_t)(qt * 16 + r) * DQK + ks * 32 + g * 8);
    f32x4 oacc[4][QT];
    float lsum[QT];
#pragma unroll
    for (int qt = 0; qt < QT; ++qt) {
        lsum[qt] = 0.f;
#pragma unroll
        for (int i = 0; i < 4; ++i) oacc[i][qt] = (f32x4){0.f, 0.f, 0.f, 0.f};
    }
    int ksrc[2];
#pragma unroll
    for (int i = 0; i < 2; ++i) {
        const int pch = (wave + 8 * i) * 64 + lane, row = pch / CH, c = pch % CH;
        const int sc = (DQK == 96) ? ((c & ~3) | ((c & 3) ^ ((0x78 >> (2 * ((row >> 2) & 3))) & 3))) : (c ^ ((row >> 1) & 7));
        ksrc[i] = row * DQK + sc * 8;
    }
    const int vrow = tid >> 3, vsrc = ((tid & 7) ^ ((vrow >> 1) & 7)) * 8;
    const bf16_t* Vp = Vt + (size_t)vrow * S + vsrc;
    auto issue = [&](int tile, int st) {
        const int kb = key0 + tile * 64;
        char* d = lds + st * STAGE + tid * 16;
        __builtin_amdgcn_global_load_lds((const GAS unsigned*)(Kb + (size_t)kb * DQK + ksrc[0]), (LAS unsigned*)(d), 16, 0, 0);
        if (NKI > 8 && wave < NKI - 8)
            __builtin_amdgcn_global_load_lds((const GAS unsigned*)(Kb + (size_t)kb * DQK + ksrc[1]), (LAS unsigned*)(d + 8192), 16, 0, 0);
        __builtin_amdgcn_global_load_lds((const GAS unsigned*)(Vp + kb), (LAS unsigned*)(d + KBYTES), 16, 0, 0);
    };
    const int ksw = (DQK == 96) ? ((0x78 >> (2 * ((r >> 2) & 3))) & 3) : ((r >> 1) & 7);
    const int vsw = (r >> 1) & 7;
    const f32x4 sinit = (f32x4){-shift2, -shift2, -shift2, -shift2};
    __syncthreads();
    issue(0, 0);
    __syncthreads();
    for (int tile = 0; tile < ntiles; ++tile) {
        const int cur = tile & 1;
        if (tile + 1 < ntiles) issue(tile + 1, cur ^ 1);
        const char* sK = lds + cur * STAGE; const char* sV = sK + KBYTES;
#pragma unroll
        for (int kk = 0; kk < 2; ++kk) {
            f32x4 sacc[2][QT];
#pragma unroll
            for (int a = 0; a < 2; ++a) {
#pragma unroll
                for (int qt = 0; qt < QT; ++qt) sacc[a][qt] = sinit;
#pragma unroll
                for (int ks = 0; ks < KS; ++ks) {
                    const int kch = (DQK == 96) ? (ks * 4 + (g ^ ksw)) : ((ks * 4 + g) ^ ksw);
                    const bf16x8 kf = *(const bf16x8*)(sK + ((2 * kk + a) * 16 + r) * KROW + kch * 16);
#pragma unroll
                    for (int qt = 0; qt < QT; ++qt) sacc[a][qt] = __builtin_amdgcn_mfma_f32_16x16x32_bf16(kf, qf[qt][ks], sacc[a][qt], 0, 0, 0);
                }
            }
            const int kbase = key0 + tile * 64 + kk * 32 + g * 4;
            bf16x8 pb[QT];
#pragma unroll
            for (int qt = 0; qt < QT; ++qt) {
#pragma unroll
                for (int a = 0; a < 2; ++a)
#pragma unroll
                    for (int j = 0; j < 4; ++j) {
                        float pv = fast_exp2(sacc[a][qt][j]);
                        if (WIN) { const int dlt = (kbase + a * 16 + j) - (q0 + qt * 16 + r); if (dlt > 128 || dlt < -128) pv = 0.f; }
                        sacc[a][qt][j] = pv; lsum[qt] += pv;
                    }
                u32x4 u;
                u.x = pk2(sacc[0][qt][0], sacc[0][qt][1]); u.y = pk2(sacc[0][qt][2], sacc[0][qt][3]);
                u.z = pk2(sacc[1][qt][0], sacc[1][qt][1]); u.w = pk2(sacc[1][qt][2], sacc[1][qt][3]);
                pb[qt] = __builtin_bit_cast(bf16x8, u);
            }
#pragma unroll
            for (int dt = 0; dt < 4; ++dt) {
                const bf16x8 vf = *(const bf16x8*)(sV + (dt * 16 + r) * 128 + (((kk * 4 + g) ^ vsw) * 16));
#pragma unroll
                for (int qt = 0; qt < QT; ++qt) oacc[dt][qt] = __builtin_amdgcn_mfma_f32_16x16x32_bf16(vf, pb[qt], oacc[dt][qt], 0, 0, 0);
            }
            __builtin_amdgcn_sched_barrier(0);
        }
        __syncthreads();
    }
#pragma unroll
    for (int qt = 0; qt < QT; ++qt) {
        const float inv = fast_rcp(xor_reduce_g(lsum[qt]) + sink_term);
        bf16_t* orow = Ow + (size_t)(qt * 16 + r) * ldo + g * 4;
#pragma unroll
        for (int dt = 0; dt < 4; ++dt) { const f32x4 a = oacc[dt][qt] * inv; *(u32x2*)(orow + dt * 16) = (u32x2){pk2(a.x, a.y), pk2(a.z, a.w)}; }
    }
}

DI float max_abs(const float* v, int n) { float m = 0.f; for (int i = 0; i < n; ++i) m = fmaxf(m, fabsf(v[i])); return m; }

DI void phase3(const Params& p, char* lds) {
    unsigned char* ws = p.ws;
    const int tid = opaque_tid(), wave = tid >> 6;
    const float shiftB = 9.797958971132712f * max_abs(p.in[15], 96) * max_abs(p.in[16], 96) * LOG2E;
    const float shiftA = 8.f * max_abs(p.in[8], 64) * max_abs(p.in[9], 64) * LOG2E;
    bf16_t* OA = (bf16_t*)(p.ws + O_OA);
    bf16_t* OB = (bf16_t*)(p.ws + O_OB);
    constexpr int NB_ITEMS = 24 * 8 * 8, NA_ITEMS = 24 * 2 * 32;
    for (int L = blockIdx.x; L < NB_ITEMS; L += gridDim.x) {
        const int idx = (L & 7) * (NB_ITEMS / 8) + (L >> 3);
        const int bh = idx >> 3, qb = idx & 7, b = bh >> 3, h = bh & 7;
        const int q0 = qb * 512 + wave * 64;
        attn_item<96, false>((const bf16_t*)(ws + O_QB) + ((size_t)bh * S + q0) * 96, (const bf16_t*)(ws + O_KB) + (size_t)bh * S * 96,
                             (const bf16_t*)(ws + O_VTB) + (size_t)bh * 64 * S, 0, S / 64, q0, shiftB, 0.f,
                             OB + ((size_t)b * S + q0) * 512 + h * 64, 512, lds, tid);
    }
    for (int L = blockIdx.x; L < NA_ITEMS; L += gridDim.x) {
        const int idx = (L & 7) * (NA_ITEMS / 8) + (L >> 3);
        const int bk = idx >> 5, qb = idx & 31, b = bk >> 1, kvh = bk & 1;
        const int q0 = qb * 128 + (wave >> 2) * 64, hd = kvh * 4 + (wave & 3);
        int ks = qb * 128 - 128; if (ks < 0) ks = 0; if (ks > S - 384) ks = S - 384;
        const float sink_term = fast_exp2(p.in[10][hd] * LOG2E - shiftA);
        attn_item<64, true>((const bf16_t*)(ws + O_QA) + ((size_t)(b * 8 + hd) * S + q0) * 64, (const bf16_t*)(ws + O_KA) + (size_t)bk * S * 64,
                            (const bf16_t*)(ws + O_VTA) + (size_t)bk * 64 * S, ks, 6, q0, shiftA, sink_term,
                            OA + ((size_t)b * S + q0) * 512 + hd * 64, 512, lds, tid);
    }
}

DI void phase4(const Params& p, char* lds) {
    const bf16_t* Gt = (const bf16_t*)((unsigned char*)p.out + OO_G);
    bf16_t* MIX = (bf16_t*)(p.ws + O_ZS);
    pg8::StaticOrder so; so.init(T, 1024, gridDim.x, blockIdx.x);
    {
        pg8::Gemm g{(const bf16_t*)(p.ws + O_OA), (const bf16_t*)(p.ws + O_WOA), T, 1024, 512};
        EpiMix<false> E{Gt, MIX};
        pg8::gemm_phase<EpiMix<false>, pg8::StaticOrder, false>((PG8_LAS unsigned char*)lds, g, so, E, nullptr);
    }
    {
        pg8::Gemm g{(const bf16_t*)(p.ws + O_OB), (const bf16_t*)(p.ws + O_WOB), T, 1024, 512};
        EpiMix<true> E{Gt, MIX};
        pg8::gemm_phase<EpiMix<true>, pg8::StaticOrder, false>((PG8_LAS unsigned char*)lds, g, so, E, nullptr);
    }
}

DI void phase5(const Params& p, char* lds) {
    pg8::Gemm g{(const bf16_t*)(p.ws + O_ZS), (const bf16_t*)(p.ws + O_WOUT), T, 1024, 1024};
    pg8::StaticOrder so; so.init(T, 1024, gridDim.x, blockIdx.x);
    EpiRes<false> E{p.in[0], p.in[1], p.out, (const float*)(p.ws + O_MOD) + 2048};
    pg8::gemm_phase<EpiRes<false>, pg8::StaticOrder, false>((PG8_LAS unsigned char*)lds, g, so, E, nullptr);
}

struct OneUnit {
    pg8::Unit u;
    DI bool next(int i, pg8::Unit& o) const { if (i) return false; o = u; return true; }
    DI void a_ready(const pg8::Unit&) const {}
    DI void done(const pg8::Unit&) const {}
};
struct EpiConv {
    static constexpr bool PERM = true, AFTER_DRAIN = true;
    bf16_t* ACT; const float* cw; const float* cb;
    DI void operator()(const f32x4 (&)[2][2][4][2], const pg8::Unit&, int, int, int, int) const {}
    DI void fused(const f32x4 (&acc)[2][2][4][2], const pg8::Unit& u, int wr, int wc, int fr, int fq, PG8_LAS unsigned char* lds, int wid, int lane) const {
#pragma unroll
        for (int ai = 0; ai < 2; ++ai)
#pragma unroll
            for (int m = 0; m < 4; ++m) {
                const int row = ai * 128 + wr * 64 + m * 16 + fr;
#pragma unroll
                for (int bj = 0; bj < 2; ++bj) {
                    const int ch = bj * 16 + wc * 4 + fq;
                    const f32x4 v0 = acc[ai][bj][m][0], v1 = acc[ai][bj][m][1];
                    u32x4 w; w.x = pk2(v0.x, v0.y); w.y = pk2(v0.z, v0.w); w.z = pk2(v1.x, v1.y); w.w = pk2(v1.z, v1.w);
                    *(PG8_LAS u32x4*)(lds + row * 512 + ((ch ^ (row & 31)) * 16)) = w;
                }
            }
        __syncthreads();
        {
            const int tid = wid * 64 + lane, cc = tid & 15, rr = tid >> 4;
            const int ca = u.pn * 128 + cc * 8, cg = DFF + ca;
            float wa[3][8], wg[3][8], ba[8], bg[8];
#pragma unroll
            for (int q = 0; q < 2; ++q) {
#pragma unroll
                for (int t = 0; t < 3; ++t) {
                    const f32x4 x = *(const f32x4*)(cw + t * NUP + ca + 4 * q), y = *(const f32x4*)(cw + t * NUP + cg + 4 * q);
#pragma unroll
                    for (int e = 0; e < 4; ++e) { wa[t][4 * q + e] = x[e]; wg[t][4 * q + e] = y[e]; }
                }
                const f32x4 x = *(const f32x4*)(cb + ca + 4 * q), y = *(const f32x4*)(cb + cg + 4 * q);
#pragma unroll
                for (int e = 0; e < 4; ++e) { ba[4 * q + e] = x[e]; bg[4 * q + e] = y[e]; }
            }
#pragma unroll 2
            for (int q = 0; q < 8; ++q) {
                const int e1 = rr + 32 * q;
                const int pr1 = u.pm * 254 + e1 - 1;
                const int b = pr1 / SEQP, s = pr1 - b * SEQP;
                if (e1 >= 1 && e1 <= 254 && s < S && b < NBATCH) {
                    float a0[8], a1[8], a2[8], g0[8], g1[8], g2[8];
                    const int r0 = e1 - 1, r1 = e1, r2 = e1 + 1;
                    unpack8(*(const PG8_LAS u32x4*)(lds + r0 * 512 + ((cc ^ (r0 & 31)) * 16)), a0);
                    unpack8(*(const PG8_LAS u32x4*)(lds + r1 * 512 + ((cc ^ (r1 & 31)) * 16)), a1);
                    unpack8(*(const PG8_LAS u32x4*)(lds + r2 * 512 + ((cc ^ (r2 & 31)) * 16)), a2);
                    unpack8(*(const PG8_LAS u32x4*)(lds + r0 * 512 + (((16 + cc) ^ (r0 & 31)) * 16)), g0);
                    unpack8(*(const PG8_LAS u32x4*)(lds + r1 * 512 + (((16 + cc) ^ (r1 & 31)) * 16)), g1);
                    unpack8(*(const PG8_LAS u32x4*)(lds + r2 * 512 + (((16 + cc) ^ (r2 & 31)) * 16)), g2);
                    float av[8];
#pragma unroll
                    for (int e = 0; e < 8; ++e) {
                        const float ua = ba[e] + wa[0][e] * a0[e] + wa[1][e] * a1[e] + wa[2][e] * a2[e];
                        const float ug = bg[e] + wg[0][e] * g0[e] + wg[1][e] * g1[e] + wg[2][e] * g2[e];
                        av[e] = ug * sigmoidf_(ug) * ua;
                    }
                    u32x4 ov; ov.x = pk2(av[0], av[1]); ov.y = pk2(av[2], av[3]); ov.z = pk2(av[4], av[5]); ov.w = pk2(av[6], av[7]);
                    *(u32x4*)(ACT + ((size_t)b * S + s) * DFF + ca) = ov;
                }
            }
        }
        __syncthreads();
    }
};

DI void phase7(const Params& p, char* lds) {
    pg8::Gemm g{(const bf16_t*)(p.ws + O_H2P), (const bf16_t*)(p.ws + O_WUP), 388 * 256, NUP, 1024, 254};
    pg8::StaticOrder so; so.init(388 * 256, NUP, gridDim.x, blockIdx.x);
    EpiConv E{(bf16_t*)(p.ws + O_ACT), p.in[22], p.in[23]};
    for (int i = 0;; ++i) {
        OneUnit one;
        if (!so.next(i, one.u)) break;
        pg8::gemm_phase<EpiConv, OneUnit, false>((PG8_LAS unsigned char*)lds, g, one, E, nullptr);
    }
}

DI void phase8(const Params& p, char* lds) {
    pg8::Gemm g{(const bf16_t*)(p.ws + O_ACT), (const bf16_t*)(p.ws + O_WDN), T, 1024, DFF};
    pg8::StaticOrder so; so.init(T, 1024, gridDim.x, blockIdx.x);
    EpiRes<true> E{p.in[0], p.in[1], p.out, (const float*)(p.ws + O_MOD) + 5120};
    pg8::gemm_phase<EpiRes<true>, pg8::StaticOrder, false>((PG8_LAS unsigned char*)lds, g, so, E, nullptr);
}

__global__ void __launch_bounds__(512) fwd_megakernel(Params p) {
    __shared__ __attribute__((aligned(16))) char lds[131072];
    cg::grid_group grid = cg::this_grid();
    char* lds4 = lds + __builtin_amdgcn_readfirstlane((int)(threadIdx.x >> 8)) * 65536;
    phase0(p, lds4);
    grid.sync();
    phase0m(p);
    grid.sync();
    norm_pass(p, false, (bf16_t*)(p.ws + O_H));
    grid.sync();
    phase1(p, lds);
    grid.sync();
    phase2(p, lds4);
    grid.sync();
    phase3(p, lds);
    grid.sync();
    phase4(p, lds);
    grid.sync();
    phase5(p, lds);
    grid.sync();
    norm_pass(p, true, (bf16_t*)(p.ws + O_H2P));
    grid.sync();
    phase7(p, lds);
    grid.sync();
    phase8(p, lds);
}

extern "C" void kernel_launch(void* const* d_in, const int* in_sizes, int n_in, void* d_out, int out_size, void* d_ws, size_t ws_size,
                              hipStream_t stream) {
    static int grid_blocks = 0;
    if (!grid_blocks) {
        int dev = 0, cus = 0, per_cu = 0;
        hipGetDevice(&dev);
        hipDeviceGetAttribute(&cus, hipDeviceAttributeMultiprocessorCount, dev);
        hipOccupancyMaxActiveBlocksPerMultiprocessor(&per_cu, fwd_megakernel, 512, 0);
        if (per_cu < 1) per_cu = 1;
        if (per_cu > 1) per_cu = 1;
        grid_blocks = cus * per_cu;
        if (n_in != 25 || ws_size < WS_NEED || out_size != T * D)
            fprintf(stderr, "kernel_launch: unexpected sizes n_in=%d ws=%zu out=%d\n", n_in, ws_size, out_size);
    }
    Params p{};
    for (int i = 0; i < 25; ++i) p.in[i] = (const float*)d_in[i];
    p.out = (float*)d_out;
    p.ws = (unsigned char*)d_ws;
    void* args[] = {&p};
    hipError_t e = hipLaunchCooperativeKernel((void*)fwd_megakernel, dim3(grid_blocks), dim3(512), args, 0, stream);
    if (e != hipSuccess) fprintf(stderr, "cooperative launch failed: %s (grid %d)\n", hipGetErrorString(e), grid_blocks);
}
```

```cpp
#include <hip/hip_runtime.h>
#include <hip/hip_cooperative_groups.h>
#include <cstdio>
#include <cstdint>
namespace cg = cooperative_groups;
#ifndef PM
#define PM 4095
#endif
#ifndef DUP
#define DUP 0
#define XSYNC 0
#endif

typedef unsigned short bf16_t;
typedef short bf16x8 __attribute__((ext_vector_type(8)));
typedef float f32x4 __attribute__((ext_vector_type(4)));
typedef unsigned u32x4 __attribute__((ext_vector_type(4)));
typedef unsigned u32x2 __attribute__((ext_vector_type(2)));
#define DI __device__ __forceinline__
__device__ __forceinline__ int opaque_tid() { int t = threadIdx.x; asm volatile("" : "+v"(t)); return t; }
#define TID4 (tid_ & 255)
#define VBID ((int)(blockIdx.x * 2 + (tid_ >> 8)))
#define VGRID ((int)(gridDim.x * 2))

constexpr int D = 1024, S = 4096, NBATCH = 24, T = NBATCH * S;
constexpr int T_PROMPT = 8 * S;
constexpr int IN_TOTAL = 3232, NZ = 1280  , NIN = NZ + 2048;
constexpr int DFF = 2816, NUP = 2 * DFF;
constexpr float EPS = 1e-6f;
constexpr float LOG2E = 1.4426950408889634f;
constexpr int NCHUNK = 4, TCH = T / NCHUNK;

constexpr size_t MiB = 1024ull * 1024ull;
constexpr size_t O_WIN = 0;
constexpr size_t O_WUQ = O_WIN + (size_t)NIN * 1024 * 2;
constexpr size_t O_WUKV = O_WUQ + 768ull * 256 * 2;
constexpr size_t O_WOA = O_WUKV + 1024ull * 128 * 2;
constexpr size_t O_WOB = O_WOA + 1024ull * 512 * 2;
constexpr size_t O_WOUT = O_WOB + 1024ull * 512 * 2;
constexpr size_t O_WUP = O_WOUT + 1024ull * 1024 * 2;
constexpr size_t O_WDN = O_WUP + (size_t)NUP * 1024 * 2;
constexpr size_t O_MODP = O_WDN + 1024ull * DFF * 2;
constexpr size_t O_MOD = O_MODP + 16ull * 24 * 6144 * 4;
constexpr size_t O_ROPEA = O_MOD + 24ull * 6144 * 4;
constexpr size_t O_ROPEB = O_ROPEA + 4096ull * 32 * 8;
constexpr size_t O_ZROW = O_ROPEB + 4096ull * 16 * 8;
constexpr size_t O_WB_END = O_ZROW + 4096;
static_assert(O_WB_END <= 48 * MiB, "weights region");
constexpr size_t O_ZS = 48 * MiB;
constexpr size_t O_QA = 288 * MiB;
constexpr size_t O_KA = O_QA + 96 * MiB;
constexpr size_t O_VTA = O_KA + 24 * MiB;
constexpr size_t O_QB = O_VTA + 24 * MiB;
constexpr size_t O_KB = O_QB + 144 * MiB;
constexpr size_t O_VTB = O_KB + 144 * MiB;
constexpr size_t O_H = 816 * MiB;
constexpr size_t O_UP = 288 * MiB;
constexpr int SEQP = S + 1, H2P_ROWS = 388 * 254 + 2;
constexpr size_t O_H2P = 48 * MiB;
constexpr size_t O_ACT = 288 * MiB;
constexpr size_t WS_NEED = 1008 * MiB;
static_assert(O_VTB + 96 * MiB <= O_H, "qkv region");
constexpr size_t OO_G = 0, O_OA = O_H, O_OB = O_H + 96 * MiB;

struct Params {
    const float* in[25];
    float* out;
    unsigned char* ws;
};

typedef __bf16 bf16x2_t __attribute__((ext_vector_type(2)));
typedef float f32x2_t __attribute__((ext_vector_type(2)));
DI unsigned pk2(float lo, float hi) { const f32x2_t v = {lo, hi}; return __builtin_bit_cast(unsigned, __builtin_convertvector(v, bf16x2_t)); }
DI float bflo(unsigned u) { return __uint_as_float(u << 16); }
DI float bfhi(unsigned u) { return __uint_as_float(u & 0xffff0000u); }
DI float bf2f(bf16_t v) { return __uint_as_float(((unsigned)v) << 16); }
DI bf16_t f2bf(float v) { return (bf16_t)(pk2(v, v) & 0xffffu); }
DI void unpack8(const u32x4 v, float (&f)[8]) {
    f[0] = bflo(v.x); f[1] = bfhi(v.x); f[2] = bflo(v.y); f[3] = bfhi(v.y); f[4] = bflo(v.z); f[5] = bfhi(v.z); f[6] = bflo(v.w); f[7] = bfhi(v.w);
}
DI float fast_rcp(float x) { return __builtin_amdgcn_rcpf(x); }
DI float fast_exp2(float x) { return __builtin_amdgcn_exp2f(x); }
DI float sigmoidf_(float v) { return fast_rcp(1.f + fast_exp2(-v * LOG2E)); }
DI float xor_reduce_g(float v) { v += __shfl_xor(v, 16); v += __shfl_xor(v, 32); return v; }
DI float wave_sum(float v) {
#pragma unroll
    for (int o = 1; o < 64; o <<= 1) v += __shfl_xor(v, o);
    return v;
}
DI int perm32(int s) { const int lo = s & 31; return (s & ~31) | (((lo >> 2) & 3) << 3) | ((lo >> 4) << 2) | (lo & 3); }
DI const float* xrow_ptr(const Params& p, int t) { return t < T_PROMPT ? p.in[0] + (size_t)t * D : p.in[1] + (size_t)(t - T_PROMPT) * D; }

DI void tile_map(int L, int nN, int ntiles, int& pm, int& pn) {
    const int xcd = L & 7, q = L >> 3;
    const int Lp = xcd * (ntiles >> 3) + q;
    const int grp = Lp / (8 * nN), rem = Lp % (8 * nN);
    pm = grp * 8 + (rem & 7); pn = rem >> 3;
}

#define LAS __attribute__((address_space(3)))
#define GAS __attribute__((address_space(1)))
template <int BM, int BN, int NWM, int NWN>
DI void gemm_mainloop_p(f32x4 (&acc)[BM / NWM / 16][BN / NWN / 16], const bf16_t* const (&Ar)[BM / (NWM * NWN * 8)],
                        const bf16_t* __restrict__ B, int ldb, int K, char* lds, const int tid) {
    constexpr int RPR = NWM * NWN * 8;
    constexpr int MT = BM / NWM / 16, NT = BN / NWN / 16, NA = BM / RPR, NB = BN / RPR, STAGE = (BM + BN) * 128, RB = RPR * 128;
    const int lane = tid & 63, wave = tid >> 6;
    const int wm = wave / NWN, wn = wave % NWN;
    const int r = lane & 15, g = lane >> 4;
    const int lr = tid >> 3, lc = tid & 7;
    const int csrc = (lc ^ ((lr >> 1) & 7)) * 8;
    const bf16_t* Bp = B + (size_t)lr * ldb + csrc;
    const int nk = K >> 6;
    auto issue = [&](int kt, int st) {
        char* d = lds + st * STAGE + tid * 16;
#pragma unroll
        for (int i = 0; i < NA; ++i)
            __builtin_amdgcn_global_load_lds((const GAS unsigned*)(Ar[i] + kt * 64), (LAS unsigned*)(d + i * RB), 16, 0, 0);
#pragma unroll
        for (int i = 0; i < NB; ++i)
            __builtin_amdgcn_global_load_lds((const GAS unsigned*)(Bp + (size_t)(RPR * i) * ldb + kt * 64), (LAS unsigned*)(d + BM * 128 + i * RB), 16, 0, 0);
    };
    issue(0, 0);
    __syncthreads();
    const int rsw = (r >> 1) & 7;
    for (int kt = 0; kt < nk; ++kt) {
        const int cur = kt & 1;
        if (kt + 1 < nk) issue(kt + 1, cur ^ 1);
        const char* sA = lds + cur * STAGE;
        const char* sB = sA + BM * 128;
#pragma unroll
        for (int ks = 0; ks < 2; ++ks) {
            bf16x8 wf[NT], xf[MT];
            const int co = ((ks * 4 + g) ^ rsw) * 16;
#pragma unroll
            for (int nt = 0; nt < NT; ++nt) wf[nt] = *(const bf16x8*)(sB + (wn * (NT * 16) + nt * 16 + r) * 128 + co);
#pragma unroll
            for (int mt = 0; mt < MT; ++mt) xf[mt] = *(const bf16x8*)(sA + (wm * (MT * 16) + mt * 16 + r) * 128 + co);
#pragma unroll
            for (int mt = 0; mt < MT; ++mt)
#pragma unroll
                for (int nt = 0; nt < NT; ++nt) acc[mt][nt] = __builtin_amdgcn_mfma_f32_16x16x32_bf16(wf[nt], xf[mt], acc[mt][nt], 0, 0, 0);
        }
        __syncthreads();
    }
}

template <int BM, int BN, int NWM, int NWN>
DI void gemm_mainloop(f32x4 (&acc)[BM / NWM / 16][BN / NWN / 16], const bf16_t* __restrict__ A, int lda,
                      const bf16_t* __restrict__ B, int ldb, int K, char* lds, const int tid) {
    constexpr int RPR = NWM * NWN * 8;
    const int lr = tid >> 3, lc = tid & 7;
    const bf16_t* Ar[BM / RPR];
#pragma unroll
    for (int i = 0; i < BM / RPR; ++i) Ar[i] = A + (size_t)(lr + RPR * i) * lda + (lc ^ ((lr >> 1) & 7)) * 8;
    gemm_mainloop_p<BM, BN, NWM, NWN>(acc, Ar, B, ldb, K, lds, tid);
}

template <int MT, int NT>
DI void zero_acc(f32x4 (&acc)[MT][NT]) {
#pragma unroll
    for (int i = 0; i < MT; ++i)
#pragma unroll
        for (int j = 0; j < NT; ++j) acc[i][j] = (f32x4){0.f, 0.f, 0.f, 0.f};
}

namespace pg8 {
#define PG8_LAS __attribute__((address_space(3)))
constexpr int BM = 256, BK = 64, HALF = 128, HTB = HALF * BK * 2, STAGE_BYTES = 8 * HTB, NXCD = 8, WGM = 8;
__host__ __device__ __forceinline__ int lds_byte(int r, int c) { const int st = (r >> 4) * 2 + (c >> 5), rr = r & 15, cc = c & 31, ob = rr * 64 + cc * 2; return st * 1024 + (ob ^ (((ob >> 9) & 1) << 5)); }
__host__ __device__ __forceinline__ void stage_rc(int b, int& R, int& C) { const int st = b / 1024, sb = b % 1024, swz = sb ^ (((sb >> 9) & 1) << 5); R = (st >> 1) * 16 + swz / 64; C = (st & 1) * 32 + (swz % 64) / 2; }
__host__ __device__ __forceinline__ int perm32(int rho) { const int n = rho >> 4, i = rho & 15; return 8 * (i >> 2) + 4 * n + (i & 3); }
struct Unit { int pm, pn; };
struct Gemm { const bf16_t* A; const bf16_t* Bt; int M, N, K; int a_rows = 256; };
struct StaticOrder {
    int nM, nN, nwg, G, c;
    __host__ __device__ void init(int M, int N, int G_, int c_) { nM = M / BM; nN = N / BM; nwg = nM * nN; G = G_; c = c_; }
    __host__ __device__ bool next(int i, Unit& u) const {
        const long L = (long)i * G + c; if (L >= nwg) return false;
        int wgid = (int)L; { const int q = nwg / NXCD, r = nwg % NXCD, xcd = wgid % NXCD, off = wgid / NXCD; wgid = (xcd < r ? xcd * (q + 1) : r * (q + 1) + (xcd - r) * q) + off; }
        const int nig = WGM * nN, gid = wgid / nig, fm = gid * WGM, gsz = (nM - fm) < WGM ? (nM - fm) : WGM;
        u.pm = fm + ((wgid % nig) % gsz); u.pn = (wgid % nig) / gsz; return true;
    }
    __device__ __forceinline__ void a_ready(const Unit&) const {}
    __device__ __forceinline__ void done(const Unit&) const {}
};
template <class Epi, class Sched, bool STAMP = false>
__device__ __forceinline__ void gemm_phase(PG8_LAS unsigned char* lds, const Gemm g, const Sched& S, const Epi& E, unsigned long long* stamps) {
    const int tid = opaque_tid(), wid = __builtin_amdgcn_readfirstlane(tid >> 6), lane = tid & 63, wr = wid >> 2, wc = wid & 3, fr = lane & 15, fq = lane >> 4;
    const int K = g.K, nt = K / BK;
    int ts_lo = 0, ts_hi = 0, nts = 0; const unsigned long long rt_entry = STAMP ? (unsigned long long)wall_clock64() : 0ull;
#define PG8_STAMP() do { if (STAMP && wid == 0 && nts < 64) { const unsigned long long _c = (unsigned long long)clock64(); \
        ts_lo = (lane == nts) ? (int)(unsigned)_c : ts_lo; ts_hi = (lane == nts) ? (int)(unsigned)(_c >> 32) : ts_hi; ++nts; } } while (0)
    PG8_STAMP();
    unsigned voffA[2], voffB[2];
#pragma unroll
    for (int i = 0; i < 2; ++i) { int R, C; stage_rc(tid * 16 + i * 8192, R, C); const int Rb = Epi::PERM ? ((R & ~31) + perm32(R & 31)) : R;
        voffA[i] = (unsigned)(R * K + C) * 2u; voffB[i] = (unsigned)(Rb * K + C) * 2u; }
    const size_t kstep = (size_t)(BK * 2);
    const size_t hstep = (size_t)HALF * K * 2;
    const size_t tstep = 2 * hstep;
    const size_t tstepA = (size_t)g.a_rows * K * 2;
    const unsigned ldsw = (unsigned)wid * 1024u;
    const int aoff = lds_byte(wr * 64 + fr, fq * 8), boff = lds_byte(wc * 32 + fr, fq * 8);
#define PG8_SA(b, h) (((b) * 2 + (h)) * HTB)
#define PG8_SB(b, h) ((4 + (b) * 2 + (h)) * HTB)
#define PG8_STAGE(bufoff, gbase, voff) do { _Pragma("unroll") for (int _i = 0; _i < 2; ++_i) \
        __builtin_amdgcn_global_load_lds((const unsigned*)((const char*)(gbase) + (voff)[_i]), (PG8_LAS unsigned*)(lds + (bufoff) + ldsw + _i * 8192), 16, 0, 0); } while (0)
#define PG8_LDA(dst, b, h) do { _Pragma("unroll") for (int m = 0; m < 4; ++m) _Pragma("unroll") for (int k = 0; k < 2; ++k) dst[m][k] = *(const PG8_LAS bf16x8*)(lds + PG8_SA(b, h) + aoff + m * 2048 + k * 1024); } while (0)
#define PG8_LDB(dst, b, h) do { _Pragma("unroll") for (int n = 0; n < 2; ++n) _Pragma("unroll") for (int k = 0; k < 2; ++k) dst[n][k] = *(const PG8_LAS bf16x8*)(lds + PG8_SB(b, h) + boff + n * 2048 + k * 1024); } while (0)
#define PG8_MMA(ai, bj, At, Bt) do { __builtin_amdgcn_s_setprio(1); _Pragma("unroll") for (int m = 0; m < 4; ++m) _Pragma("unroll") for (int n = 0; n < 2; ++n) _Pragma("unroll") for (int k = 0; k < 2; ++k) \
        acc[ai][bj][m][n] = __builtin_amdgcn_mfma_f32_16x16x32_bf16(Bt[n][k], At[m][k], acc[ai][bj][m][n], 0, 0, 0); __builtin_amdgcn_s_setprio(0); } while (0)
#define PG8_WAIT_V(n) asm volatile("s_waitcnt vmcnt(" #n ")" ::: "memory")
#define PG8_WAIT_L(n) asm volatile("s_waitcnt lgkmcnt(" #n ")" ::: "memory")
#define PG8_BAR __builtin_amdgcn_s_barrier()
#define PG8_SCHED __builtin_amdgcn_sched_barrier(0)
    Unit cur, nxt; int ui = 0;
    if (!S.next(0, cur)) return;
    f32x4 acc[2][2][4][2];
#pragma unroll
    for (int a = 0; a < 2; ++a)
#pragma unroll
        for (int b = 0; b < 2; ++b)
#pragma unroll
            for (int m = 0; m < 4; ++m)
#pragma unroll
                for (int n = 0; n < 2; ++n) acc[a][b][m][n] = (f32x4){0.f, 0.f, 0.f, 0.f};
    bf16x8 At[4][2], B0[2][2], B1[2][2];
    const char* cA = (const char*)g.A + (size_t)cur.pm * tstepA; const char* cB = (const char*)g.Bt + (size_t)cur.pn * tstep;
    S.a_ready(cur);
    PG8_STAGE(PG8_SB(0, 0), cB, voffB); PG8_STAGE(PG8_SA(0, 0), cA, voffA); PG8_STAGE(PG8_SB(0, 1), cB + hstep, voffB); PG8_STAGE(PG8_SA(0, 1), cA + hstep, voffA);
    if (wr == 1) PG8_BAR;
    PG8_WAIT_V(4); PG8_BAR;
    PG8_STAGE(PG8_SB(1, 0), cB + kstep, voffB); PG8_STAGE(PG8_SA(1, 0), cA + kstep, voffA); PG8_STAGE(PG8_SB(1, 1), cB + hstep + kstep, voffB);
    PG8_WAIT_V(6); PG8_BAR;
    PG8_STAMP();
    for (;;) {
        const bool has_next = S.next(ui + 1, nxt);
        const char* nA = has_next ? (const char*)g.A + (size_t)nxt.pm * tstepA : cA; const char* nB = has_next ? (const char*)g.Bt + (size_t)nxt.pn * tstep : cB;
        for (int t = 0; t < nt; t += 2) {
            const bool last = (t == nt - 2);
            const char* a1 = cA + (size_t)(t + 1) * kstep;
            const char* a2 = last ? nA : cA + (size_t)(t + 2) * kstep; const char* b2 = last ? nB : cB + (size_t)(t + 2) * kstep;
            const char* a3 = a2 + kstep; const char* b3 = b2 + kstep;
            if (last && has_next) S.a_ready(nxt);
            PG8_LDB(B0, 0, 0); PG8_SCHED; PG8_LDA(At, 0, 0); PG8_STAGE(PG8_SA(1, 1), a1 + hstep, voffA);
            PG8_WAIT_L(8); PG8_BAR; PG8_WAIT_L(0); PG8_MMA(0, 0, At, B0); PG8_BAR; PG8_SCHED;
            PG8_LDB(B1, 0, 1); PG8_STAGE(PG8_SB(0, 0), b2, voffB);
            PG8_BAR; PG8_WAIT_L(0); PG8_MMA(0, 1, At, B1); PG8_BAR;
            PG8_LDA(At, 0, 1); PG8_STAGE(PG8_SA(0, 0), a2, voffA);
            PG8_BAR; PG8_WAIT_L(0); PG8_MMA(1, 0, At, B0); PG8_BAR; PG8_SCHED;
            PG8_STAGE(PG8_SB(0, 1), b2 + hstep, voffB);
            PG8_WAIT_V(6); PG8_BAR; PG8_MMA(1, 1, At, B1); PG8_BAR;
            PG8_LDB(B0, 1, 0); PG8_SCHED; PG8_LDA(At, 1, 0); PG8_STAGE(PG8_SA(0, 1), a2 + hstep, voffA);
            PG8_WAIT_L(8); PG8_BAR; PG8_WAIT_L(0); PG8_MMA(0, 0, At, B0); PG8_BAR; PG8_SCHED;
            PG8_LDB(B1, 1, 1); PG8_STAGE(PG8_SB(1, 0), b3, voffB);
            PG8_BAR; PG8_WAIT_L(0); PG8_MMA(0, 1, At, B1); PG8_BAR;
            PG8_LDA(At, 1, 1); PG8_STAGE(PG8_SA(1, 0), a3, voffA);
            PG8_BAR; PG8_WAIT_L(0); PG8_MMA(1, 0, At, B0); PG8_BAR; PG8_SCHED;
            PG8_STAGE(PG8_SB(1, 1), b3 + hstep, voffB);
            PG8_WAIT_V(6); PG8_BAR; PG8_MMA(1, 1, At, B1); PG8_BAR;
        }
        PG8_STAMP();
        if constexpr (!Epi::AFTER_DRAIN) { E(acc, cur, wr, wc, fr, fq); S.done(cur); }
        PG8_STAMP();
        if (!has_next) break;
#pragma unroll
        for (int a = 0; a < 2; ++a)
#pragma unroll
            for (int b = 0; b < 2; ++b)
#pragma unroll
                for (int m = 0; m < 4; ++m)
#pragma unroll
                    for (int n = 0; n < 2; ++n) acc[a][b][m][n] = (f32x4){0.f, 0.f, 0.f, 0.f};
        cur = nxt; cA = nA; cB = nB; ++ui;
    }
    PG8_WAIT_V(0);
    if (wr == 0) PG8_BAR;
    PG8_BAR;
    if constexpr (Epi::AFTER_DRAIN) { E.fused(acc, cur, wr, wc, fr, fq, lds, wid, lane); S.done(cur); }
    PG8_STAMP();
    if (STAMP && wid == 0) { stamps[lane] = lane < nts ? (((unsigned long long)(unsigned)ts_hi << 32) | (unsigned)ts_lo) : 0ull;
        if (lane == 62) stamps[62] = rt_entry; if (lane == 63) stamps[63] = (unsigned long long)wall_clock64(); }
#undef PG8_STAMP
#undef PG8_SA
#undef PG8_SB
#undef PG8_STAGE
#undef PG8_LDA
#undef PG8_LDB
#undef PG8_MMA
#undef PG8_WAIT_V
#undef PG8_WAIT_L
#undef PG8_BAR
#undef PG8_SCHED
}
}


struct EpiP1 {
    static constexpr bool PERM = true, AFTER_DRAIN = false;
    bf16_t* ZS; bf16_t* G;
    DI void operator()(const f32x4 (&acc)[2][2][4][2], const pg8::Unit& u, int wr, int wc, int fr, int fq) const {
        const int row0 = u.pm * 256 + wr * 64 + fr, colt = u.pn * 256 + wc * 32 + 8 * fq;
        const bool small = u.pn < NZ / 256;
#pragma unroll
        for (int ai = 0; ai < 2; ++ai)
#pragma unroll
            for (int m = 0; m < 4; ++m) {
                const size_t row = (size_t)(row0 + ai * 128 + m * 16);
#pragma unroll
                for (int bj = 0; bj < 2; ++bj) {
                    const int col = colt + bj * 128;
                    const f32x4 v0 = acc[ai][bj][m][0], v1 = acc[ai][bj][m][1];
                    u32x4 w;
                    if (small) { w.x = pk2(v0.x, v0.y); w.y = pk2(v0.z, v0.w); w.z = pk2(v1.x, v1.y); w.w = pk2(v1.z, v1.w); *(u32x4*)(ZS + row * NZ + col) = w; }
                    else { w.x = pk2(sigmoidf_(v0.x), sigmoidf_(v0.y)); w.y = pk2(sigmoidf_(v0.z), sigmoidf_(v0.w)); w.z = pk2(sigmoidf_(v1.x), sigmoidf_(v1.y)); w.w = pk2(sigmoidf_(v1.z), sigmoidf_(v1.w));
                           *(u32x4*)(G + row * 2048 + (col - NZ)) = w; }
                }
            }
    }
};
template <bool SECOND> struct EpiMix {
    static constexpr bool PERM = true, AFTER_DRAIN = false;
    const bf16_t* G; bf16_t* MIX;
    DI void operator()(const f32x4 (&acc)[2][2][4][2], const pg8::Unit& u, int wr, int wc, int fr, int fq) const {
        const int row0 = u.pm * 256 + wr * 64 + fr, colt = u.pn * 256 + wc * 32 + 8 * fq;
#pragma unroll
        for (int ai = 0; ai < 2; ++ai)
#pragma unroll
            for (int m = 0; m < 4; ++m) {
                const size_t row = (size_t)(row0 + ai * 128 + m * 16);
#pragma unroll
                for (int bj = 0; bj < 2; ++bj) {
                    const int col = colt + bj * 128;
                    float gv[8], o[8];
                    unpack8(*(const u32x4*)(G + row * 2048 + (SECOND ? 1024 : 0) + col), gv);
                    const f32x4 v0 = acc[ai][bj][m][0], v1 = acc[ai][bj][m][1];
                    if (SECOND) unpack8(*(const u32x4*)(MIX + row * 1024 + col), o);
                    else { for (int e = 0; e < 8; ++e) o[e] = 0.f; }
                    o[0] += gv[0] * v0.x; o[1] += gv[1] * v0.y; o[2] += gv[2] * v0.z; o[3] += gv[3] * v0.w;
                    o[4] += gv[4] * v1.x; o[5] += gv[5] * v1.y; o[6] += gv[6] * v1.z; o[7] += gv[7] * v1.w;
                    u32x4 w; w.x = pk2(o[0], o[1]); w.y = pk2(o[2], o[3]); w.z = pk2(o[4], o[5]); w.w = pk2(o[6], o[7]);
                    *(u32x4*)(MIX + row * 1024 + col) = w;
                }
            }
    }
};
template <bool INPLACE> struct EpiRes {
    static constexpr bool PERM = false, AFTER_DRAIN = false;
    const float* xp; const float* xs; float* out; const float* gate;
    DI void operator()(const f32x4 (&acc)[2][2][4][2], const pg8::Unit& u, int wr, int wc, int fr, int fq) const {
        const int row0 = u.pm * 256 + wr * 64 + fr, colt = u.pn * 256 + wc * 32 + 4 * fq;
        const float* gt = gate + (size_t)((u.pm * 256) >> 12) * 6144;
#pragma unroll
        for (int ai = 0; ai < 2; ++ai)
#pragma unroll
            for (int m = 0; m < 4; ++m) {
                const int row = row0 + ai * 128 + m * 16;
                float* orow = out + (size_t)row * D;
                const float* brow = INPLACE ? orow : (row < T_PROMPT ? xp + (size_t)row * D : xs + (size_t)(row - T_PROMPT) * D);
#pragma unroll
                for (int bj = 0; bj < 2; ++bj)
#pragma unroll
                    for (int n = 0; n < 2; ++n) {
                        const int col = colt + bj * 128 + n * 16;
                        const f32x4 xv = *(const f32x4*)(brow + col), gv = *(const f32x4*)(gt + col);
                        *(f32x4*)(orow + col) = xv + gv * acc[ai][bj][m][n];
                    }
            }
    }
};

DI void transpose_item(const float* __restrict__ W, int K, int N, bf16_t* __restrict__ WT, int mode, const float* __restrict__ scale,
                       float* scr, int item, int lane) {
    const int nblk = N >> 5, kb = item / nblk, nb = item % nblk, k0 = kb * 64, n0 = nb * 32;
#pragma unroll 8
    for (int i = 0; i < 32; ++i) {
        const int kk = 2 * i + (lane >> 5);
        float v = W[(size_t)(k0 + kk) * N + n0 + (lane & 31)];
        if (scale) v *= scale[k0 + kk];
        scr[kk * 33 + (lane & 31)] = v;
    }
    asm volatile("s_waitcnt lgkmcnt(0)" ::: "memory");
    const int c = lane & 7;
#pragma unroll
    for (int j = 0; j < 4; ++j) {
        const int nl = (lane >> 3) + 8 * j;
        const float* s = scr + (8 * c) * 33 + nl;
        u32x4 o;
        o.x = pk2(s[0 * 33], s[1 * 33]); o.y = pk2(s[2 * 33], s[3 * 33]); o.z = pk2(s[4 * 33], s[5 * 33]); o.w = pk2(s[6 * 33], s[7 * 33]);
        const int n = n0 + nl;
        int row;
        if (mode == 1) row = n < 1184 ? n : n + 96;
        else if (mode == 2) { const int h = n >> 7, jj = n & 127; row = jj < 64 ? h * 64 + jj : 512 + h * 64 + (jj - 64); }
        else if (mode == 3) { const int hf = n >= DFF ? 1 : 0, m2 = n - hf * DFF; row = (m2 >> 7) * 256 + hf * 128 + (m2 & 127); }
        else row = n;
        *(u32x4*)(WT + (size_t)row * K + k0 + 8 * c) = o;
    }
    asm volatile("s_waitcnt lgkmcnt(0)" ::: "memory");
}

DI void phase0(const Params& p, char* lds) {
    const int tid_ = opaque_tid();
    const int tid = TID4, bid = VBID, G = VGRID, lane = tid & 63, wave = tid >> 6;
    unsigned char* ws = p.ws;
    float* sc = (float*)lds;
    for (int it = bid; it < 384; it += G) {
        const int cb = it % 24, ks = it / 24;
        __syncthreads();
        for (int i = tid; i < 24 * 64; i += 256) {
            const int b = i >> 6, k = i & 63;
            const float* c = b < 8 ? p.in[2] + b * 1024 : p.in[3] + (b - 8) * 1024;
            const float v = c[ks * 64 + k];
            sc[i] = v * sigmoidf_(v);
        }
        __syncthreads();
        float a[24];
#pragma unroll
        for (int b = 0; b < 24; ++b) a[b] = 0.f;
        const int n = cb * 256 + tid;
        const float* w = p.in[4] + (size_t)(ks * 64) * 6144 + n;
        for (int k = 0; k < 64; ++k) {
            const float wv = w[(size_t)k * 6144];
#pragma unroll
            for (int b = 0; b < 24; ++b) a[b] += sc[b * 64 + k] * wv;
        }
        float* mp = (float*)(ws + O_MODP) + (size_t)(ks * 24) * 6144 + n;
#pragma unroll
        for (int b = 0; b < 24; ++b) mp[(size_t)b * 6144] = a[b];
    }
    __syncthreads();
    {
        float* scr = (float*)(lds + wave * 8448);
        const int gw = bid * 4 + wave, NGW = G * 4;
        constexpr int I0 = 16 * 101, I1 = 4 * 24, I2 = 2 * 32, I3 = 8 * 32, I4 = 8 * 32, I5 = 16 * 32, I6 = 16 * 176, I7 = 44 * 32;
        constexpr int NI = I0 + I1 + I2 + I3 + I4 + I5 + I6 + I7;
        for (int it = gw; it < NI; it += NGW) {
            int q = it;
            if (q < I0) { transpose_item(p.in[7], 1024, IN_TOTAL, (bf16_t*)(ws + O_WIN), 1, nullptr, scr, q, lane); continue; } q -= I0;
            if (q < I1) { transpose_item(p.in[12], 256, 768, (bf16_t*)(ws + O_WUQ), 0, p.in[11], scr, q, lane); continue; } q -= I1;
            if (q < I2) { transpose_item(p.in[14], 128, 1024, (bf16_t*)(ws + O_WUKV), 2, p.in[13], scr, q, lane); continue; } q -= I2;
            if (q < I3) { transpose_item(p.in[17], 512, 1024, (bf16_t*)(ws + O_WOA), 0, nullptr, scr, q, lane); continue; } q -= I3;
            if (q < I4) { transpose_item(p.in[18], 512, 1024, (bf16_t*)(ws + O_WOB), 0, nullptr, scr, q, lane); continue; } q -= I4;
            if (q < I5) { transpose_item(p.in[19], 1024, 1024, (bf16_t*)(ws + O_WOUT), 0, nullptr, scr, q, lane); continue; } q -= I5;
            if (q < I6) { transpose_item(p.in[21], 1024, NUP, (bf16_t*)(ws + O_WUP), 3, nullptr, scr, q, lane); continue; } q -= I6;
            transpose_item(p.in[24], DFF, 1024, (bf16_t*)(ws + O_WDN), 0, nullptr, scr, q, lane);
        }
    }
    const int gt = bid * 256 + tid, NGT = G * 256;
    for (int i = gt; i < 4096 * 48; i += NGT) {
        const int pos = i / 48, j = i % 48;
        float inv;
        if (j < 32) inv = exp2f(-(float)(2 * j) * (1.f / 64.f) * 13.287712379549449f);
        else inv = exp2f(-(float)(2 * (j - 32)) * (1.f / 32.f) * 13.287712379549449f);
        const float ang = (float)pos * inv;
        float rev = ang * 0.15915494309189535f;
        rev -= floorf(rev);
        const float sn = __builtin_amdgcn_sinf(rev), cs = __builtin_amdgcn_cosf(rev);
        float2* dst = j < 32 ? (float2*)(ws + O_ROPEA) + pos * 32 + j : (float2*)(ws + O_ROPEB) + pos * 16 + (j - 32);
        *dst = make_float2(cs, sn);
    }
    for (int i = gt; i < 96 * 1024 / 8; i += NGT) *(u32x4*)((bf16_t*)(ws + O_WIN) + 1184 * 1024 + (size_t)i * 8) = (u32x4){0u, 0u, 0u, 0u};
    if (gt < 256) *(u32x4*)(ws + O_ZROW + gt * 16) = (u32x4){0u, 0u, 0u, 0u};
}

DI void phase0m(const Params& p) {
    const int tid_ = opaque_tid();
    const int gt = VBID * 256 + TID4, NGT = VGRID * 256;
    const float* mp = (const float*)(p.ws + O_MODP);
    float* mod = (float*)(p.ws + O_MOD);
    for (int i = gt; i < 24 * 6144; i += NGT) {
        float s = p.in[5][i % 6144];
#pragma unroll
        for (int ks = 0; ks < 16; ++ks) s += mp[(size_t)ks * 24 * 6144 + i];
        mod[i] = s;
    }
}

DI void norm_pass(const Params& p, bool second, bf16_t* dst) {
    const int tid_ = opaque_tid();
    const int lane = TID4 & 63, gw = VBID * 4 + (TID4 >> 6), NGW = VGRID * 4;
    const float* gwt = second ? p.in[20] : p.in[6];
    const float* mod = (const float*)(p.ws + O_MOD);
    f32x4 gv[4];
#pragma unroll
    for (int j = 0; j < 4; ++j) gv[j] = *((const f32x4*)gwt + 64 * j + lane);
    for (int t0 = gw * 2; t0 < T; t0 += NGW * 2) {
        f32x4 v[2][4]; float s[2];
#pragma unroll
        for (int u = 0; u < 2; ++u) {
            const int t = t0 + u;
            const float* xr = second ? p.out + (size_t)t * D : xrow_ptr(p, t);
            s[u] = 0.f;
#pragma unroll
            for (int j = 0; j < 4; ++j) { v[u][j] = *((const f32x4*)xr + 64 * j + lane); s[u] += (v[u][j].x * v[u][j].x + v[u][j].y * v[u][j].y) + (v[u][j].z * v[u][j].z + v[u][j].w * v[u][j].w); }
        }
        const int b = t0 >> 12;
        const float* sh = mod + (size_t)b * 6144 + (second ? 3072 : 0);
        const float* sc = sh + 1024;
#pragma unroll
        for (int u = 0; u < 2; ++u) {
            const int t = t0 + u;
            const float rstd = rsqrtf(wave_sum(s[u]) * (1.f / D) + EPS);
            u32x2* o = (u32x2*)(dst + (size_t)(second ? t + b + 1 : t) * D) + lane;
#pragma unroll
            for (int j = 0; j < 4; ++j) {
                const f32x4 scv = *((const f32x4*)sc + 64 * j + lane), shv = *((const f32x4*)sh + 64 * j + lane);
                f32x4 y;
                y.x = v[u][j].x * rstd * gv[j].x * (1.f + scv.x) + shv.x; y.y = v[u][j].y * rstd * gv[j].y * (1.f + scv.y) + shv.y;
                y.z = v[u][j].z * rstd * gv[j].z * (1.f + scv.z) + shv.z; y.w = v[u][j].w * rstd * gv[j].w * (1.f + scv.w) + shv.w;
                o[64 * j] = (u32x2){pk2(y.x, y.y), pk2(y.z, y.w)};
            }
        }
    }
    if (second) {
        constexpr int NZR = 25 + (H2P_ROWS - (NBATCH * SEQP + 1));
        for (int z = gw; z < NZR; z += NGW) {
            const int pr = z < 25 ? z * SEQP : NBATCH * SEQP + 1 + (z - 25);
            u32x2* o = (u32x2*)(dst + (size_t)pr * D) + lane;
#pragma unroll
            for (int j = 0; j < 4; ++j) o[64 * j] = (u32x2){0u, 0u};
        }
    }
}

DI void phase1(const Params& p, char* lds) {
    pg8::Gemm g{(const bf16_t*)(p.ws + O_H), (const bf16_t*)(p.ws + O_WIN), T, NIN, 1024};
    pg8::StaticOrder so; so.init(T, NIN, gridDim.x, blockIdx.x);
    EpiP1 E{(bf16_t*)(p.ws + O_ZS), (bf16_t*)((unsigned char*)p.out + OO_G)};
    pg8::gemm_phase<EpiP1, pg8::StaticOrder, false>((PG8_LAS unsigned char*)lds, g, so, E, nullptr);
}

template <int NCH>
DI float row_sumsq(const bf16_t* rowp, int g) {
    float s = 0.f;
#pragma unroll
    for (int c = 0; c < NCH; ++c) {
        const u32x4 v = *(const u32x4*)(rowp + (g * NCH + c) * 8);
#pragma unroll
        for (int e = 0; e < 4; ++e) { const float a = bflo(v[e]), b = bfhi(v[e]); s += a * a + b * b; }
    }
    return xor_reduce_g(s);
}

DI void phase2(const Params& p, char* lds) {
    const int tid_ = opaque_tid();
    unsigned char* ws = p.ws;
    const bf16_t* ZS = (const bf16_t*)(ws + O_ZS);
    const int tid = TID4, lane = tid & 63, wave = tid >> 6, r = lane & 15, g = lane >> 4;
    const float2* ropeA = (const float2*)(ws + O_ROPEA);
    const float2* ropeB = (const float2*)(ws + O_ROPEB);
    constexpr int NTL = T / 128;
    for (int it = VBID; it < NTL * 8; it += VGRID) {
        const int tile = it >> 3, sub = it & 7, t0 = tile * 128, b = t0 >> 12, s0 = t0 & (S - 1);
        {
            const int h = sub;
            f32x4 acc[2][6]; zero_acc(acc);
            gemm_mainloop<128, 96, 4, 1>(acc, ZS + (size_t)t0 * NZ + 768, NZ, (const bf16_t*)(ws + O_WUQ) + (size_t)h * 96 * 256, 256, 256, lds, tid);
            const float* gq = p.in[15];
            const float qs = 0.10206207261596577f * LOG2E;
            bf16_t* QB = (bf16_t*)(ws + O_QB) + ((size_t)(b * 8 + h) * S) * 96;
#pragma unroll
            for (int mt = 0; mt < 2; ++mt) {
                const int ml = wave * 32 + mt * 16 + r, sp = s0 + ml;
                const float rstd = rsqrtf(row_sumsq<8>(ZS + (size_t)(t0 + ml) * NZ + 768, g) * (1.f / 256.f) + EPS);
                float ss = 0.f;
#pragma unroll
                for (int nt = 0; nt < 6; ++nt) { acc[mt][nt] = acc[mt][nt] * rstd; const f32x4 a = acc[mt][nt]; ss += (a.x * a.x + a.y * a.y) + (a.z * a.z + a.w * a.w); }
                const float r2 = rsqrtf(xor_reduce_g(ss) * (1.f / 96.f) + EPS);
#pragma unroll
                for (int nt = 0; nt < 6; ++nt) {
                    const f32x4 gg = *(const f32x4*)(gq + nt * 16 + g * 4);
                    acc[mt][nt] = acc[mt][nt] * r2 * gg;
                }
#pragma unroll
                for (int j = 0; j < 4; ++j) {
                    const float2 cs = ropeB[sp * 16 + g * 4 + j];
                    const float x1 = acc[mt][4][j], x2 = acc[mt][5][j];
                    acc[mt][4][j] = x1 * cs.x - x2 * cs.y;
                    acc[mt][5][j] = x1 * cs.y + x2 * cs.x;
                }
                bf16_t* qrow = QB + (size_t)sp * 96 + g * 4;
#pragma unroll
                for (int nt = 0; nt < 6; ++nt) { const f32x4 a = acc[mt][nt] * qs; *(u32x2*)(qrow + nt * 16) = (u32x2){pk2(a.x, a.y), pk2(a.z, a.w)}; }
                __builtin_amdgcn_sched_barrier(0);
            }
        }
    }
    for (int it = VBID; it < NTL * 4; it += VGRID) {
        const int tile = it >> 2, hp = it & 3, t0 = tile * 128, b = t0 >> 12, s0 = t0 & (S - 1);
        {
            f32x4 acc[4][4]; zero_acc(acc);
            gemm_mainloop<128, 128, 2, 2>(acc, ZS + (size_t)t0 * NZ + 1024, NZ,
                                          (const bf16_t*)(ws + O_WUKV) + (size_t)(hp * 128) * 128, 128, 128, lds, tid);
            const int wm = wave >> 1, wn = wave & 1, h = hp * 2 + wn;
            {
                const float* gk = p.in[16];
                bf16_t* KB = (bf16_t*)(ws + O_KB) + ((size_t)(b * 8 + h) * S) * 96;
#pragma unroll
                for (int mt = 0; mt < 4; ++mt) {
                    const int ml = wm * 64 + mt * 16 + r, sp = s0 + ml;
                    const bf16_t* zrow = ZS + (size_t)(t0 + ml) * NZ;
                    const float rstd = rsqrtf(row_sumsq<4>(zrow + 1024, g) * (1.f / 128.f) + EPS);
                    const u32x2 k1 = *(const u32x2*)(zrow + 1152 + g * 4), k2 = *(const u32x2*)(zrow + 1168 + g * 4);
                    float x1[4] = {bflo(k1.x), bfhi(k1.x), bflo(k1.y), bfhi(k1.y)};
                    float x2[4] = {bflo(k2.x), bfhi(k2.x), bflo(k2.y), bfhi(k2.y)};
                    float ss = 0.f;
#pragma unroll
                    for (int j = 0; j < 4; ++j) ss += x1[j] * x1[j] + x2[j] * x2[j];
#pragma unroll
                    for (int nt = 0; nt < 4; ++nt) { acc[mt][nt] = acc[mt][nt] * rstd; const f32x4 a = acc[mt][nt]; ss += (a.x * a.x + a.y * a.y) + (a.z * a.z + a.w * a.w); }
                    const float r2 = rsqrtf(xor_reduce_g(ss) * (1.f / 96.f) + EPS);
                    bf16_t* krow = KB + (size_t)sp * 96 + g * 4;
#pragma unroll
                    for (int nt = 0; nt < 4; ++nt) {
                        const f32x4 gg = *(const f32x4*)(gk + nt * 16 + g * 4);
                        const f32x4 a = acc[mt][nt] * r2 * gg;
                        *(u32x2*)(krow + nt * 16) = (u32x2){pk2(a.x, a.y), pk2(a.z, a.w)};
                    }
                    const f32x4 g1 = *(const f32x4*)(gk + 64 + g * 4), g2 = *(const f32x4*)(gk + 80 + g * 4);
                    float o1[4], o2[4];
#pragma unroll
                    for (int j = 0; j < 4; ++j) {
                        const float2 cs = ropeB[sp * 16 + g * 4 + j];
                        const float y1 = x1[j] * r2 * g1[j], y2 = x2[j] * r2 * g2[j];
                        o1[j] = y1 * cs.x - y2 * cs.y; o2[j] = y1 * cs.y + y2 * cs.x;
                    }
                    *(u32x2*)(krow + 64) = (u32x2){pk2(o1[0], o1[1]), pk2(o1[2], o1[3])};
                    *(u32x2*)(krow + 80) = (u32x2){pk2(o2[0], o2[1]), pk2(o2[2], o2[3])};
                    __builtin_amdgcn_sched_barrier(0);
                }
            }
        }
    }
    for (int it = VBID; it < NTL * 4; it += VGRID) {
        const int tile = it >> 2, hp = it & 3, t0 = tile * 128, b = t0 >> 12, s0 = t0 & (S - 1);
        {
            f32x4 acc[4][4]; zero_acc(acc);
            gemm_mainloop<128, 128, 2, 2>(acc, ZS + (size_t)t0 * NZ + 1024, NZ,
                                          (const bf16_t*)(ws + O_WUKV) + (size_t)(512 + hp * 128) * 128, 128, 128, lds, tid);
            const int wm = wave >> 1, wn = wave & 1, h = hp * 2 + wn;
            {
                bf16_t* VT = (bf16_t*)(ws + O_VTB) + ((size_t)(b * 8 + h) * 64) * S;
#pragma unroll
                for (int mt = 0; mt < 4; ++mt) {
                    const int ml = wm * 64 + mt * 16 + r, sp = s0 + ml;
                    const float rstd = rsqrtf(row_sumsq<4>(ZS + (size_t)(t0 + ml) * NZ + 1024, g) * (1.f / 128.f) + EPS);
                    const int ps = perm32(sp);
#pragma unroll
                    for (int nt = 0; nt < 4; ++nt)
#pragma unroll
                        for (int j = 0; j < 4; ++j) VT[(size_t)(nt * 16 + g * 4 + j) * S + ps] = f2bf(acc[mt][nt][j] * rstd);
                    __builtin_amdgcn_sched_barrier(0);
                }
            }
        }
    }
    __syncthreads();
    for (int tile = VBID; tile < NTL * 2; tile += VGRID) {
        const int t0 = tile * 64, b = t0 >> 12, s0 = t0 & (S - 1);
        {
            const float* gqa = p.in[8];
            const float* gka = p.in[9];
            const int half = lane >> 5, i = lane & 31;
            const float qs = 0.125f * LOG2E;
            const float gq1 = gqa[i], gq2 = gqa[32 + i], gk1 = gka[i], gk2 = gka[32 + i];
            for (int tt0 = wave * 4; tt0 < 64; tt0 += 16) {
                float x1[4][5], x2[4][5]; float2 cs[4];
#pragma unroll
                for (int u = 0; u < 4; ++u) {
                    const bf16_t* zrow = ZS + (size_t)(t0 + tt0 + u) * NZ;
                    cs[u] = ropeA[(s0 + tt0 + u) * 32 + i];
#pragma unroll
                    for (int q = 0; q < 5; ++q) { const int hd = 2 * q + half; x1[u][q] = bf2f(zrow[hd * 64 + i]); x2[u][q] = bf2f(zrow[hd * 64 + 32 + i]); }
                }
#pragma unroll
                for (int u = 0; u < 4; ++u) {
                    const int sp = s0 + tt0 + u;
#pragma unroll
                    for (int q = 0; q < 5; ++q) {
                        const int hd = 2 * q + half;
                        float ss = x1[u][q] * x1[u][q] + x2[u][q] * x2[u][q];
#pragma unroll
                        for (int o = 1; o < 32; o <<= 1) ss += __shfl_xor(ss, o);
                        const float rr = rsqrtf(ss * (1.f / 64.f) + EPS);
                        const bool isq = q < 4;
                        const float y1 = x1[u][q] * rr * (isq ? gq1 : gk1), y2 = x2[u][q] * rr * (isq ? gq2 : gk2);
                        float o1 = y1 * cs[u].x - y2 * cs[u].y, o2 = y1 * cs[u].y + y2 * cs[u].x;
                        bf16_t* dst;
                        if (isq) { o1 *= qs; o2 *= qs; dst = (bf16_t*)(ws + O_QA) + ((size_t)(b * 8 + hd) * S + sp) * 64; }
                        else dst = (bf16_t*)(ws + O_KA) + ((size_t)(b * 2 + (hd - 8)) * S + sp) * 64;
                        dst[i] = f2bf(o1); dst[32 + i] = f2bf(o2);
                    }
                }
            }
            __syncthreads();
            bf16_t* tl = (bf16_t*)lds;
            for (int idx = tid; idx < 64 * 16; idx += 256) {
                const int tt = idx >> 4, c = idx & 15;
                const u32x4 v = *(const u32x4*)(ZS + (size_t)(t0 + tt) * NZ + 640 + c * 8);
                u32x2* d2 = (u32x2*)(tl + tt * 132 + c * 8);
                d2[0] = (u32x2){v.x, v.y}; d2[1] = (u32x2){v.z, v.w};
            }
            __syncthreads();
            bf16_t* VT = (bf16_t*)(ws + O_VTA) + ((size_t)(b * 2) * 64) * S;
            for (int idx = tid; idx < 64 * 128; idx += 256) {
                const int pp = idx & 63, dd = idx >> 6;
                const int lo = pp & 31;
                const int tt = (pp & ~31) | (((lo >> 2) & 1) << 4) | ((lo >> 3) << 2) | (lo & 3);
                VT[(size_t)dd * S + s0 + pp] = tl[tt * 132 + dd];
            }
            __syncthreads();
        }
    }
}

template <int DQK, bool WIN>
DI void attn_item(const bf16_t* __restrict__ Qw, const bf16_t* __restrict__ Kb, const bf16_t* __restrict__ Vt, int key0, int ntiles, int q0,
                  float shift2, float sink_term, bf16_t* __restrict__ Ow, int ldo, char* lds, const int tid) {
    constexpr int QT = 4, KS = DQK / 32, CH = DQK / 8, KROW = DQK * 2, KBYTES = 64 * KROW, NKI = KBYTES / 1024, STAGE = KBYTES + 8192;
    const int lane = tid & 63, r = lane & 15, g = lane >> 4, wave = __builtin_amdgcn_readfirstlane(tid >> 6);
    bf16x8 qf[QT][KS];
#pragma unroll
    for (int qt = 0; qt < QT; ++qt)
#pragma unroll
        for (int ks = 0; ks < KS; ++ks) qf[qt][ks] = *(const bf16x8*)(Qw + (size_t)(qt * 16 + r) * DQK + ks * 32 + g * 8);
    f32x4 oacc[4][QT], lacc[QT];
#pragma unroll
    for (int qt = 0; qt < QT; ++qt) {
        lacc[qt] = (f32x4){0.f, 0.f, 0.f, 0.f};
#pragma unroll
        for (int i = 0; i < 4; ++i) oacc[i][qt] = (f32x4){0.f, 0.f, 0.f, 0.f};
    }
    int ksrc[2];
#pragma unroll
    for (int i = 0; i < 2; ++i) {
        const int pch = (wave + 8 * i) * 64 + lane, row = pch / CH, c = pch % CH;
        const int sc = (DQK == 96) ? ((c & ~3) | ((c & 3) ^ ((0x78 >> (2 * ((row >> 2) & 3))) & 3))) : (c ^ ((row >> 1) & 7));
        ksrc[i] = row * DQK + sc * 8;
    }
    const int vrow = tid >> 3, vsrc = ((tid & 7) ^ ((vrow >> 1) & 7)) * 8;
    const bf16_t* Vp = Vt + (size_t)vrow * S + vsrc;
    auto issue = [&](int tile, int st) {
        const int kb = key0 + tile * 64;
        char* d = lds + st * STAGE + tid * 16;
        __builtin_amdgcn_global_load_lds((const GAS unsigned*)(Kb + (size_t)kb * DQK + ksrc[0]), (LAS unsigned*)(d), 16, 0, 0);
        if (NKI > 8 && wave < NKI - 8)
            __builtin_amdgcn_global_load_lds((const GAS unsigned*)(Kb + (size_t)kb * DQK + ksrc[1]), (LAS unsigned*)(d + 8192), 16, 0, 0);
        __builtin_amdgcn_global_load_lds((const GAS unsigned*)(Vp + kb), (LAS unsigned*)(d + KBYTES), 16, 0, 0);
    };
    const int ksw = (DQK == 96) ? ((0x78 >> (2 * ((r >> 2) & 3))) & 3) : ((r >> 1) & 7);
    const int vsw = (r >> 1) & 7;
    const bf16x8 ones = (bf16x8){0x3F80, 0x3F80, 0x3F80, 0x3F80, 0x3F80, 0x3F80, 0x3F80, 0x3F80};
    const f32x4 sinit = (f32x4){-shift2, -shift2, -shift2, -shift2};
    __syncthreads();
    issue(0, 0);
    __syncthreads();
    for (int tile = 0; tile < ntiles; ++tile) {
        const int cur = tile & 1;
        if (tile + 1 < ntiles) issue(tile + 1, cur ^ 1);
        const char* sK = lds + cur * STAGE; const char* sV = sK + KBYTES;
#pragma unroll
        for (int kk = 0; kk < 2; ++kk) {
            f32x4 sacc[2][QT];
#pragma unroll
            for (int a = 0; a < 2; ++a) {
#pragma unroll
                for (int qt = 0; qt < QT; ++qt) sacc[a][qt] = sinit;
#pragma unroll
                for (int ks = 0; ks < KS; ++ks) {
                    const int kch = (DQK == 96) ? (ks * 4 + (g ^ ksw)) : ((ks * 4 + g) ^ ksw);
                    const bf16x8 kf = *(const bf16x8*)(sK + ((2 * kk + a) * 16 + r) * KROW + kch * 16);
#pragma unroll
                    for (int qt = 0; qt < QT; ++qt) sacc[a][qt] = __builtin_amdgcn_mfma_f32_16x16x32_bf16(kf, qf[qt][ks], sacc[a][qt], 0, 0, 0);
                }
            }
            const int kbase = key0 + tile * 64 + kk * 32 + g * 4;
            bf16x8 pb[QT];
#pragma unroll
            for (int qt = 0; qt < QT; ++qt) {
#pragma unroll
                for (int a = 0; a < 2; ++a)
#pragma unroll
                    for (int j = 0; j < 4; ++j) {
                        float pv = fast_exp2(sacc[a][qt][j]);
                        if (WIN) { const int dlt = (kbase + a * 16 + j) - (q0 + qt * 16 + r); if (dlt > 128 || dlt < -128) pv = 0.f; }
                        sacc[a][qt][j] = pv;
                    }
                u32x4 u;
                u.x = pk2(sacc[0][qt][0], sacc[0][qt][1]); u.y = pk2(sacc[0][qt][2], sacc[0][qt][3]);
                u.z = pk2(sacc[1][qt][0], sacc[1][qt][1]); u.w = pk2(sacc[1][qt][2], sacc[1][qt][3]);
                pb[qt] = __builtin_bit_cast(bf16x8, u);
            }
#pragma unroll
            for (int dt = 0; dt < 4; ++dt) {
                const bf16x8 vf = *(const bf16x8*)(sV + (dt * 16 + r) * 128 + (((kk * 4 + g) ^ vsw) * 16));
#pragma unroll
                for (int qt = 0; qt < QT; ++qt) oacc[dt][qt] = __builtin_amdgcn_mfma_f32_16x16x32_bf16(vf, pb[qt], oacc[dt][qt], 0, 0, 0);
            }
#pragma unroll
            for (int qt = 0; qt < QT; ++qt) lacc[qt] = __builtin_amdgcn_mfma_f32_16x16x32_bf16(ones, pb[qt], lacc[qt], 0, 0, 0);
            __builtin_amdgcn_sched_barrier(0);
        }
        __syncthreads();
    }
#pragma unroll
    for (int qt = 0; qt < QT; ++qt) {
        const float inv = fast_rcp(lacc[qt][0] + sink_term);
        bf16_t* orow = Ow + (size_t)(qt * 16 + r) * ldo + g * 4;
#pragma unroll
        for (int dt = 0; dt < 4; ++dt) { const f32x4 a = oacc[dt][qt] * inv; *(u32x2*)(orow + dt * 16) = (u32x2){pk2(a.x, a.y), pk2(a.z, a.w)}; }
    }
}

DI float max_abs(const float* v, int n) { float m = 0.f; for (int i = 0; i < n; ++i) m = fmaxf(m, fabsf(v[i])); return m; }

DI void phase3(const Params& p, char* lds) {
    unsigned char* ws = p.ws;
    const int tid = opaque_tid(), wave = tid >> 6;
    const float shiftB = 9.797958971132712f * max_abs(p.in[15], 96) * max_abs(p.in[16], 96) * LOG2E;
    const float shiftA = 8.f * max_abs(p.in[8], 64) * max_abs(p.in[9], 64) * LOG2E;
    bf16_t* OA = (bf16_t*)(p.ws + O_OA);
    bf16_t* OB = (bf16_t*)(p.ws + O_OB);
    constexpr int NB_ITEMS = 24 * 8 * 8, NA_ITEMS = 24 * 2 * 32;
    for (int L = blockIdx.x; L < NB_ITEMS; L += gridDim.x) {
        const int idx = (L & 7) * (NB_ITEMS / 8) + (L >> 3);
        const int bh = idx >> 3, qb = idx & 7, b = bh >> 3, h = bh & 7;
        const int q0 = qb * 512 + wave * 64;
        attn_item<96, false>((const bf16_t*)(ws + O_QB) + ((size_t)bh * S + q0) * 96, (const bf16_t*)(ws + O_KB) + (size_t)bh * S * 96,
                             (const bf16_t*)(ws + O_VTB) + (size_t)bh * 64 * S, 0, S / 64, q0, shiftB, 0.f,
                             OB + ((size_t)b * S + q0) * 512 + h * 64, 512, lds, tid);
    }
    for (int L = blockIdx.x; L < NA_ITEMS; L += gridDim.x) {
        const int idx = (L & 7) * (NA_ITEMS / 8) + (L >> 3);
        const int bk = idx >> 5, qb = idx & 31, b = bk >> 1, kvh = bk & 1;
        const int q0 = qb * 128 + (wave >> 2) * 64, hd = kvh * 4 + (wave & 3);
        int ks = qb * 128 - 128; if (ks < 0) ks = 0; if (ks > S - 384) ks = S - 384;
        const float sink_term = fast_exp2(p.in[10][hd] * LOG2E - shiftA);
        attn_item<64, true>((const bf16_t*)(ws + O_QA) + ((size_t)(b * 8 + hd) * S + q0) * 64, (const bf16_t*)(ws + O_KA) + (size_t)bk * S * 64,
                            (const bf16_t*)(ws + O_VTA) + (size_t)bk * 64 * S, ks, 6, q0, shiftA, sink_term,
                            OA + ((size_t)b * S + q0) * 512 + hd * 64, 512, lds, tid);
    }
}

DI void phase4(const Params& p, char* lds) {
    const bf16_t* Gt = (const bf16_t*)((unsigned char*)p.out + OO_G);
    bf16_t* MIX = (bf16_t*)(p.ws + O_ZS);
    pg8::StaticOrder so; so.init(T, 1024, gridDim.x, blockIdx.x);
    {
        pg8::Gemm g{(const bf16_t*)(p.ws + O_OA), (const bf16_t*)(p.ws + O_WOA), T, 1024, 512};
        EpiMix<false> E{Gt, MIX};
        pg8::gemm_phase<EpiMix<false>, pg8::StaticOrder, false>((PG8_LAS unsigned char*)lds, g, so, E, nullptr);
    }
    {
        pg8::Gemm g{(const bf16_t*)(p.ws + O_OB), (const bf16_t*)(p.ws + O_WOB), T, 1024, 512};
        EpiMix<true> E{Gt, MIX};
        pg8::gemm_phase<EpiMix<true>, pg8::StaticOrder, false>((PG8_LAS unsigned char*)lds, g, so, E, nullptr);
    }
}

DI void phase5(const Params& p, char* lds) {
    pg8::Gemm g{(const bf16_t*)(p.ws + O_ZS), (const bf16_t*)(p.ws + O_WOUT), T, 1024, 1024};
    pg8::StaticOrder so; so.init(T, 1024, gridDim.x, blockIdx.x);
    EpiRes<false> E{p.in[0], p.in[1], p.out, (const float*)(p.ws + O_MOD) + 2048};
    pg8::gemm_phase<EpiRes<false>, pg8::StaticOrder, false>((PG8_LAS unsigned char*)lds, g, so, E, nullptr);
}

struct OneUnit {
    pg8::Unit u;
    DI bool next(int i, pg8::Unit& o) const { if (i) return false; o = u; return true; }
    DI void a_ready(const pg8::Unit&) const {}
    DI void done(const pg8::Unit&) const {}
};
struct EpiConv {
    static constexpr bool PERM = true, AFTER_DRAIN = true;
    bf16_t* ACT; const float* cw; const float* cb;
    DI void operator()(const f32x4 (&)[2][2][4][2], const pg8::Unit&, int, int, int, int) const {}
    DI void fused(const f32x4 (&acc)[2][2][4][2], const pg8::Unit& u, int wr, int wc, int fr, int fq, PG8_LAS unsigned char* lds, int wid, int lane) const {
#pragma unroll
        for (int ai = 0; ai < 2; ++ai)
#pragma unroll
            for (int m = 0; m < 4; ++m) {
                const int row = ai * 128 + wr * 64 + m * 16 + fr;
#pragma unroll
                for (int bj = 0; bj < 2; ++bj) {
                    const int ch = bj * 16 + wc * 4 + fq;
                    const f32x4 v0 = acc[ai][bj][m][0], v1 = acc[ai][bj][m][1];
                    u32x4 w; w.x = pk2(v0.x, v0.y); w.y = pk2(v0.z, v0.w); w.z = pk2(v1.x, v1.y); w.w = pk2(v1.z, v1.w);
                    *(PG8_LAS u32x4*)(lds + row * 512 + ((ch ^ (row & 31)) * 16)) = w;
                }
            }
        __syncthreads();
        {
            const int tid = wid * 64 + lane, cc = tid & 15, rr = tid >> 4;
            const int ca = u.pn * 128 + cc * 8, cg = DFF + ca;
            float wa[3][8], wg[3][8], ba[8], bg[8];
#pragma unroll
            for (int q = 0; q < 2; ++q) {
#pragma unroll
                for (int t = 0; t < 3; ++t) {
                    const f32x4 x = *(const f32x4*)(cw + t * NUP + ca + 4 * q), y = *(const f32x4*)(cw + t * NUP + cg + 4 * q);
#pragma unroll
                    for (int e = 0; e < 4; ++e) { wa[t][4 * q + e] = x[e]; wg[t][4 * q + e] = y[e]; }
                }
                const f32x4 x = *(const f32x4*)(cb + ca + 4 * q), y = *(const f32x4*)(cb + cg + 4 * q);
#pragma unroll
                for (int e = 0; e < 4; ++e) { ba[4 * q + e] = x[e]; bg[4 * q + e] = y[e]; }
            }
#pragma unroll 2
            for (int q = 0; q < 8; ++q) {
                const int e1 = rr + 32 * q;
                const int pr1 = u.pm * 254 + e1 - 1;
                const int b = pr1 / SEQP, s = pr1 - b * SEQP;
                if (e1 >= 1 && e1 <= 254 && s < S && b < NBATCH) {
                    float a0[8], a1[8], a2[8], g0[8], g1[8], g2[8];
                    const int r0 = e1 - 1, r1 = e1, r2 = e1 + 1;
                    unpack8(*(const PG8_LAS u32x4*)(lds + r0 * 512 + ((cc ^ (r0 & 31)) * 16)), a0);
                    unpack8(*(const PG8_LAS u32x4*)(lds + r1 * 512 + ((cc ^ (r1 & 31)) * 16)), a1);
                    unpack8(*(const PG8_LAS u32x4*)(lds + r2 * 512 + ((cc ^ (r2 & 31)) * 16)), a2);
                    unpack8(*(const PG8_LAS u32x4*)(lds + r0 * 512 + (((16 + cc) ^ (r0 & 31)) * 16)), g0);
                    unpack8(*(const PG8_LAS u32x4*)(lds + r1 * 512 + (((16 + cc) ^ (r1 & 31)) * 16)), g1);
                    unpack8(*(const PG8_LAS u32x4*)(lds + r2 * 512 + (((16 + cc) ^ (r2 & 31)) * 16)), g2);
                    float av[8];
#pragma unroll
                    for (int e = 0; e < 8; ++e) {
                        const float ua = ba[e] + wa[0][e] * a0[e] + wa[1][e] * a1[e] + wa[2][e] * a2[e];
                        const float ug = bg[e] + wg[0][e] * g0[e] + wg[1][e] * g1[e] + wg[2][e] * g2[e];
                        av[e] = ug * sigmoidf_(ug) * ua;
                    }
                    u32x4 ov; ov.x = pk2(av[0], av[1]); ov.y = pk2(av[2], av[3]); ov.z = pk2(av[4], av[5]); ov.w = pk2(av[6], av[7]);
                    *(u32x4*)(ACT + ((size_t)b * S + s) * DFF + ca) = ov;
                }
            }
        }
        __syncthreads();
    }
};

DI void phase7(const Params& p, char* lds) {
    pg8::Gemm g{(const bf16_t*)(p.ws + O_H2P), (const bf16_t*)(p.ws + O_WUP), 388 * 256, NUP, 1024, 254};
    pg8::StaticOrder so; so.init(388 * 256, NUP, gridDim.x, blockIdx.x);
    EpiConv E{(bf16_t*)(p.ws + O_ACT), p.in[22], p.in[23]};
    for (int i = 0;; ++i) {
        OneUnit one;
        if (!so.next(i, one.u)) break;
        pg8::gemm_phase<EpiConv, OneUnit, false>((PG8_LAS unsigned char*)lds, g, one, E, nullptr);
    }
}

DI void phase8(const Params& p, char* lds) {
    pg8::Gemm g{(const bf16_t*)(p.ws + O_ACT), (const bf16_t*)(p.ws + O_WDN), T, 1024, DFF};
    pg8::StaticOrder so; so.init(T, 1024, gridDim.x, blockIdx.x);
    EpiRes<true> E{p.in[0], p.in[1], p.out, (const float*)(p.ws + O_MOD) + 5120};
    pg8::gemm_phase<EpiRes<true>, pg8::StaticOrder, false>((PG8_LAS unsigned char*)lds, g, so, E, nullptr);
}

__global__ void __launch_bounds__(512) fwd_megakernel(Params p) {
    __shared__ __attribute__((aligned(16))) char lds[131072];
    cg::grid_group grid = cg::this_grid();
    char* lds4 = lds + __builtin_amdgcn_readfirstlane((int)(threadIdx.x >> 8)) * 65536;
    phase0(p, lds4);
    grid.sync();
    phase0m(p);
    grid.sync();
    norm_pass(p, false, (bf16_t*)(p.ws + O_H));
    grid.sync();
    phase1(p, lds);
    grid.sync();
    phase2(p, lds4);
    grid.sync();
    phase3(p, lds);
    grid.sync();
    phase4(p, lds);
    grid.sync();
    phase5(p, lds);
    grid.sync();
    norm_pass(p, true, (bf16_t*)(p.ws + O_H2P));
    grid.sync();
    phase7(p, lds);
    grid.sync();
    phase8(p, lds);
}

extern "C" void kernel_launch(void* const* d_in, const int* in_sizes, int n_in, void* d_out, int out_size, void* d_ws, size_t ws_size,
                              hipStream_t stream) {
    static int grid_blocks = 0;
    if (!grid_blocks) {
        int dev = 0, cus = 0, per_cu = 0;
        hipGetDevice(&dev);
        hipDeviceGetAttribute(&cus, hipDeviceAttributeMultiprocessorCount, dev);
        hipOccupancyMaxActiveBlocksPerMultiprocessor(&per_cu, fwd_megakernel, 512, 0);
        if (per_cu < 1) per_cu = 1;
        if (per_cu > 1) per_cu = 1;
        grid_blocks = cus * per_cu;
        if (n_in != 25 || ws_size < WS_NEED || out_size != T * D)
            fprintf(stderr, "kernel_launch: unexpected sizes n_in=%d ws=%zu out=%d\n", n_in, ws_size, out_size);
    }
    Params p{};
    for (int i = 0; i < 25; ++i) p.in[i] = (const float*)d_in[i];
    p.out = (float*)d_out;
    p.ws = (unsigned char*)d_ws;
    void* args[] = {&p};
    hipError_t e = hipLaunchCooperativeKernel((void*)fwd_megakernel, dim3(grid_blocks), dim3(512), args, 0, stream);
    if (e != hipSuccess) fprintf(stderr, "cooperative launch failed: %s (grid %d)\n", hipGetErrorString(e), grid_blocks);
}
```

```cpp
#include <hip/hip_runtime.h>
#include <hip/hip_cooperative_groups.h>
#include <cstdio>
#include <cstdint>
namespace cg = cooperative_groups;
#ifndef PM
#define PM 4095
#endif
#ifndef DUP
#define DUP 0
#define XSYNC 0
#endif

typedef unsigned short bf16_t;
typedef short bf16x8 __attribute__((ext_vector_type(8)));
typedef float f32x4 __attribute__((ext_vector_type(4)));
typedef unsigned u32x4 __attribute__((ext_vector_type(4)));
typedef unsigned u32x2 __attribute__((ext_vector_type(2)));
#define DI __device__ __forceinline__
__device__ __forceinline__ int opaque_tid() { int t = threadIdx.x; asm volatile("" : "+v"(t)); return t; }
#define TID4 (tid_ & 255)
#define VBID ((int)(blockIdx.x * 2 + (tid_ >> 8)))
#define VGRID ((int)(gridDim.x * 2))

constexpr int D = 1024, S = 4096, NBATCH = 24, T = NBATCH * S;
constexpr int T_PROMPT = 8 * S;
constexpr int IN_TOTAL = 3232, NZ = 1280  , NIN = NZ + 2048;
constexpr int DFF = 2816, NUP = 2 * DFF;
constexpr float EPS = 1e-6f;
constexpr float LOG2E = 1.4426950408889634f;
constexpr int NCHUNK = 4, TCH = T / NCHUNK;

constexpr size_t MiB = 1024ull * 1024ull;
constexpr size_t O_WIN = 0;
constexpr size_t O_WUQ = O_WIN + (size_t)NIN * 1024 * 2;
constexpr size_t O_WUKV = O_WUQ + 768ull * 256 * 2;
constexpr size_t O_WOA = O_WUKV + 1024ull * 128 * 2;
constexpr size_t O_WOB = O_WOA + 1024ull * 512 * 2;
constexpr size_t O_WOUT = O_WOB + 1024ull * 512 * 2;
constexpr size_t O_WUP = O_WOUT + 1024ull * 1024 * 2;
constexpr size_t O_WDN = O_WUP + (size_t)NUP * 1024 * 2;
constexpr size_t O_MODP = O_WDN + 1024ull * DFF * 2;
constexpr size_t O_MOD = O_MODP + 16ull * 24 * 6144 * 4;
constexpr size_t O_ROPEA = O_MOD + 24ull * 6144 * 4;
constexpr size_t O_ROPEB = O_ROPEA + 4096ull * 32 * 8;
constexpr size_t O_ZROW = O_ROPEB + 4096ull * 16 * 8;
constexpr size_t O_WB_END = O_ZROW + 4096;
static_assert(O_WB_END <= 48 * MiB, "weights region");
constexpr size_t O_ZS = 48 * MiB;
constexpr size_t O_QA = 288 * MiB;
constexpr size_t O_KA = O_QA + 96 * MiB;
constexpr size_t O_VTA = O_KA + 24 * MiB;
constexpr size_t O_QB = O_VTA + 24 * MiB;
constexpr size_t O_KB = O_QB + 144 * MiB;
constexpr size_t O_VTB = O_KB + 144 * MiB;
constexpr size_t O_H = 816 * MiB;
constexpr size_t O_UP = 288 * MiB;
constexpr int SEQP = S + 1, H2P_ROWS = 388 * 254 + 2;
constexpr size_t O_H2P = 48 * MiB;
constexpr size_t O_ACT = 288 * MiB;
constexpr size_t WS_NEED = 1008 * MiB;
static_assert(O_VTB + 96 * MiB <= O_H, "qkv region");
constexpr size_t OO_G = 0, O_OA = O_H, O_OB = O_H + 96 * MiB;

struct Params {
    const float* in[25];
    float* out;
    unsigned char* ws;
};

typedef __bf16 bf16x2_t __attribute__((ext_vector_type(2)));
typedef float f32x2_t __attribute__((ext_vector_type(2)));
DI unsigned pk2(float lo, float hi) { const f32x2_t v = {lo, hi}; return __builtin_bit_cast(unsigned, __builtin_convertvector(v, bf16x2_t)); }
DI float bflo(unsigned u) { return __uint_as_float(u << 16); }
DI float bfhi(unsigned u) { return __uint_as_float(u & 0xffff0000u); }
DI float bf2f(bf16_t v) { return __uint_as_float(((unsigned)v) << 16); }
DI bf16_t f2bf(float v) { return (bf16_t)(pk2(v, v) & 0xffffu); }
DI void unpack8(const u32x4 v, float (&f)[8]) {
    f[0] = bflo(v.x); f[1] = bfhi(v.x); f[2] = bflo(v.y); f[3] = bfhi(v.y); f[4] = bflo(v.z); f[5] = bfhi(v.z); f[6] = bflo(v.w); f[7] = bfhi(v.w);
}
DI float fast_rcp(float x) { return __builtin_amdgcn_rcpf(x); }
DI float fast_exp2(float x) { return __builtin_amdgcn_exp2f(x); }
DI float sigmoidf_(float v) { return fast_rcp(1.f + fast_exp2(-v * LOG2E)); }
DI float xor_reduce_g(float v) { v += __shfl_xor(v, 16); v += __shfl_xor(v, 32); return v; }
DI float wave_sum(float v) {
#pragma unroll
    for (int o = 1; o < 64; o <<= 1) v += __shfl_xor(v, o);
    return v;
}
DI int perm32(int s) { const int lo = s & 31; return (s & ~31) | (((lo >> 2) & 3) << 3) | ((lo >> 4) << 2) | (lo & 3); }
DI const float* xrow_ptr(const Params& p, int t) { return t < T_PROMPT ? p.in[0] + (size_t)t * D : p.in[1] + (size_t)(t - T_PROMPT) * D; }

DI void tile_map(int L, int nN, int ntiles, int& pm, int& pn) {
    const int xcd = L & 7, q = L >> 3;
    const int Lp = xcd * (ntiles >> 3) + q;
    const int grp = Lp / (8 * nN), rem = Lp % (8 * nN);
    pm = grp * 8 + (rem & 7); pn = rem >> 3;
}

#define LAS __attribute__((address_space(3)))
#define GAS __attribute__((address_space(1)))
template <int BM, int BN, int NWM, int NWN>
DI void gemm_mainloop_p(f32x4 (&acc)[BM / NWM / 16][BN / NWN / 16], const bf16_t* const (&Ar)[BM / (NWM * NWN * 8)],
                        const bf16_t* __restrict__ B, int ldb, int K, char* lds, const int tid) {
    constexpr int RPR = NWM * NWN * 8;
    constexpr int MT = BM / NWM / 16, NT = BN / NWN / 16, NA = BM / RPR, NB = BN / RPR, STAGE = (BM + BN) * 128, RB = RPR * 128;
    const int lane = tid & 63, wave = tid >> 6;
    const int wm = wave / NWN, wn = wave % NWN;
    const int r = lane & 15, g = lane >> 4;
    const int lr = tid >> 3, lc = tid & 7;
    const int csrc = (lc ^ ((lr >> 1) & 7)) * 8;
    const bf16_t* Bp = B + (size_t)lr * ldb + csrc;
    const int nk = K >> 6;
    auto issue = [&](int kt, int st) {
        char* d = lds + st * STAGE + tid * 16;
#pragma unroll
        for (int i = 0; i < NA; ++i)
            __builtin_amdgcn_global_load_lds((const GAS unsigned*)(Ar[i] + kt * 64), (LAS unsigned*)(d + i * RB), 16, 0, 0);
#pragma unroll
        for (int i = 0; i < NB; ++i)
            __builtin_amdgcn_global_load_lds((const GAS unsigned*)(Bp + (size_t)(RPR * i) * ldb + kt * 64), (LAS unsigned*)(d + BM * 128 + i * RB), 16, 0, 0);
    };
    issue(0, 0);
    __syncthreads();
    const int rsw = (r >> 1) & 7;
    for (int kt = 0; kt < nk; ++kt) {
        const int cur = kt & 1;
        if (kt + 1 < nk) issue(kt + 1, cur ^ 1);
        const char* sA = lds + cur * STAGE;
        const char* sB = sA + BM * 128;
#pragma unroll
        for (int ks = 0; ks < 2; ++ks) {
            bf16x8 wf[NT], xf[MT];
            const int co = ((ks * 4 + g) ^ rsw) * 16;
#pragma unroll
            for (int nt = 0; nt < NT; ++nt) wf[nt] = *(const bf16x8*)(sB + (wn * (NT * 16) + nt * 16 + r) * 128 + co);
#pragma unroll
            for (int mt = 0; mt < MT; ++mt) xf[mt] = *(const bf16x8*)(sA + (wm * (MT * 16) + mt * 16 + r) * 128 + co);
#pragma unroll
            for (int mt = 0; mt < MT; ++mt)
#pragma unroll
                for (int nt = 0; nt < NT; ++nt) acc[mt][nt] = __builtin_amdgcn_mfma_f32_16x16x32_bf16(wf[nt], xf[mt], acc[mt][nt], 0, 0, 0);
        }
        __syncthreads();
    }
}

template <int BM, int BN, int NWM, int NWN>
DI void gemm_mainloop(f32x4 (&acc)[BM / NWM / 16][BN / NWN / 16], const bf16_t* __restrict__ A, int lda,
                      const bf16_t* __restrict__ B, int ldb, int K, char* lds, const int tid) {
    constexpr int RPR = NWM * NWN * 8;
    const int lr = tid >> 3, lc = tid & 7;
    const bf16_t* Ar[BM / RPR];
#pragma unroll
    for (int i = 0; i < BM / RPR; ++i) Ar[i] = A + (size_t)(lr + RPR * i) * lda + (lc ^ ((lr >> 1) & 7)) * 8;
    gemm_mainloop_p<BM, BN, NWM, NWN>(acc, Ar, B, ldb, K, lds, tid);
}

template <int MT, int NT>
DI void zero_acc(f32x4 (&acc)[MT][NT]) {
#pragma unroll
    for (int i = 0; i < MT; ++i)
#pragma unroll
        for (int j = 0; j < NT; ++j) acc[i][j] = (f32x4){0.f, 0.f, 0.f, 0.f};
}

namespace pg8 {
#define PG8_LAS __attribute__((address_space(3)))
constexpr int BM = 256, BK = 64, HALF = 128, HTB = HALF * BK * 2, STAGE_BYTES = 8 * HTB, NXCD = 8, WGM = 8;
__host__ __device__ __forceinline__ int lds_byte(int r, int c) { const int st = (r >> 4) * 2 + (c >> 5), rr = r & 15, cc = c & 31, ob = rr * 64 + cc * 2; return st * 1024 + (ob ^ (((ob >> 9) & 1) << 5)); }
__host__ __device__ __forceinline__ void stage_rc(int b, int& R, int& C) { const int st = b / 1024, sb = b % 1024, swz = sb ^ (((sb >> 9) & 1) << 5); R = (st >> 1) * 16 + swz / 64; C = (st & 1) * 32 + (swz % 64) / 2; }
__host__ __device__ __forceinline__ int perm32(int rho) { const int n = rho >> 4, i = rho & 15; return 8 * (i >> 2) + 4 * n + (i & 3); }
struct Unit { int pm, pn; };
struct Gemm { const bf16_t* A; const bf16_t* Bt; int M, N, K; int a_rows = 256; int lda = 0; };
struct StaticOrder {
    int nM, nN, nwg, G, c;
    __host__ __device__ void init(int M, int N, int G_, int c_) { nM = M / BM; nN = N / BM; nwg = nM * nN; G = G_; c = c_; }
    __host__ __device__ bool next(int i, Unit& u) const {
        const long L = (long)i * G + c; if (L >= nwg) return false;
        int wgid = (int)L; { const int q = nwg / NXCD, r = nwg % NXCD, xcd = wgid % NXCD, off = wgid / NXCD; wgid = (xcd < r ? xcd * (q + 1) : r * (q + 1) + (xcd - r) * q) + off; }
        const int nig = WGM * nN, gid = wgid / nig, fm = gid * WGM, gsz = (nM - fm) < WGM ? (nM - fm) : WGM;
        u.pm = fm + ((wgid % nig) % gsz); u.pn = (wgid % nig) / gsz; return true;
    }
    __device__ __forceinline__ void a_ready(const Unit&) const {}
    __device__ __forceinline__ void done(const Unit&) const {}
};
template <class Epi, class Sched, bool STAMP = false>
__device__ __forceinline__ void gemm_phase(PG8_LAS unsigned char* lds, const Gemm g, const Sched& S, const Epi& E, unsigned long long* stamps) {
    const int tid = opaque_tid(), wid = __builtin_amdgcn_readfirstlane(tid >> 6), lane = tid & 63, wr = wid >> 2, wc = wid & 3, fr = lane & 15, fq = lane >> 4;
    const int K = g.K, nt = K / BK, LDA = g.lda ? g.lda : g.K;
    int ts_lo = 0, ts_hi = 0, nts = 0; const unsigned long long rt_entry = STAMP ? (unsigned long long)wall_clock64() : 0ull;
#define PG8_STAMP() do { if (STAMP && wid == 0 && nts < 64) { const unsigned long long _c = (unsigned long long)clock64(); \
        ts_lo = (lane == nts) ? (int)(unsigned)_c : ts_lo; ts_hi = (lane == nts) ? (int)(unsigned)(_c >> 32) : ts_hi; ++nts; } } while (0)
    PG8_STAMP();
    unsigned voffA[2], voffB[2];
#pragma unroll
    for (int i = 0; i < 2; ++i) { int R, C; stage_rc(tid * 16 + i * 8192, R, C); const int Rb = Epi::PERM ? ((R & ~31) + perm32(R & 31)) : R;
        voffA[i] = (unsigned)(R * LDA + C) * 2u; voffB[i] = (unsigned)(Rb * K + C) * 2u; }
    const size_t kstep = (size_t)(BK * 2);
    const size_t hstep = (size_t)HALF * K * 2;
    const size_t hstepA = (size_t)HALF * LDA * 2;
    const size_t tstep = 2 * hstep;
    const size_t tstepA = (size_t)g.a_rows * LDA * 2;
    const unsigned ldsw = (unsigned)wid * 1024u;
    const int aoff = lds_byte(wr * 64 + fr, fq * 8), boff = lds_byte(wc * 32 + fr, fq * 8);
#define PG8_SA(b, h) (((b) * 2 + (h)) * HTB)
#define PG8_SB(b, h) ((4 + (b) * 2 + (h)) * HTB)
#define PG8_STAGE(bufoff, gbase, voff) do { _Pragma("unroll") for (int _i = 0; _i < 2; ++_i) \
        __builtin_amdgcn_global_load_lds((const unsigned*)((const char*)(gbase) + (voff)[_i]), (PG8_LAS unsigned*)(lds + (bufoff) + ldsw + _i * 8192), 16, 0, 0); } while (0)
#define PG8_LDA(dst, b, h) do { _Pragma("unroll") for (int m = 0; m < 4; ++m) _Pragma("unroll") for (int k = 0; k < 2; ++k) dst[m][k] = *(const PG8_LAS bf16x8*)(lds + PG8_SA(b, h) + aoff + m * 2048 + k * 1024); } while (0)
#define PG8_LDB(dst, b, h) do { _Pragma("unroll") for (int n = 0; n < 2; ++n) _Pragma("unroll") for (int k = 0; k < 2; ++k) dst[n][k] = *(const PG8_LAS bf16x8*)(lds + PG8_SB(b, h) + boff + n * 2048 + k * 1024); } while (0)
#define PG8_MMA(ai, bj, At, Bt) do { __builtin_amdgcn_s_setprio(1); _Pragma("unroll") for (int m = 0; m < 4; ++m) _Pragma("unroll") for (int n = 0; n < 2; ++n) _Pragma("unroll") for (int k = 0; k < 2; ++k) \
        acc[ai][bj][m][n] = __builtin_amdgcn_mfma_f32_16x16x32_bf16(Bt[n][k], At[m][k], acc[ai][bj][m][n], 0, 0, 0); __builtin_amdgcn_s_setprio(0); } while (0)
#define PG8_WAIT_V(n) asm volatile("s_waitcnt vmcnt(" #n ")" ::: "memory")
#define PG8_WAIT_L(n) asm volatile("s_waitcnt lgkmcnt(" #n ")" ::: "memory")
#define PG8_BAR __builtin_amdgcn_s_barrier()
#define PG8_SCHED __builtin_amdgcn_sched_barrier(0)
    Unit cur, nxt; int ui = 0;
    if (!S.next(0, cur)) return;
    f32x4 acc[2][2][4][2];
#pragma unroll
    for (int a = 0; a < 2; ++a)
#pragma unroll
        for (int b = 0; b < 2; ++b)
#pragma unroll
            for (int m = 0; m < 4; ++m)
#pragma unroll
                for (int n = 0; n < 2; ++n) acc[a][b][m][n] = (f32x4){0.f, 0.f, 0.f, 0.f};
    bf16x8 At[4][2], B0[2][2], B1[2][2];
    const char* cA = (const char*)g.A + (size_t)cur.pm * tstepA; const char* cB = (const char*)g.Bt + (size_t)cur.pn * tstep;
    S.a_ready(cur);
    PG8_STAGE(PG8_SB(0, 0), cB, voffB); PG8_STAGE(PG8_SA(0, 0), cA, voffA); PG8_STAGE(PG8_SB(0, 1), cB + hstep, voffB); PG8_STAGE(PG8_SA(0, 1), cA + hstepA, voffA);
    if (wr == 1) PG8_BAR;
    PG8_WAIT_V(4); PG8_BAR;
    PG8_STAGE(PG8_SB(1, 0), cB + kstep, voffB); PG8_STAGE(PG8_SA(1, 0), cA + kstep, voffA); PG8_STAGE(PG8_SB(1, 1), cB + hstep + kstep, voffB);
    PG8_WAIT_V(6); PG8_BAR;
    PG8_STAMP();
    for (;;) {
        const bool has_next = S.next(ui + 1, nxt);
        const char* nA = has_next ? (const char*)g.A + (size_t)nxt.pm * tstepA : cA; const char* nB = has_next ? (const char*)g.Bt + (size_t)nxt.pn * tstep : cB;
        for (int t = 0; t < nt; t += 2) {
            const bool last = (t == nt - 2);
            const char* a1 = cA + (size_t)(t + 1) * kstep;
            const char* a2 = last ? nA : cA + (size_t)(t + 2) * kstep; const char* b2 = last ? nB : cB + (size_t)(t + 2) * kstep;
            const char* a3 = a2 + kstep; const char* b3 = b2 + kstep;
            if (last && has_next) S.a_ready(nxt);
            PG8_LDB(B0, 0, 0); PG8_SCHED; PG8_LDA(At, 0, 0); PG8_STAGE(PG8_SA(1, 1), a1 + hstepA, voffA);
            PG8_WAIT_L(8); PG8_BAR; PG8_WAIT_L(0); PG8_MMA(0, 0, At, B0); PG8_BAR; PG8_SCHED;
            PG8_LDB(B1, 0, 1); PG8_STAGE(PG8_SB(0, 0), b2, voffB);
            PG8_BAR; PG8_WAIT_L(0); PG8_MMA(0, 1, At, B1); PG8_BAR;
            PG8_LDA(At, 0, 1); PG8_STAGE(PG8_SA(0, 0), a2, voffA);
            PG8_BAR; PG8_WAIT_L(0); PG8_MMA(1, 0, At, B0); PG8_BAR; PG8_SCHED;
            PG8_STAGE(PG8_SB(0, 1), b2 + hstep, voffB);
            PG8_WAIT_V(6); PG8_BAR; PG8_MMA(1, 1, At, B1); PG8_BAR;
            PG8_LDB(B0, 1, 0); PG8_SCHED; PG8_LDA(At, 1, 0); PG8_STAGE(PG8_SA(0, 1), a2 + hstepA, voffA);
            PG8_WAIT_L(8); PG8_BAR; PG8_WAIT_L(0); PG8_MMA(0, 0, At, B0); PG8_BAR; PG8_SCHED;
            PG8_LDB(B1, 1, 1); PG8_STAGE(PG8_SB(1, 0), b3, voffB);
            PG8_BAR; PG8_WAIT_L(0); PG8_MMA(0, 1, At, B1); PG8_BAR;
            PG8_LDA(At, 1, 1); PG8_STAGE(PG8_SA(1, 0), a3, voffA);
            PG8_BAR; PG8_WAIT_L(0); PG8_MMA(1, 0, At, B0); PG8_BAR; PG8_SCHED;
            PG8_STAGE(PG8_SB(1, 1), b3 + hstep, voffB);
            PG8_WAIT_V(6); PG8_BAR; PG8_MMA(1, 1, At, B1); PG8_BAR;
        }
        PG8_STAMP();
        if constexpr (!Epi::AFTER_DRAIN) { E(acc, cur, wr, wc, fr, fq); S.done(cur); }
        PG8_STAMP();
        if (!has_next) break;
#pragma unroll
        for (int a = 0; a < 2; ++a)
#pragma unroll
            for (int b = 0; b < 2; ++b)
#pragma unroll
                for (int m = 0; m < 4; ++m)
#pragma unroll
                    for (int n = 0; n < 2; ++n) acc[a][b][m][n] = (f32x4){0.f, 0.f, 0.f, 0.f};
        cur = nxt; cA = nA; cB = nB; ++ui;
    }
    PG8_WAIT_V(0);
    if (wr == 0) PG8_BAR;
    PG8_BAR;
    if constexpr (Epi::AFTER_DRAIN) { E.fused(acc, cur, wr, wc, fr, fq, lds, wid, lane); S.done(cur); }
    PG8_STAMP();
    if (STAMP && wid == 0) { stamps[lane] = lane < nts ? (((unsigned long long)(unsigned)ts_hi << 32) | (unsigned)ts_lo) : 0ull;
        if (lane == 62) stamps[62] = rt_entry; if (lane == 63) stamps[63] = (unsigned long long)wall_clock64(); }
#undef PG8_STAMP
#undef PG8_SA
#undef PG8_SB
#undef PG8_STAGE
#undef PG8_LDA
#undef PG8_LDB
#undef PG8_MMA
#undef PG8_WAIT_V
#undef PG8_WAIT_L
#undef PG8_BAR
#undef PG8_SCHED
}
}


struct EpiP1 {
    static constexpr bool PERM = true, AFTER_DRAIN = false;
    bf16_t* ZS; bf16_t* G;
    DI void operator()(const f32x4 (&acc)[2][2][4][2], const pg8::Unit& u, int wr, int wc, int fr, int fq) const {
        const int row0 = u.pm * 256 + wr * 64 + fr, colt = u.pn * 256 + wc * 32 + 8 * fq;
        const bool small = u.pn < NZ / 256;
#pragma unroll
        for (int ai = 0; ai < 2; ++ai)
#pragma unroll
            for (int m = 0; m < 4; ++m) {
                const size_t row = (size_t)(row0 + ai * 128 + m * 16);
#pragma unroll
                for (int bj = 0; bj < 2; ++bj) {
                    const int col = colt + bj * 128;
                    const f32x4 v0 = acc[ai][bj][m][0], v1 = acc[ai][bj][m][1];
                    u32x4 w;
                    if (small) { w.x = pk2(v0.x, v0.y); w.y = pk2(v0.z, v0.w); w.z = pk2(v1.x, v1.y); w.w = pk2(v1.z, v1.w); *(u32x4*)(ZS + row * NZ + col) = w; }
                    else { w.x = pk2(sigmoidf_(v0.x), sigmoidf_(v0.y)); w.y = pk2(sigmoidf_(v0.z), sigmoidf_(v0.w)); w.z = pk2(sigmoidf_(v1.x), sigmoidf_(v1.y)); w.w = pk2(sigmoidf_(v1.z), sigmoidf_(v1.w));
                           *(u32x4*)(G + row * 2048 + (col - NZ)) = w; }
                }
            }
    }
};
struct EpiRaw {
    static constexpr bool PERM = true, AFTER_DRAIN = false;
    bf16_t* O; int ldc;
    DI void operator()(const f32x4 (&acc)[2][2][4][2], const pg8::Unit& u, int wr, int wc, int fr, int fq) const {
        const int row0 = u.pm * 256 + wr * 64 + fr, colt = u.pn * 256 + wc * 32 + 8 * fq;
#pragma unroll
        for (int ai = 0; ai < 2; ++ai)
#pragma unroll
            for (int m = 0; m < 4; ++m) {
                const size_t row = (size_t)(row0 + ai * 128 + m * 16);
#pragma unroll
                for (int bj = 0; bj < 2; ++bj) {
                    const f32x4 v0 = acc[ai][bj][m][0], v1 = acc[ai][bj][m][1];
                    u32x4 w; w.x = pk2(v0.x, v0.y); w.y = pk2(v0.z, v0.w); w.z = pk2(v1.x, v1.y); w.w = pk2(v1.z, v1.w);
                    *(u32x4*)(O + row * ldc + colt + bj * 128) = w;
                }
            }
    }
};
template <bool SECOND> struct EpiMix {
    static constexpr bool PERM = true, AFTER_DRAIN = false;
    const bf16_t* G; bf16_t* MIX;
    DI void operator()(const f32x4 (&acc)[2][2][4][2], const pg8::Unit& u, int wr, int wc, int fr, int fq) const {
        const int row0 = u.pm * 256 + wr * 64 + fr, colt = u.pn * 256 + wc * 32 + 8 * fq;
#pragma unroll
        for (int ai = 0; ai < 2; ++ai)
#pragma unroll
            for (int m = 0; m < 4; ++m) {
                const size_t row = (size_t)(row0 + ai * 128 + m * 16);
#pragma unroll
                for (int bj = 0; bj < 2; ++bj) {
                    const int col = colt + bj * 128;
                    float gv[8], o[8];
                    unpack8(*(const u32x4*)(G + row * 2048 + (SECOND ? 1024 : 0) + col), gv);
                    const f32x4 v0 = acc[ai][bj][m][0], v1 = acc[ai][bj][m][1];
                    if (SECOND) unpack8(*(const u32x4*)(MIX + row * 1024 + col), o);
                    else { for (int e = 0; e < 8; ++e) o[e] = 0.f; }
                    o[0] += gv[0] * v0.x; o[1] += gv[1] * v0.y; o[2] += gv[2] * v0.z; o[3] += gv[3] * v0.w;
                    o[4] += gv[4] * v1.x; o[5] += gv[5] * v1.y; o[6] += gv[6] * v1.z; o[7] += gv[7] * v1.w;
                    u32x4 w; w.x = pk2(o[0], o[1]); w.y = pk2(o[2], o[3]); w.z = pk2(o[4], o[5]); w.w = pk2(o[6], o[7]);
                    *(u32x4*)(MIX + row * 1024 + col) = w;
                }
            }
    }
};
template <bool INPLACE> struct EpiRes {
    static constexpr bool PERM = false, AFTER_DRAIN = false;
    const float* xp; const float* xs; float* out; const float* gate;
    DI void operator()(const f32x4 (&acc)[2][2][4][2], const pg8::Unit& u, int wr, int wc, int fr, int fq) const {
        const int row0 = u.pm * 256 + wr * 64 + fr, colt = u.pn * 256 + wc * 32 + 4 * fq;
        const float* gt = gate + (size_t)((u.pm * 256) >> 12) * 6144;
#pragma unroll
        for (int ai = 0; ai < 2; ++ai)
#pragma unroll
            for (int m = 0; m < 4; ++m) {
                const int row = row0 + ai * 128 + m * 16;
                float* orow = out + (size_t)row * D;
                const float* brow = INPLACE ? orow : (row < T_PROMPT ? xp + (size_t)row * D : xs + (size_t)(row - T_PROMPT) * D);
#pragma unroll
                for (int bj = 0; bj < 2; ++bj)
#pragma unroll
                    for (int n = 0; n < 2; ++n) {
                        const int col = colt + bj * 128 + n * 16;
                        const f32x4 xv = *(const f32x4*)(brow + col), gv = *(const f32x4*)(gt + col);
                        *(f32x4*)(orow + col) = xv + gv * acc[ai][bj][m][n];
                    }
            }
    }
};

DI void transpose_item(const float* __restrict__ W, int K, int N, bf16_t* __restrict__ WT, int mode, const float* __restrict__ scale,
                       float* scr, int item, int lane) {
    const int nblk = N >> 5, kb = item / nblk, nb = item % nblk, k0 = kb * 64, n0 = nb * 32;
#pragma unroll 8
    for (int i = 0; i < 32; ++i) {
        const int kk = 2 * i + (lane >> 5);
        float v = W[(size_t)(k0 + kk) * N + n0 + (lane & 31)];
        if (scale) v *= scale[k0 + kk];
        scr[kk * 33 + (lane & 31)] = v;
    }
    asm volatile("s_waitcnt lgkmcnt(0)" ::: "memory");
    const int c = lane & 7;
#pragma unroll
    for (int j = 0; j < 4; ++j) {
        const int nl = (lane >> 3) + 8 * j;
        const float* s = scr + (8 * c) * 33 + nl;
        u32x4 o;
        o.x = pk2(s[0 * 33], s[1 * 33]); o.y = pk2(s[2 * 33], s[3 * 33]); o.z = pk2(s[4 * 33], s[5 * 33]); o.w = pk2(s[6 * 33], s[7 * 33]);
        const int n = n0 + nl;
        int row;
        if (mode == 1) row = n < 1184 ? n : n + 96;
        else if (mode == 2) { const int h = n >> 7, jj = n & 127; row = jj < 64 ? h * 64 + jj : 512 + h * 64 + (jj - 64); }
        else if (mode == 3) { const int hf = n >= DFF ? 1 : 0, m2 = n - hf * DFF; row = (m2 >> 7) * 256 + hf * 128 + (m2 & 127); }
        else row = n;
        *(u32x4*)(WT + (size_t)row * K + k0 + 8 * c) = o;
    }
    asm volatile("s_waitcnt lgkmcnt(0)" ::: "memory");
}

DI void phase0(const Params& p, char* lds) {
    const int tid_ = opaque_tid();
    const int tid = TID4, bid = VBID, G = VGRID, lane = tid & 63, wave = tid >> 6;
    unsigned char* ws = p.ws;
    float* sc = (float*)lds;
    for (int it = bid; it < 384; it += G) {
        const int cb = it % 24, ks = it / 24;
        __syncthreads();
        for (int i = tid; i < 24 * 64; i += 256) {
            const int b = i >> 6, k = i & 63;
            const float* c = b < 8 ? p.in[2] + b * 1024 : p.in[3] + (b - 8) * 1024;
            const float v = c[ks * 64 + k];
            sc[i] = v * sigmoidf_(v);
        }
        __syncthreads();
        float a[24];
#pragma unroll
        for (int b = 0; b < 24; ++b) a[b] = 0.f;
        const int n = cb * 256 + tid;
        const float* w = p.in[4] + (size_t)(ks * 64) * 6144 + n;
        for (int k = 0; k < 64; ++k) {
            const float wv = w[(size_t)k * 6144];
#pragma unroll
            for (int b = 0; b < 24; ++b) a[b] += sc[b * 64 + k] * wv;
        }
        float* mp = (float*)(ws + O_MODP) + (size_t)(ks * 24) * 6144 + n;
#pragma unroll
        for (int b = 0; b < 24; ++b) mp[(size_t)b * 6144] = a[b];
    }
    __syncthreads();
    {
        float* scr = (float*)(lds + wave * 8448);
        const int gw = bid * 4 + wave, NGW = G * 4;
        constexpr int I0 = 16 * 101, I1 = 4 * 24, I2 = 2 * 32, I3 = 8 * 32, I4 = 8 * 32, I5 = 16 * 32, I6 = 16 * 176, I7 = 44 * 32;
        constexpr int NI = I0 + I1 + I2 + I3 + I4 + I5 + I6 + I7;
        for (int it = gw; it < NI; it += NGW) {
            int q = it;
            if (q < I0) { transpose_item(p.in[7], 1024, IN_TOTAL, (bf16_t*)(ws + O_WIN), 1, nullptr, scr, q, lane); continue; } q -= I0;
            if (q < I1) { transpose_item(p.in[12], 256, 768, (bf16_t*)(ws + O_WUQ), 0, p.in[11], scr, q, lane); continue; } q -= I1;
            if (q < I2) { transpose_item(p.in[14], 128, 1024, (bf16_t*)(ws + O_WUKV), 2, p.in[13], scr, q, lane); continue; } q -= I2;
            if (q < I3) { transpose_item(p.in[17], 512, 1024, (bf16_t*)(ws + O_WOA), 0, nullptr, scr, q, lane); continue; } q -= I3;
            if (q < I4) { transpose_item(p.in[18], 512, 1024, (bf16_t*)(ws + O_WOB), 0, nullptr, scr, q, lane); continue; } q -= I4;
            if (q < I5) { transpose_item(p.in[19], 1024, 1024, (bf16_t*)(ws + O_WOUT), 0, nullptr, scr, q, lane); continue; } q -= I5;
            if (q < I6) { transpose_item(p.in[21], 1024, NUP, (bf16_t*)(ws + O_WUP), 3, nullptr, scr, q, lane); continue; } q -= I6;
            transpose_item(p.in[24], DFF, 1024, (bf16_t*)(ws + O_WDN), 0, nullptr, scr, q, lane);
        }
    }
    const int gt = bid * 256 + tid, NGT = G * 256;
    for (int i = gt; i < 4096 * 48; i += NGT) {
        const int pos = i / 48, j = i % 48;
        float inv;
        if (j < 32) inv = exp2f(-(float)(2 * j) * (1.f / 64.f) * 13.287712379549449f);
        else inv = exp2f(-(float)(2 * (j - 32)) * (1.f / 32.f) * 13.287712379549449f);
        const float ang = (float)pos * inv;
        float rev = ang * 0.15915494309189535f;
        rev -= floorf(rev);
        const float sn = __builtin_amdgcn_sinf(rev), cs = __builtin_amdgcn_cosf(rev);
        float2* dst = j < 32 ? (float2*)(ws + O_ROPEA) + pos * 32 + j : (float2*)(ws + O_ROPEB) + pos * 16 + (j - 32);
        *dst = make_float2(cs, sn);
    }
    for (int i = gt; i < 96 * 1024 / 8; i += NGT) *(u32x4*)((bf16_t*)(ws + O_WIN) + 1184 * 1024 + (size_t)i * 8) = (u32x4){0u, 0u, 0u, 0u};
    if (gt < 256) *(u32x4*)(ws + O_ZROW + gt * 16) = (u32x4){0u, 0u, 0u, 0u};
}

DI void phase0m(const Params& p) {
    const int tid_ = opaque_tid();
    const int gt = VBID * 256 + TID4, NGT = VGRID * 256;
    const float* mp = (const float*)(p.ws + O_MODP);
    float* mod = (float*)(p.ws + O_MOD);
    for (int i = gt; i < 24 * 6144; i += NGT) {
        float s = p.in[5][i % 6144];
#pragma unroll
        for (int ks = 0; ks < 16; ++ks) s += mp[(size_t)ks * 24 * 6144 + i];
        mod[i] = s;
    }
}

DI void norm_pass(const Params& p, bool second, bf16_t* dst) {
    const int tid_ = opaque_tid();
    const int lane = TID4 & 63, gw = VBID * 4 + (TID4 >> 6), NGW = VGRID * 4;
    const float* gwt = second ? p.in[20] : p.in[6];
    const float* mod = (const float*)(p.ws + O_MOD);
    f32x4 gv[4];
#pragma unroll
    for (int j = 0; j < 4; ++j) gv[j] = *((const f32x4*)gwt + 64 * j + lane);
    for (int t0 = gw * 2; t0 < T; t0 += NGW * 2) {
        f32x4 v[2][4]; float s[2];
#pragma unroll
        for (int u = 0; u < 2; ++u) {
            const int t = t0 + u;
            const float* xr = second ? p.out + (size_t)t * D : xrow_ptr(p, t);
            s[u] = 0.f;
#pragma unroll
            for (int j = 0; j < 4; ++j) { v[u][j] = *((const f32x4*)xr + 64 * j + lane); s[u] += (v[u][j].x * v[u][j].x + v[u][j].y * v[u][j].y) + (v[u][j].z * v[u][j].z + v[u][j].w * v[u][j].w); }
        }
        const int b = t0 >> 12;
        const float* sh = mod + (size_t)b * 6144 + (second ? 3072 : 0);
        const float* sc = sh + 1024;
#pragma unroll
        for (int u = 0; u < 2; ++u) {
            const int t = t0 + u;
            const float rstd = rsqrtf(wave_sum(s[u]) * (1.f / D) + EPS);
            u32x2* o = (u32x2*)(dst + (size_t)(second ? t + b + 1 : t) * D) + lane;
#pragma unroll
            for (int j = 0; j < 4; ++j) {
                const f32x4 scv = *((const f32x4*)sc + 64 * j + lane), shv = *((const f32x4*)sh + 64 * j + lane);
                f32x4 y;
                y.x = v[u][j].x * rstd * gv[j].x * (1.f + scv.x) + shv.x; y.y = v[u][j].y * rstd * gv[j].y * (1.f + scv.y) + shv.y;
                y.z = v[u][j].z * rstd * gv[j].z * (1.f + scv.z) + shv.z; y.w = v[u][j].w * rstd * gv[j].w * (1.f + scv.w) + shv.w;
                o[64 * j] = (u32x2){pk2(y.x, y.y), pk2(y.z, y.w)};
            }
        }
    }
    if (second) {
        constexpr int NZR = 25 + (H2P_ROWS - (NBATCH * SEQP + 1));
        for (int z = gw; z < NZR; z += NGW) {
            const int pr = z < 25 ? z * SEQP : NBATCH * SEQP + 1 + (z - 25);
            u32x2* o = (u32x2*)(dst + (size_t)pr * D) + lane;
#pragma unroll
            for (int j = 0; j < 4; ++j) o[64 * j] = (u32x2){0u, 0u};
        }
    }
}

DI void phase1(const Params& p, char* lds) {
    pg8::Gemm g{(const bf16_t*)(p.ws + O_H), (const bf16_t*)(p.ws + O_WIN), T, NIN, 1024};
    pg8::StaticOrder so; so.init(T, NIN, gridDim.x, blockIdx.x);
    EpiP1 E{(bf16_t*)(p.ws + O_ZS), (bf16_t*)((unsigned char*)p.out + OO_G)};
    pg8::gemm_phase<EpiP1, pg8::StaticOrder, false>((PG8_LAS unsigned char*)lds, g, so, E, nullptr);
}

template <int NCH>
DI float row_sumsq(const bf16_t* rowp, int g) {
    float s = 0.f;
#pragma unroll
    for (int c = 0; c < NCH; ++c) {
        const u32x4 v = *(const u32x4*)(rowp + (g * NCH + c) * 8);
#pragma unroll
        for (int e = 0; e < 4; ++e) { const float a = bflo(v[e]), b = bfhi(v[e]); s += a * a + b * b; }
    }
    return xor_reduce_g(s);
}

DI void phase2q(const Params& p, char* lds) {
    pg8::Gemm g{(const bf16_t*)(p.ws + O_ZS) + 768, (const bf16_t*)(p.ws + O_WUQ), T, 768, 256, 256, NZ};
    pg8::StaticOrder so; so.init(T, 768, gridDim.x, blockIdx.x);
    EpiRaw E{(bf16_t*)(p.ws + O_QB), 768};
    pg8::gemm_phase<EpiRaw, pg8::StaticOrder, false>((PG8_LAS unsigned char*)lds, g, so, E, nullptr);
}

DI void phase2(const Params& p, char* lds) {
    const int tid_ = opaque_tid();
    unsigned char* ws = p.ws;
    const bf16_t* ZS = (const bf16_t*)(ws + O_ZS);
    const int tid = TID4, lane = tid & 63, wave = tid >> 6, r = lane & 15, g = lane >> 4;
    const float2* ropeA = (const float2*)(ws + O_ROPEA);
    const float2* ropeB = (const float2*)(ws + O_ROPEB);
    constexpr int NTL = T / 128;
    for (int it = VBID; it < NTL * 4; it += VGRID) {
        const int tile = it >> 2, hp = it & 3, t0 = tile * 128, b = t0 >> 12, s0 = t0 & (S - 1);
        {
            f32x4 acc[4][4]; zero_acc(acc);
            gemm_mainloop<128, 128, 2, 2>(acc, ZS + (size_t)t0 * NZ + 1024, NZ,
                                          (const bf16_t*)(ws + O_WUKV) + (size_t)(hp * 128) * 128, 128, 128, lds, tid);
            const int wm = wave >> 1, wn = wave & 1, h = hp * 2 + wn;
            {
                const float* gk = p.in[16];
                bf16_t* KB = (bf16_t*)(ws + O_KB) + ((size_t)(b * 8 + h) * S) * 96;
#pragma unroll
                for (int mt = 0; mt < 4; ++mt) {
                    const int ml = wm * 64 + mt * 16 + r, sp = s0 + ml;
                    const bf16_t* zrow = ZS + (size_t)(t0 + ml) * NZ;
                    const float rstd = rsqrtf(row_sumsq<4>(zrow + 1024, g) * (1.f / 128.f) + EPS);
                    const u32x2 k1 = *(const u32x2*)(zrow + 1152 + g * 4), k2 = *(const u32x2*)(zrow + 1168 + g * 4);
                    float x1[4] = {bflo(k1.x), bfhi(k1.x), bflo(k1.y), bfhi(k1.y)};
                    float x2[4] = {bflo(k2.x), bfhi(k2.x), bflo(k2.y), bfhi(k2.y)};
                    float ss = 0.f;
#pragma unroll
                    for (int j = 0; j < 4; ++j) ss += x1[j] * x1[j] + x2[j] * x2[j];
#pragma unroll
                    for (int nt = 0; nt < 4; ++nt) { acc[mt][nt] = acc[mt][nt] * rstd; const f32x4 a = acc[mt][nt]; ss += (a.x * a.x + a.y * a.y) + (a.z * a.z + a.w * a.w); }
                    const float r2 = rsqrtf(xor_reduce_g(ss) * (1.f / 96.f) + EPS);
                    bf16_t* krow = KB + (size_t)sp * 96 + g * 4;
#pragma unroll
                    for (int nt = 0; nt < 4; ++nt) {
                        const f32x4 gg = *(const f32x4*)(gk + nt * 16 + g * 4);
                        const f32x4 a = acc[mt][nt] * r2 * gg;
                        *(u32x2*)(krow + nt * 16) = (u32x2){pk2(a.x, a.y), pk2(a.z, a.w)};
                    }
                    const f32x4 g1 = *(const f32x4*)(gk + 64 + g * 4), g2 = *(const f32x4*)(gk + 80 + g * 4);
                    float o1[4], o2[4];
#pragma unroll
                    for (int j = 0; j < 4; ++j) {
                        const float2 cs = ropeB[sp * 16 + g * 4 + j];
                        const float y1 = x1[j] * r2 * g1[j], y2 = x2[j] * r2 * g2[j];
                        o1[j] = y1 * cs.x - y2 * cs.y; o2[j] = y1 * cs.y + y2 * cs.x;
                    }
                    *(u32x2*)(krow + 64) = (u32x2){pk2(o1[0], o1[1]), pk2(o1[2], o1[3])};
                    *(u32x2*)(krow + 80) = (u32x2){pk2(o2[0], o2[1]), pk2(o2[2], o2[3])};
                    __builtin_amdgcn_sched_barrier(0);
                }
            }
        }
    }
    for (int it = VBID; it < NTL * 4; it += VGRID) {
        const int tile = it >> 2, hp = it & 3, t0 = tile * 128, b = t0 >> 12, s0 = t0 & (S - 1);
        {
            f32x4 acc[4][4]; zero_acc(acc);
            gemm_mainloop<128, 128, 2, 2>(acc, ZS + (size_t)t0 * NZ + 1024, NZ,
                                          (const bf16_t*)(ws + O_WUKV) + (size_t)(512 + hp * 128) * 128, 128, 128, lds, tid);
            const int wm = wave >> 1, wn = wave & 1, h = hp * 2 + wn;
            {
                bf16_t* VT = (bf16_t*)(ws + O_VTB) + ((size_t)(b * 8 + h) * 64) * S;
#pragma unroll
                for (int mt = 0; mt < 4; ++mt) {
                    const int ml = wm * 64 + mt * 16 + r, sp = s0 + ml;
                    const float rstd = rsqrtf(row_sumsq<4>(ZS + (size_t)(t0 + ml) * NZ + 1024, g) * (1.f / 128.f) + EPS);
                    const int ps = perm32(sp);
#pragma unroll
                    for (int nt = 0; nt < 4; ++nt)
#pragma unroll
                        for (int j = 0; j < 4; ++j) VT[(size_t)(nt * 16 + g * 4 + j) * S + ps] = f2bf(acc[mt][nt][j] * rstd);
                    __builtin_amdgcn_sched_barrier(0);
                }
            }
        }
    }
    __syncthreads();
    for (int tile = VBID; tile < NTL * 2; tile += VGRID) {
        const int t0 = tile * 64, b = t0 >> 12, s0 = t0 & (S - 1);
        {
            const float* gqa = p.in[8];
            const float* gka = p.in[9];
            const int half = lane >> 5, i = lane & 31;
            const float qs = 0.125f * LOG2E;
            const float gq1 = gqa[i], gq2 = gqa[32 + i], gk1 = gka[i], gk2 = gka[32 + i];
            for (int tt0 = wave * 4; tt0 < 64; tt0 += 16) {
                float x1[4][5], x2[4][5]; float2 cs[4];
#pragma unroll
                for (int u = 0; u < 4; ++u) {
                    const bf16_t* zrow = ZS + (size_t)(t0 + tt0 + u) * NZ;
                    cs[u] = ropeA[(s0 + tt0 + u) * 32 + i];
#pragma unroll
                    for (int q = 0; q < 5; ++q) { const int hd = 2 * q + half; x1[u][q] = bf2f(zrow[hd * 64 + i]); x2[u][q] = bf2f(zrow[hd * 64 + 32 + i]); }
                }
#pragma unroll
                for (int u = 0; u < 4; ++u) {
                    const int sp = s0 + tt0 + u;
#pragma unroll
                    for (int q = 0; q < 5; ++q) {
                        const int hd = 2 * q + half;
                        float ss = x1[u][q] * x1[u][q] + x2[u][q] * x2[u][q];
#pragma unroll
                        for (int o = 1; o < 32; o <<= 1) ss += __shfl_xor(ss, o);
                        const float rr = rsqrtf(ss * (1.f / 64.f) + EPS);
                        const bool isq = q < 4;
                        const float y1 = x1[u][q] * rr * (isq ? gq1 : gk1), y2 = x2[u][q] * rr * (isq ? gq2 : gk2);
                        float o1 = y1 * cs[u].x - y2 * cs[u].y, o2 = y1 * cs[u].y + y2 * cs[u].x;
                        bf16_t* dst;
                        if (isq) { o1 *= qs; o2 *= qs; dst = (bf16_t*)(ws + O_QA) + ((size_t)(b * 8 + hd) * S + sp) * 64; }
                        else dst = (bf16_t*)(ws + O_KA) + ((size_t)(b * 2 + (hd - 8)) * S + sp) * 64;
                        dst[i] = f2bf(o1); dst[32 + i] = f2bf(o2);
                    }
                }
            }
            __syncthreads();
            bf16_t* tl = (bf16_t*)lds;
            for (int idx = tid; idx < 64 * 16; idx += 256) {
                const int tt = idx >> 4, c = idx & 15;
                const u32x4 v = *(const u32x4*)(ZS + (size_t)(t0 + tt) * NZ + 640 + c * 8);
                u32x2* d2 = (u32x2*)(tl + tt * 132 + c * 8);
                d2[0] = (u32x2){v.x, v.y}; d2[1] = (u32x2){v.z, v.w};
            }
            __syncthreads();
            bf16_t* VT = (bf16_t*)(ws + O_VTA) + ((size_t)(b * 2) * 64) * S;
            for (int idx = tid; idx < 64 * 128; idx += 256) {
                const int pp = idx & 63, dd = idx >> 6;
                const int lo = pp & 31;
                const int tt = (pp & ~31) | (((lo >> 2) & 1) << 4) | ((lo >> 3) << 2) | (lo & 3);
                VT[(size_t)dd * S + s0 + pp] = tl[tt * 132 + dd];
            }
            __syncthreads();
        }
    }
}

template <int DQK, bool WIN, bool QN = false>
DI void attn_item(const bf16_t* __restrict__ Qw, const bf16_t* __restrict__ Kb, const bf16_t* __restrict__ Vt, int key0, int ntiles, int q0,
                  float shift2, float sink_term, bf16_t* __restrict__ Ow, int ldo, char* lds, const int tid,
                  const bf16_t* __restrict__ cqp = nullptr, const float* __restrict__ gq = nullptr, const float2* __restrict__ rope = nullptr) {
    constexpr int QT = 4, KS = DQK / 32, CH = DQK / 8, KROW = DQK * 2, KBYTES = 64 * KROW, NKI = KBYTES / 1024, STAGE = KBYTES + 8192;
    const int lane = tid & 63, r = lane & 15, g = lane >> 4, wave = __builtin_amdgcn_readfirstlane(tid >> 6);
    bf16x8 qf[QT][KS];
    if constexpr (QN) __syncthreads();
    if constexpr (!QN) {
#pragma unroll
        for (int qt = 0; qt < QT; ++qt)
#pragma unroll
            for (int ks = 0; ks < KS; ++ks) qf[qt][ks] = *(const bf16x8*)(Qw + (size_t)(qt * 16 + r) * DQK + ks * 32 + g * 8);
    } else {
        const float qs = 0.10206207261596577f * LOG2E;
#pragma unroll
        for (int qt = 0; qt < QT; ++qt) {
            const int row = qt * 16 + r;
            const float rstd = rsqrtf(row_sumsq<8>(cqp + (size_t)row * NZ, g) * (1.f / 256.f) + EPS);
            float x[3][8]; float ss = 0.f;
#pragma unroll
            for (int ks = 0; ks < 3; ++ks) {
                unpack8(*(const u32x4*)(Qw + (size_t)row * 768 + ks * 32 + g * 8), x[ks]);
#pragma unroll
                for (int e = 0; e < 8; ++e) { x[ks][e] *= rstd; ss += x[ks][e] * x[ks][e]; }
            }
            const float r2 = rsqrtf(xor_reduce_g(ss) * (1.f / 96.f) + EPS);
#pragma unroll
            for (int ks = 0; ks < 3; ++ks) {
                const f32x4 g0 = *(const f32x4*)(gq + ks * 32 + g * 8), g1 = *(const f32x4*)(gq + ks * 32 + g * 8 + 4);
                x[ks][0] *= r2 * g0.x; x[ks][1] *= r2 * g0.y; x[ks][2] *= r2 * g0.z; x[ks][3] *= r2 * g0.w;
                x[ks][4] *= r2 * g1.x; x[ks][5] *= r2 * g1.y; x[ks][6] *= r2 * g1.z; x[ks][7] *= r2 * g1.w;
            }
#pragma unroll
            for (int e = 0; e < 8; ++e) {
                const float2 cs = rope[(q0 + row) * 16 + (g & 1) * 8 + e];
                const float own = x[2][e], oth = __shfl_xor(own, 32);
                x[2][e] = g < 2 ? own * cs.x - oth * cs.y : oth * cs.y + own * cs.x;
            }
#pragma unroll
            for (int ks = 0; ks < 3; ++ks) {
                u32x4 u;
                u.x = pk2(x[ks][0] * qs, x[ks][1] * qs); u.y = pk2(x[ks][2] * qs, x[ks][3] * qs);
                u.z = pk2(x[ks][4] * qs, x[ks][5] * qs); u.w = pk2(x[ks][6] * qs, x[ks][7] * qs);
                *(u32x4*)(lds + ((wave * QT + qt) * 3 + ks) * 1024 + lane * 16) = u;
            }
            __builtin_amdgcn_sched_barrier(0);
        }
        asm volatile("s_waitcnt lgkmcnt(0)" ::: "memory");
#pragma unroll
        for (int qt = 0; qt < QT; ++qt)
#pragma unroll
            for (int ks = 0; ks < KS; ++ks) qf[qt][ks] = *(const bf16x8*)(lds + ((wave * QT + qt) * 3 + ks) * 1024 + lane * 16);
        asm volatile("s_waitcnt lgkmcnt(0)" ::: "memory");
    }
    f32x4 oacc[4][QT], lacc[QT];
#pragma unroll
    for (int qt = 0; qt < QT; ++qt) {
        lacc[qt] = (f32x4){0.f, 0.f, 0.f, 0.f};
#pragma unroll
        for (int i = 0; i < 4; ++i) oacc[i][qt] = (f32x4){0.f, 0.f, 0.f, 0.f};
    }
    int ksrc[2];
#pragma unroll
    for (int i = 0; i < 2; ++i) {
        const int pch = (wave + 8 * i) * 64 + lane, row = pch / CH, c = pch % CH;
        const int sc = (DQK == 96) ? ((c & ~3) | ((c & 3) ^ ((0x78 >> (2 * ((row >> 2) & 3))) & 3))) : (c ^ ((row >> 1) & 7));
        ksrc[i] = row * DQK + sc * 8;
    }
    const int vrow = tid >> 3, vsrc = ((tid & 7) ^ ((vrow >> 1) & 7)) * 8;
    const bf16_t* Vp = Vt + (size_t)vrow * S + vsrc;
    auto issue = [&](int tile, int st) {
        const int kb = key0 + tile * 64;
        char* d = lds + st * STAGE + tid * 16;
        __builtin_amdgcn_global_load_lds((const GAS unsigned*)(Kb + (size_t)kb * DQK + ksrc[0]), (LAS unsigned*)(d), 16, 0, 0);
        if (NKI > 8 && wave < NKI - 8)
            __builtin_amdgcn_global_load_lds((const GAS unsigned*)(Kb + (size_t)kb * DQK + ksrc[1]), (LAS unsigned*)(d + 8192), 16, 0, 0);
        __builtin_amdgcn_global_load_lds((const GAS unsigned*)(Vp + kb), (LAS unsigned*)(d + KBYTES), 16, 0, 0);
    };
    const int ksw = (DQK == 96) ? ((0x78 >> (2 * ((r >> 2) & 3))) & 3) : ((r >> 1) & 7);
    const int vsw = (r >> 1) & 7;
    const bf16x8 ones = (bf16x8){0x3F80, 0x3F80, 0x3F80, 0x3F80, 0x3F80, 0x3F80, 0x3F80, 0x3F80};
    const f32x4 sinit = (f32x4){-shift2, -shift2, -shift2, -shift2};
    __syncthreads();
    issue(0, 0);
    __syncthreads();
    for (int tile = 0; tile < ntiles; ++tile) {
        const int cur = tile & 1;
        if (tile + 1 < ntiles) issue(tile + 1, cur ^ 1);
        const char* sK = lds + cur * STAGE; const char* sV = sK + KBYTES;
#pragma unroll
        for (int kk = 0; kk < 2; ++kk) {
            f32x4 sacc[2][QT];
#pragma unroll
            for (int a = 0; a < 2; ++a) {
#pragma unroll
                for (int qt = 0; qt < QT; ++qt) sacc[a][qt] = sinit;
#pragma unroll
                for (int ks = 0; ks < KS; ++ks) {
                    const int kch = (DQK == 96) ? (ks * 4 + (g ^ ksw)) : ((ks * 4 + g) ^ ksw);
                    const bf16x8 kf = *(const bf16x8*)(sK + ((2 * kk + a) * 16 + r) * KROW + kch * 16);
#pragma unroll
                    for (int qt = 0; qt < QT; ++qt) sacc[a][qt] = __builtin_amdgcn_mfma_f32_16x16x32_bf16(kf, qf[qt][ks], sacc[a][qt], 0, 0, 0);
                }
            }
            const int kbase = key0 + tile * 64 + kk * 32 + g * 4;
            bf16x8 pb[QT];
#pragma unroll
            for (int qt = 0; qt < QT; ++qt) {
#pragma unroll
                for (int a = 0; a < 2; ++a)
#pragma unroll
                    for (int j = 0; j < 4; ++j) {
                        float pv = fast_exp2(sacc[a][qt][j]);
                        if (WIN) { const int dlt = (kbase + a * 16 + j) - (q0 + qt * 16 + r); if (dlt > 128 || dlt < -128) pv = 0.f; }
                        sacc[a][qt][j] = pv;
                    }
                u32x4 u;
                u.x = pk2(sacc[0][qt][0], sacc[0][qt][1]); u.y = pk2(sacc[0][qt][2], sacc[0][qt][3]);
                u.z = pk2(sacc[1][qt][0], sacc[1][qt][1]); u.w = pk2(sacc[1][qt][2], sacc[1][qt][3]);
                pb[qt] = __builtin_bit_cast(bf16x8, u);
            }
#pragma unroll
            for (int dt = 0; dt < 4; ++dt) {
                const bf16x8 vf = *(const bf16x8*)(sV + (dt * 16 + r) * 128 + (((kk * 4 + g) ^ vsw) * 16));
#pragma unroll
                for (int qt = 0; qt < QT; ++qt) oacc[dt][qt] = __builtin_amdgcn_mfma_f32_16x16x32_bf16(vf, pb[qt], oacc[dt][qt], 0, 0, 0);
            }
#pragma unroll
            for (int qt = 0; qt < QT; ++qt) lacc[qt] = __builtin_amdgcn_mfma_f32_16x16x32_bf16(ones, pb[qt], lacc[qt], 0, 0, 0);
            __builtin_amdgcn_sched_barrier(0);
        }
        __syncthreads();
    }
#pragma unroll
    for (int qt = 0; qt < QT; ++qt) {
        const float inv = fast_rcp(lacc[qt][0] + sink_term);
        bf16_t* orow = Ow + (size_t)(qt * 16 + r) * ldo + g * 4;
#pragma unroll
        for (int dt = 0; dt < 4; ++dt) { const f32x4 a = oacc[dt][qt] * inv; *(u32x2*)(orow + dt * 16) = (u32x2){pk2(a.x, a.y), pk2(a.z, a.w)}; }
    }
}

DI float max_abs(const float* v, int n) { float m = 0.f; for (int i = 0; i < n; ++i) m = fmaxf(m, fabsf(v[i])); return m; }

DI void phase3(const Params& p, char* lds) {
    unsigned char* ws = p.ws;
    const int tid = opaque_tid(), wave = tid >> 6;
    const float shiftB = 9.797958971132712f * max_abs(p.in[15], 96) * max_abs(p.in[16], 96) * LOG2E;
    const float shiftA = 8.f * max_abs(p.in[8], 64) * max_abs(p.in[9], 64) * LOG2E;
    bf16_t* OA = (bf16_t*)(p.ws + O_OA);
    bf16_t* OB = (bf16_t*)(p.ws + O_OB);
    constexpr int NB_ITEMS = 24 * 8 * 8, NA_ITEMS = 24 * 2 * 32;
    for (int L = blockIdx.x; L < NB_ITEMS; L += gridDim.x) {
        const int idx = (L & 7) * (NB_ITEMS / 8) + (L >> 3);
        const int bh = idx >> 3, qb = idx & 7, b = bh >> 3, h = bh & 7;
        const int q0 = qb * 512 + wave * 64;
        attn_item<96, false, true>((const bf16_t*)(ws + O_QB) + ((size_t)b * S + q0) * 768 + h * 96, (const bf16_t*)(ws + O_KB) + (size_t)bh * S * 96,
                             (const bf16_t*)(ws + O_VTB) + (size_t)bh * 64 * S, 0, S / 64, q0, shiftB, 0.f,
                             OB + ((size_t)b * S + q0) * 512 + h * 64, 512, lds, tid,
                             (const bf16_t*)(ws + O_ZS) + ((size_t)b * S + q0) * NZ + 768, p.in[15], (const float2*)(ws + O_ROPEB));
    }
    for (int L = blockIdx.x; L < NA_ITEMS; L += gridDim.x) {
        const int idx = (L & 7) * (NA_ITEMS / 8) + (L >> 3);
        const int bk = idx >> 5, qb = idx & 31, b = bk >> 1, kvh = bk & 1;
        const int q0 = qb * 128 + (wave >> 2) * 64, hd = kvh * 4 + (wave & 3);
        int ks = qb * 128 - 128; if (ks < 0) ks = 0; if (ks > S - 384) ks = S - 384;
        const float sink_term = fast_exp2(p.in[10][hd] * LOG2E - shiftA);
        attn_item<64, true>((const bf16_t*)(ws + O_QA) + ((size_t)(b * 8 + hd) * S + q0) * 64, (const bf16_t*)(ws + O_KA) + (size_t)bk * S * 64,
                            (const bf16_t*)(ws + O_VTA) + (size_t)bk * 64 * S, ks, 6, q0, shiftA, sink_term,
                            OA + ((size_t)b * S + q0) * 512 + hd * 64, 512, lds, tid);
    }
}

DI void phase4(const Params& p, char* lds) {
    const bf16_t* Gt = (const bf16_t*)((unsigned char*)p.out + OO_G);
    bf16_t* MIX = (bf16_t*)(p.ws + O_ZS);
    pg8::StaticOrder so; so.init(T, 1024, gridDim.x, blockIdx.x);
    {
        pg8::Gemm g{(const bf16_t*)(p.ws + O_OA), (const bf16_t*)(p.ws + O_WOA), T, 1024, 512};
        EpiMix<false> E{Gt, MIX};
        pg8::gemm_phase<EpiMix<false>, pg8::StaticOrder, false>((PG8_LAS unsigned char*)lds, g, so, E, nullptr);
    }
    {
        pg8::Gemm g{(const bf16_t*)(p.ws + O_OB), (const bf16_t*)(p.ws + O_WOB), T, 1024, 512};
        EpiMix<true> E{Gt, MIX};
        pg8::gemm_phase<EpiMix<true>, pg8::StaticOrder, false>((PG8_LAS unsigned char*)lds, g, so, E, nullptr);
    }
}

DI void phase5(const Params& p, char* lds) {
    pg8::Gemm g{(const bf16_t*)(p.ws + O_ZS), (const bf16_t*)(p.ws + O_WOUT), T, 1024, 1024};
    pg8::StaticOrder so; so.init(T, 1024, gridDim.x, blockIdx.x);
    EpiRes<false> E{p.in[0], p.in[1], p.out, (const float*)(p.ws + O_MOD) + 2048};
    pg8::gemm_phase<EpiRes<false>, pg8::StaticOrder, false>((PG8_LAS unsigned char*)lds, g, so, E, nullptr);
}

struct OneUnit {
    pg8::Unit u;
    DI bool next(int i, pg8::Unit& o) const { if (i) return false; o = u; return true; }
    DI void a_ready(const pg8::Unit&) const {}
    DI void done(const pg8::Unit&) const {}
};
struct EpiConv {
    static constexpr bool PERM = true, AFTER_DRAIN = true;
    bf16_t* ACT; const float* cw; const float* cb;
    DI void operator()(const f32x4 (&)[2][2][4][2], const pg8::Unit&, int, int, int, int) const {}
    DI void fused(const f32x4 (&acc)[2][2][4][2], const pg8::Unit& u, int wr, int wc, int fr, int fq, PG8_LAS unsigned char* lds, int wid, int lane) const {
#pragma unroll
        for (int ai = 0; ai < 2; ++ai)
#pragma unroll
            for (int m = 0; m < 4; ++m) {
                const int row = ai * 128 + wr * 64 + m * 16 + fr;
#pragma unroll
                for (int bj = 0; bj < 2; ++bj) {
                    const int ch = bj * 16 + wc * 4 + fq;
                    const f32x4 v0 = acc[ai][bj][m][0], v1 = acc[ai][bj][m][1];
                    u32x4 w; w.x = pk2(v0.x, v0.y); w.y = pk2(v0.z, v0.w); w.z = pk2(v1.x, v1.y); w.w = pk2(v1.z, v1.w);
                    *(PG8_LAS u32x4*)(lds + row * 512 + ((ch ^ (row & 31)) * 16)) = w;
                }
            }
        __syncthreads();
        {
            const int tid = wid * 64 + lane, cc = tid & 15, rr = tid >> 4;
            const int ca = u.pn * 128 + cc * 8, cg = DFF + ca;
            float wa[3][8], wg[3][8], ba[8], bg[8];
#pragma unroll
            for (int q = 0; q < 2; ++q) {
#pragma unroll
                for (int t = 0; t < 3; ++t) {
                    const f32x4 x = *(const f32x4*)(cw + t * NUP + ca + 4 * q), y = *(const f32x4*)(cw + t * NUP + cg + 4 * q);
#pragma unroll
                    for (int e = 0; e < 4; ++e) { wa[t][4 * q + e] = x[e]; wg[t][4 * q + e] = y[e]; }
                }
                const f32x4 x = *(const f32x4*)(cb + ca + 4 * q), y = *(const f32x4*)(cb + cg + 4 * q);
#pragma unroll
                for (int e = 0; e < 4; ++e) { ba[4 * q + e] = x[e]; bg[4 * q + e] = y[e]; }
            }
#pragma unroll 2
            for (int q = 0; q < 8; ++q) {
                const int e1 = rr + 32 * q;
                const int pr1 = u.pm * 254 + e1 - 1;
                const int b = pr1 / SEQP, s = pr1 - b * SEQP;
                if (e1 >= 1 && e1 <= 254 && s < S && b < NBATCH) {
                    float a0[8], a1[8], a2[8], g0[8], g1[8], g2[8];
                    const int r0 = e1 - 1, r1 = e1, r2 = e1 + 1;
                    unpack8(*(const PG8_LAS u32x4*)(lds + r0 * 512 + ((cc ^ (r0 & 31)) * 16)), a0);
                    unpack8(*(const PG8_LAS u32x4*)(lds + r1 * 512 + ((cc ^ (r1 & 31)) * 16)), a1);
                    unpack8(*(const PG8_LAS u32x4*)(lds + r2 * 512 + ((cc ^ (r2 & 31)) * 16)), a2);
                    unpack8(*(const PG8_LAS u32x4*)(lds + r0 * 512 + (((16 + cc) ^ (r0 & 31)) * 16)), g0);
                    unpack8(*(const PG8_LAS u32x4*)(lds + r1 * 512 + (((16 + cc) ^ (r1 & 31)) * 16)), g1);
                    unpack8(*(const PG8_LAS u32x4*)(lds + r2 * 512 + (((16 + cc) ^ (r2 & 31)) * 16)), g2);
                    float av[8];
#pragma unroll
                    for (int e = 0; e < 8; ++e) {
                        const float ua = ba[e] + wa[0][e] * a0[e] + wa[1][e] * a1[e] + wa[2][e] * a2[e];
                        const float ug = bg[e] + wg[0][e] * g0[e] + wg[1][e] * g1[e] + wg[2][e] * g2[e];
                        av[e] = ug * sigmoidf_(ug) * ua;
                    }
                    u32x4 ov; ov.x = pk2(av[0], av[1]); ov.y = pk2(av[2], av[3]); ov.z = pk2(av[4], av[5]); ov.w = pk2(av[6], av[7]);
                    *(u32x4*)(ACT + ((size_t)b * S + s) * DFF + ca) = ov;
                }
            }
        }
        __syncthreads();
    }
};

DI void phase7(const Params& p, char* lds) {
    pg8::Gemm g{(const bf16_t*)(p.ws + O_H2P), (const bf16_t*)(p.ws + O_WUP), 388 * 256, NUP, 1024, 254};
    pg8::StaticOrder so; so.init(388 * 256, NUP, gridDim.x, blockIdx.x);
    EpiConv E{(bf16_t*)(p.ws + O_ACT), p.in[22], p.in[23]};
    for (int i = 0;; ++i) {
        OneUnit one;
        if (!so.next(i, one.u)) break;
        pg8::gemm_phase<EpiConv, OneUnit, false>((PG8_LAS unsigned char*)lds, g, one, E, nullptr);
    }
}

DI void phase8(const Params& p, char* lds) {
    pg8::Gemm g{(const bf16_t*)(p.ws + O_ACT), (const bf16_t*)(p.ws + O_WDN), T, 1024, DFF};
    pg8::StaticOrder so; so.init(T, 1024, gridDim.x, blockIdx.x);
    EpiRes<true> E{p.in[0], p.in[1], p.out, (const float*)(p.ws + O_MOD) + 5120};
    pg8::gemm_phase<EpiRes<true>, pg8::StaticOrder, false>((PG8_LAS unsigned char*)lds, g, so, E, nullptr);
}

__global__ void __launch_bounds__(512) fwd_megakernel(Params p) {
    __shared__ __attribute__((aligned(16))) char lds[131072];
    cg::grid_group grid = cg::this_grid();
    char* lds4 = lds + __builtin_amdgcn_readfirstlane((int)(threadIdx.x >> 8)) * 65536;
    phase0(p, lds4);
    grid.sync();
    phase0m(p);
    grid.sync();
    norm_pass(p, false, (bf16_t*)(p.ws + O_H));
    grid.sync();
    phase1(p, lds);
    grid.sync();
    phase2q(p, lds);
    phase2(p, lds4);
    grid.sync();
    phase3(p, lds);
    grid.sync();
    phase4(p, lds);
    grid.sync();
    phase5(p, lds);
    grid.sync();
    norm_pass(p, true, (bf16_t*)(p.ws + O_H2P));
    grid.sync();
    phase7(p, lds);
    grid.sync();
    phase8(p, lds);
}

extern "C" void kernel_launch(void* const* d_in, const int* in_sizes, int n_in, void* d_out, int out_size, void* d_ws, size_t ws_size,
                              hipStream_t stream) {
    static int grid_blocks = 0;
    if (!grid_blocks) {
        int dev = 0, cus = 0, per_cu = 0;
        hipGetDevice(&dev);
        hipDeviceGetAttribute(&cus, hipDeviceAttributeMultiprocessorCount, dev);
        hipOccupancyMaxActiveBlocksPerMultiprocessor(&per_cu, fwd_megakernel, 512, 0);
        if (per_cu < 1) per_cu = 1;
        if (per_cu > 1) per_cu = 1;
        grid_blocks = cus * per_cu;
        if (n_in != 25 || ws_size < WS_NEED || out_size != T * D)
            fprintf(stderr, "kernel_launch: unexpected sizes n_in=%d ws=%zu out=%d\n", n_in, ws_size, out_size);
    }
    Params p{};
    for (int i = 0; i < 25; ++i) p.in[i] = (const float*)d_in[i];
    p.out = (float*)d_out;
    p.ws = (unsigned char*)d_ws;
    void* args[] = {&p};
    hipError_t e = hipLaunchCooperativeKernel((void*)fwd_megakernel, dim3(grid_blocks), dim3(512), args, 0, stream);
    if (e != hipSuccess) fprintf(stderr, "cooperative launch failed: %s (grid %d)\n", hipGetErrorString(e), grid_blocks);
}
```
